# Optimizing an MI355X kernel written in HIP

```python
import math
import jax, jax.numpy as jnp
from jax import lax
import numpy as np

D_MODEL = 1024
BATCH = 32
SEQ = 2048
DEPTH = 4

GRID_W = 64
CTX_LEN = 256
ROPE_THETA = 10000.0
EPS = 1e-6
NEG_INF = -1e30
Q_BLOCK = 128
D_FF = 4 * D_MODEL

MLA_HEADS = 8
MLA_NOPE = 64
MLA_ROPE = 32
MLA_V = 64
MLA_Q_RANK = 256
MLA_KV_RANK = 128
MLA_SCALE = (MLA_NOPE + MLA_ROPE) ** -0.5
DIFF_HEADS = 4
DIFF_HD = 64
DIFF_SCALE = DIFF_HD ** -0.5
GQA_HEADS = 8
GQA_KV_HEADS = 2
GQA_GROUP = GQA_HEADS // GQA_KV_HEADS
GQA_HD = 64
NA_HEADS = 8
NA_HD = 64
NA_WIN_ROWS = 8
NA_WIN_COLS = 16
NA_COL_CHUNK = 16
NA_COL_BAND = NA_COL_CHUNK + NA_WIN_COLS
HEAD_SCALE = GQA_HD ** -0.5

EVEN_SPLITS = (MLA_Q_RANK, MLA_KV_RANK, MLA_ROPE,
               DIFF_HEADS * 2 * DIFF_HD, DIFF_HEADS * 2 * DIFF_HD, DIFF_HEADS * 2 * DIFF_HD)
EVEN_IN = sum(EVEN_SPLITS)
EVEN_MIX = MLA_HEADS * MLA_V + DIFF_HEADS * 2 * DIFF_HD
ODD_SPLITS = (GQA_HEADS * GQA_HD, GQA_KV_HEADS * GQA_HD, GQA_KV_HEADS * GQA_HD,
              NA_HEADS * NA_HD, NA_HEADS * NA_HD, NA_HEADS * NA_HD)
ODD_IN = sum(ODD_SPLITS)
ODD_MIX = GQA_HEADS * GQA_HD + NA_HEADS * NA_HD

kernel_name = 'hybrid_flow_backbone'


def rms_norm(x, g):
    xf = x.astype(jnp.float32)
    y = xf * lax.rsqrt(jnp.mean(xf * xf, axis=-1, keepdims=True) + EPS)
    return (y * g.astype(jnp.float32)).astype(x.dtype)


def modulate(u, shift, scale):
    return u * (1 + scale) + shift


def split_cols(p, sizes):
    return jnp.split(p, np.cumsum(sizes)[:-1].tolist(), axis=-1)


def axial_angles(seq_len, rot_dim):
    t = jnp.arange(seq_len, dtype=jnp.int32)
    row = (t // GRID_W).astype(jnp.float32)
    col = (t % GRID_W).astype(jnp.float32)
    n = rot_dim // 4
    inv = ROPE_THETA ** (-jnp.arange(n, dtype=jnp.float32) / n)
    return jnp.concatenate([row[:, None] * inv, col[:, None] * inv], axis=-1)


def apply_rope(x, ang):
    half = x.shape[-1] // 2
    shape = (1, ang.shape[0]) + (1,) * (x.ndim - 3) + (half,)
    cos = jnp.cos(ang).reshape(shape).astype(x.dtype)
    sin = jnp.sin(ang).reshape(shape).astype(x.dtype)
    x1, x2 = x[..., :half], x[..., half:]
    return jnp.concatenate([x1 * cos - x2 * sin, x2 * cos + x1 * sin], axis=-1)


def sweep_query_blocks(fn, *qs):
    b, s = qs[0].shape[:2]
    nb = s // Q_BLOCK
    blocks = tuple(jnp.moveaxis(q.reshape((b, nb, Q_BLOCK) + q.shape[2:]), 1, 0) for q in qs)
    out = lax.map(lambda a: fn(*a), blocks)
    out = jnp.moveaxis(out, 0, 1)
    return out.reshape((b, s) + out.shape[3:])


def attend_mla(q_nope, q_rope, k_nope, k_rope, v):
    s = (jnp.einsum('bqhd,bkhd->bhqk', q_nope, k_nope)
         + jnp.einsum('bqhr,bkr->bhqk', q_rope, k_rope)).astype(jnp.float32) * MLA_SCALE
    p = jax.nn.softmax(s, axis=-1).astype(v.dtype)
    return jnp.einsum('bhqk,bkhd->bqhd', p, v)


def attend_diff(q, k, v, lam):
    s = jnp.einsum('bqhmd,bkhmd->bhmqk', q, k).astype(jnp.float32) * DIFF_SCALE
    p = jax.nn.softmax(s, axis=-1)
    p = p[:, :, 0] - lam * p[:, :, 1]
    return jnp.einsum('bhqk,bkhv->bqhv', p.astype(v.dtype), v)


def attend_gqa(q, k, v):
    s = jnp.einsum('bqhgd,bkhd->bhgqk', q, k).astype(jnp.float32) * HEAD_SCALE
    p = jax.nn.softmax(s, axis=-1).astype(v.dtype)
    return jnp.einsum('bhgqk,bkhd->bqhgd', p, v)


def neighbourhood_attention(q, k, v, k_ctx, v_ctx, rpb):
    b, s, h, d = q.shape
    rows = s // GRID_W
    win_r = min(NA_WIN_ROWS, rows)
    n_chunks = GRID_W // NA_COL_CHUNK
    q_col = np.arange(GRID_W).reshape(n_chunks, NA_COL_CHUNK)
    band_start = np.clip(q_col[:, 0] - NA_WIN_COLS // 2, 0, GRID_W - NA_COL_BAND)
    key_col = band_start[:, None] + np.arange(NA_COL_BAND)
    win_start = np.clip(q_col - NA_WIN_COLS // 2, 0, GRID_W - NA_WIN_COLS)
    col_mask = ((key_col[:, None, :] >= win_start[..., None])
                & (key_col[:, None, :] < win_start[..., None] + NA_WIN_COLS))
    rel_col_idx = np.clip(key_col[:, None, :] - q_col[..., None] + NA_WIN_COLS - 1,
                          0, 2 * NA_WIN_COLS - 2)
    kg = k.reshape(b, rows, GRID_W, h, d)
    vg = v.reshape(b, rows, GRID_W, h, d)
    qg = q.reshape(b, rows, n_chunks, NA_COL_CHUNK, h, d)
    n_ctx = k_ctx.shape[1]

    def row_block(args):
        r, q_row = args
        r0 = jnp.clip(r - win_r // 2, 0, rows - win_r)
        k_band = lax.dynamic_slice_in_dim(kg, r0, win_r, axis=1)
        v_band = lax.dynamic_slice_in_dim(vg, r0, win_r, axis=1)
        k_sub = k_band[:, :, key_col]
        v_sub = v_band[:, :, key_col]
        s_loc = jnp.einsum('bjqhd,bijkhd->bhjqik', q_row, k_sub).astype(jnp.float32) * HEAD_SCALE
        rel_row = r0 + jnp.arange(win_r) - r + NA_WIN_ROWS - 1
        bias = rpb[:, rel_row[None, None, :, None], rel_col_idx[:, :, None, :]]
        s_loc = jnp.where(col_mask[:, :, None, :], s_loc + bias[None].astype(jnp.float32), NEG_INF)
        s_loc = s_loc.reshape(b, h, n_chunks, NA_COL_CHUNK, win_r * NA_COL_BAND)
        s_ctx = jnp.einsum('bjqhd,bkhd->bhjqk', q_row, k_ctx).astype(jnp.float32) * HEAD_SCALE
        p = jax.nn.softmax(jnp.concatenate([s_ctx, s_loc], axis=-1), axis=-1).astype(v.dtype)
        p_ctx = p[..., :n_ctx]
        p_loc = p[..., n_ctx:].reshape(b, h, n_chunks, NA_COL_CHUNK, win_r, NA_COL_BAND)
        return (jnp.einsum('bhjqk,bkhd->bjqhd', p_ctx, v_ctx)
                + jnp.einsum('bhjqik,bijkhd->bjqhd', p_loc, v_sub))

    out = lax.map(row_block, (jnp.arange(rows), jnp.moveaxis(qg, 1, 0)))
    return jnp.moveaxis(out, 0, 1).reshape(b, s, h, d)


def even_mixer(a_lat, a_ctx, w_in, w_out, mla_q_norm, mla_w_uq, mla_kv_norm, mla_w_ukv,
               diff_lambda, diff_subln, lam_init, ang_mla, ang_head, want_ctx):
    lp = diff_lambda.astype(jnp.float32)
    lam = jnp.exp(jnp.sum(lp[0] * lp[1])) - jnp.exp(jnp.sum(lp[2] * lp[3])) + lam_init

    def project(a, rope):
        b, t, _ = a.shape
        cq, ckv, kr, dq, dk, dv = split_cols(a @ w_in, EVEN_SPLITS)
        q = (rms_norm(cq, mla_q_norm) @ mla_w_uq).reshape(b, t, MLA_HEADS, MLA_NOPE + MLA_ROPE)
        kv = (rms_norm(ckv, mla_kv_norm) @ mla_w_ukv).reshape(b, t, MLA_HEADS, MLA_NOPE + MLA_V)
        qn, qr = q[..., :MLA_NOPE], q[..., MLA_NOPE:]
        kn, v = kv[..., :MLA_NOPE], kv[..., MLA_NOPE:]
        dq = dq.reshape(b, t, DIFF_HEADS, 2, DIFF_HD)
        dk = dk.reshape(b, t, DIFF_HEADS, 2, DIFF_HD)
        dv = dv.reshape(b, t, DIFF_HEADS, 2 * DIFF_HD)
        if rope:
            qr, kr = apply_rope(qr, ang_mla), apply_rope(kr, ang_mla)
            dq, dk = apply_rope(dq, ang_head), apply_rope(dk, ang_head)
        return qn, qr, kn, kr, v, dq, dk, dv

    def merge(o_mla, o_diff):
        b, t = o_mla.shape[:2]
        o_diff = rms_norm(o_diff, diff_subln) * (1.0 - lam_init)
        return jnp.concatenate([o_mla.reshape(b, t, -1), o_diff.reshape(b, t, -1)], axis=-1) @ w_out

    qn_c, qr_c, kn_c, kr_c, v_c, dq_c, dk_c, dv_c = project(a_ctx, False)
    qn, qr, kn, kr, v, dq, dk, dv = project(a_lat, True)
    cat = lambda u, w: jnp.concatenate([u, w], axis=1)
    kn_all, kr_all, v_all = cat(kn_c, kn), cat(kr_c, kr), cat(v_c, v)
    dk_all, dv_all = cat(dk_c, dk), cat(dv_c, dv)
    o_lat = merge(sweep_query_blocks(lambda a, b: attend_mla(a, b, kn_all, kr_all, v_all), qn, qr),
                  sweep_query_blocks(lambda a: attend_diff(a, dk_all, dv_all, lam), dq))
    o_ctx = None
    if want_ctx:
        o_ctx = merge(attend_mla(qn_c, qr_c, kn_c, kr_c, v_c), attend_diff(dq_c, dk_c, dv_c, lam))
    return o_lat, o_ctx


def odd_mixer(a_lat, a_ctx, w_in, w_out, gqa_qk_norm, na_rpb, ang_head, want_ctx):
    def project(a, rope):
        b, t, _ = a.shape
        gq, gk, gv, nq, nk, nv = split_cols(a @ w_in, ODD_SPLITS)
        gq = rms_norm(gq.reshape(b, t, GQA_KV_HEADS, GQA_GROUP, GQA_HD), gqa_qk_norm[0])
        gk = rms_norm(gk.reshape(b, t, GQA_KV_HEADS, GQA_HD), gqa_qk_norm[1])
        gv = gv.reshape(b, t, GQA_KV_HEADS, GQA_HD)
        nq = nq.reshape(b, t, NA_HEADS, NA_HD)
        nk = nk.reshape(b, t, NA_HEADS, NA_HD)
        nv = nv.reshape(b, t, NA_HEADS, NA_HD)
        if rope:
            gq, gk = apply_rope(gq, ang_head), apply_rope(gk, ang_head)
        return gq, gk, gv, nq, nk, nv

    def merge(o_gqa, o_na):
        b, t = o_gqa.shape[:2]
        return jnp.concatenate([o_gqa.reshape(b, t, -1), o_na.reshape(b, t, -1)], axis=-1) @ w_out

    gq_c, gk_c, gv_c, nq_c, nk_c, nv_c = project(a_ctx, False)
    gq, gk, gv, nq, nk, nv = project(a_lat, True)
    gk_all = jnp.concatenate([gk_c, gk], axis=1)
    gv_all = jnp.concatenate([gv_c, gv], axis=1)
    o_lat = merge(sweep_query_blocks(lambda a: attend_gqa(a, gk_all, gv_all), gq),
                  neighbourhood_attention(nq, nk, nv, nk_c, nv_c, na_rpb))
    o_ctx = None
    if want_ctx:
        o_ctx = merge(attend_gqa(gq_c, gk_c, gv_c), attend_gqa(nq_c[:, :, :, None], nk_c, nv_c))
    return o_lat, o_ctx


def channel_mixer(a, w1, w2):
    return jnp.square(jax.nn.relu(a @ w1)) @ w2


def setup_inputs(seed: int = 0) -> dict:
    key = jax.random.key(seed)
    ks = jax.random.split(key, 22)
    n_even, n_odd = (DEPTH + 1) // 2, DEPTH // 2
    f32 = jnp.float32
    nrm = lambda k, shape: jax.random.normal(k, shape, f32)
    lin = lambda k, shape, fan_in: nrm(k, shape) * fan_in ** -0.5
    gain = lambda k, shape: 1.0 + 0.02 * nrm(k, shape)
    return {
        'x': nrm(ks[0], (BATCH, SEQ, D_MODEL)),
        'c': nrm(ks[1], (BATCH, D_MODEL)),
        'ctx': nrm(ks[2], (BATCH, CTX_LEN, D_MODEL)),
        'c_ctx': nrm(ks[3], (D_MODEL,)),
        'w_ada': lin(ks[4], (DEPTH, D_MODEL, 6 * D_MODEL), D_MODEL),
        'b_ada': 0.01 * nrm(ks[5], (DEPTH, 6 * D_MODEL)),
        'norm_g': gain(ks[6], (DEPTH, 4, D_MODEL)),
        'w_ff1': lin(ks[7], (DEPTH, D_MODEL, D_FF), D_MODEL),
        'w_ff2': lin(ks[8], (DEPTH, D_FF, D_MODEL), D_FF),
        'w_in_even': lin(ks[9], (n_even, D_MODEL, EVEN_IN), D_MODEL),
        'w_out_even': lin(ks[10], (n_even, EVEN_MIX, D_MODEL), EVEN_MIX),
        'mla_q_norm': gain(ks[11], (n_even, MLA_Q_RANK)),
        'mla_w_uq': lin(ks[12], (n_even, MLA_Q_RANK, MLA_HEADS * (MLA_NOPE + MLA_ROPE)), MLA_Q_RANK),
        'mla_kv_norm': gain(ks[13], (n_even, MLA_KV_RANK)),
        'mla_w_ukv': lin(ks[14], (n_even, MLA_KV_RANK, MLA_HEADS * (MLA_NOPE + MLA_V)), MLA_KV_RANK),
        'diff_lambda': 0.1 * nrm(ks[15], (n_even, 4, DIFF_HD)),
        'diff_subln': gain(ks[16], (n_even, 2 * DIFF_HD)),
        'w_in_odd': lin(ks[17], (n_odd, D_MODEL, ODD_IN), D_MODEL),
        'w_out_odd': lin(ks[18], (n_odd, ODD_MIX, D_MODEL), ODD_MIX),
        'gqa_qk_norm': gain(ks[19], (n_odd, 2, GQA_HD)),
        'na_rpb': 0.1 * nrm(ks[20], (n_odd, NA_HEADS, 2 * NA_WIN_ROWS - 1, 2 * NA_WIN_COLS - 1)),
    }


def reference(x, c, ctx, c_ctx, w_ada, b_ada, norm_g, w_ff1, w_ff2,
              w_in_even, w_out_even, mla_q_norm, mla_w_uq, mla_kv_norm, mla_w_ukv,
              diff_lambda, diff_subln, w_in_odd, w_out_odd, gqa_qk_norm, na_rpb):
    seq = x.shape[1]
    ang_mla = axial_angles(seq, MLA_ROPE)
    ang_head = axial_angles(seq, GQA_HD)
    silu_c, silu_cc = jax.nn.silu(c), jax.nn.silu(c_ctx)
    h, hc = x, ctx
    for layer in range(DEPTH):
        want_ctx = layer < DEPTH - 1
        mod = jnp.split((silu_c @ w_ada[layer] + b_ada[layer])[:, None, :], 6, axis=-1)
        mod_c = jnp.split(silu_cc @ w_ada[layer] + b_ada[layer], 6, axis=-1)
        g = norm_g[layer]
        a_lat = modulate(rms_norm(h, g[0]), mod[0], mod[1])
        a_ctx = modulate(rms_norm(hc, g[0]), mod_c[0], mod_c[1])
        i = layer // 2
        if layer % 2 == 0:
            lam_init = 0.8 - 0.6 * math.exp(-0.3 * layer)
            o_lat, o_ctx = even_mixer(a_lat, a_ctx, w_in_even[i], w_out_even[i], mla_q_norm[i], mla_w_uq[i],
                                      mla_kv_norm[i], mla_w_ukv[i], diff_lambda[i], diff_subln[i],
                                      lam_init, ang_mla, ang_head, want_ctx)
        else:
            o_lat, o_ctx = odd_mixer(a_lat, a_ctx, w_in_odd[i], w_out_odd[i], gqa_qk_norm[i], na_rpb[i],
                                     ang_head, want_ctx)
        h = h + mod[2] * rms_norm(o_lat, g[1])
        f = channel_mixer(modulate(rms_norm(h, g[2]), mod[3], mod[4]), w_ff1[layer], w_ff2[layer])
        h = h + mod[5] * rms_norm(f, g[3])
        if want_ctx:
            hc = hc + mod_c[2] * rms_norm(o_ctx, g[1])
            fc = channel_mixer(modulate(rms_norm(hc, g[2]), mod_c[3], mod_c[4]), w_ff1[layer], w_ff2[layer])
            hc = hc + mod_c[5] * rms_norm(fc, g[3])
    return h
```

```cpp
#include <hip/hip_runtime.h>
#include <hip/hip_cooperative_groups.h>
#include <cstdio>
#include <cstdint>
namespace cg = cooperative_groups;
namespace pg8 {
#define PG8_LAS __attribute__((address_space(3)))
typedef unsigned short bf16_t;
typedef short bf16x8 __attribute__((ext_vector_type(8)));
typedef float f32x4 __attribute__((ext_vector_type(4)));
typedef unsigned u32x4 __attribute__((ext_vector_type(4)));
constexpr int BM = 256, BK = 64, HALF = 128, HTB = HALF * BK * 2  , STAGE_BYTES = 8 * HTB, NXCD = 8, WGM = 8;

__host__ __device__ __forceinline__ int lds_byte(int r, int c) { const int st = (r >> 4) * 2 + (c >> 5), rr = r & 15, cc = c & 31, ob = rr * 64 + cc * 2; return st * 1024 + (ob ^ (((ob >> 9) & 1) << 5)); }
__host__ __device__ __forceinline__ void stage_rc(int b, int& R, int& C) { const int st = b / 1024, sb = b % 1024, swz = sb ^ (((sb >> 9) & 1) << 5); R = (st >> 1) * 16 + swz / 64; C = (st & 1) * 32 + (swz % 64) / 2; }
__host__ __device__ __forceinline__ int perm32(int rho) { const int n = rho >> 4, i = rho & 15; return 8 * (i >> 2) + 4 * n + (i & 3); }

struct Unit { int pm, pn; };
struct Gemm { const bf16_t* A; const bf16_t* Bt; int M, N, K, lda; };

struct StaticOrder {
    int nM, nN, nwg, G, c;
    __host__ __device__ void init(int M, int N, int G_, int c_) { nM = M / BM; nN = N / BM; nwg = nM * nN; G = G_; c = c_; }
    __host__ __device__ bool next(int i, Unit& u) const {
        const long L = (long)i * G + c; if (L >= nwg) return false;
        int wgid = (int)L; { const int q = nwg / NXCD, r = nwg % NXCD, xcd = wgid % NXCD, off = wgid / NXCD; wgid = (xcd < r ? xcd * (q + 1) : r * (q + 1) + (xcd - r) * q) + off; }
        const int nig = WGM * nN, gid = wgid / nig, fm = gid * WGM, gsz = (nM - fm) < WGM ? (nM - fm) : WGM;
        u.pm = fm + ((wgid % nig) % gsz); u.pn = (wgid % nig) / gsz; return true;
    }
    __device__ __forceinline__ void a_ready(const Unit&) const {}
    __device__ __forceinline__ void done(const Unit&) const {}
};

__device__ __forceinline__ unsigned cvt_pk_bf16(float lo, float hi) { unsigned r; asm volatile("v_cvt_pk_bf16_f32 %0, %1, %2" : "=v"(r) : "v"(lo), "v"(hi)); return r; }
template <class Epi, class Sched, bool ALIGN_EPI = false, bool SP2 = false>
__device__ __forceinline__ void gemm_phase(PG8_LAS unsigned char* lds, const Gemm g, const Sched& S, const Epi& E) {
    int tid_ = threadIdx.x; asm volatile("" : "+v"(tid_));
    const int tid = tid_, wid = __builtin_amdgcn_readfirstlane(tid >> 6), lane = tid & 63, wr = wid >> 2, wc = wid & 3, fr = lane & 15, fq = lane >> 4;
    const int K = g.K, nt = K / BK;
    unsigned voffA[2], voffB[2];
#pragma unroll
    for (int i = 0; i < 2; ++i) { int R, C; stage_rc(tid * 16 + i * 8192, R, C); const int Rb = Epi::PERM ? ((R & ~31) + perm32(R & 31)) : R;
        voffA[i] = (unsigned)(R * g.lda + C) * 2u; voffB[i] = (unsigned)(Rb * K + C) * 2u; }
    const size_t kstep = (size_t)(BK * 2);
    const size_t hstep = (size_t)HALF * K * 2, hstepA = (size_t)HALF * g.lda * 2;
    const size_t tstep = 2 * hstep, tstepA = 2 * hstepA;
    const unsigned ldsw = (unsigned)wid * 1024u;
    const int aoff = lds_byte(wr * 64 + fr, fq * 8), boff = lds_byte(wc * 32 + fr, fq * 8);
#define PG8_SA(b, h) (((b) * 2 + (h)) * HTB)
#define PG8_SB(b, h) ((4 + (b) * 2 + (h)) * HTB)
#define PG8_STAGE(bufoff, gbase, voff) do { _Pragma("unroll") for (int _i = 0; _i < 2; ++_i) \
        __builtin_amdgcn_global_load_lds((const unsigned*)((const char*)(gbase) + (voff)[_i]), (PG8_LAS unsigned*)(lds + (bufoff) + ldsw + _i * 8192), 16, 0, 0); } while (0)
#define PG8_LDA(dst, b, h) do { _Pragma("unroll") for (int m = 0; m < 4; ++m) _Pragma("unroll") for (int k = 0; k < 2; ++k) dst[m][k] = *(const PG8_LAS bf16x8*)(lds + PG8_SA(b, h) + aoff + m * 2048 + k * 1024); } while (0)
#define PG8_LDB(dst, b, h) do { _Pragma("unroll") for (int n = 0; n < 2; ++n) _Pragma("unroll") for (int k = 0; k < 2; ++k) dst[n][k] = *(const PG8_LAS bf16x8*)(lds + PG8_SB(b, h) + boff + n * 2048 + k * 1024); } while (0)
#define PG8_MMA(ai, bj, At, Bt) do { __builtin_amdgcn_s_setprio(1); _Pragma("unroll") for (int m = 0; m < 4; ++m) _Pragma("unroll") for (int n = 0; n < 2; ++n) _Pragma("unroll") for (int k = 0; k < 2; ++k) \
        acc[ai][bj][m][n] = __builtin_amdgcn_mfma_f32_16x16x32_bf16(Bt[n][k], At[m][k], acc[ai][bj][m][n], 0, 0, 0); __builtin_amdgcn_s_setprio(0); } while (0)
#define PG8_WAIT_V(n) asm volatile("s_waitcnt vmcnt(" #n ")" ::: "memory")
#define PG8_WAIT_L(n) asm volatile("s_waitcnt lgkmcnt(" #n ")" ::: "memory")
#define PG8_BAR __builtin_amdgcn_s_barrier()
#define PG8_SCHED __builtin_amdgcn_sched_barrier(0)
    Unit cur, nxt; int ui = 0;
    if (!S.next(0, cur)) return;
    f32x4 acc[2][2][4][2];
#pragma unroll
    for (int a = 0; a < 2; ++a)
#pragma unroll
        for (int b = 0; b < 2; ++b)
#pragma unroll
            for (int m = 0; m < 4; ++m)
#pragma unroll
                for (int n = 0; n < 2; ++n) acc[a][b][m][n] = (f32x4){0.f, 0.f, 0.f, 0.f};
    bf16x8 At[4][2], B0[2][2], B1[2][2];
    const char* cA = (const char*)g.A + (size_t)cur.pm * tstepA; const char* cB = (const char*)g.Bt + (size_t)cur.pn * tstep;
    S.a_ready(cur);
    if constexpr (SP2) {
        PG8_STAGE(PG8_SB(0, 0), cB, voffB); PG8_STAGE(PG8_SB(0, 1), cB + hstep, voffB); PG8_STAGE(PG8_SA(0, 0), cA, voffA); PG8_STAGE(PG8_SA(0, 1), cA + hstepA, voffA);
        if (wr == 1) PG8_BAR;
        PG8_WAIT_V(2); PG8_BAR;
        PG8_STAGE(PG8_SB(1, 0), cB + kstep, voffB); PG8_STAGE(PG8_SA(1, 0), cA + kstep, voffA); PG8_STAGE(PG8_SB(1, 1), cB + hstep + kstep, voffB);
        PG8_WAIT_V(6); PG8_BAR;
    } else {
        PG8_STAGE(PG8_SB(0, 0), cB, voffB); PG8_STAGE(PG8_SA(0, 0), cA, voffA); PG8_STAGE(PG8_SB(0, 1), cB + hstep, voffB); PG8_STAGE(PG8_SA(0, 1), cA + hstepA, voffA);
        if (wr == 1) PG8_BAR;
        PG8_WAIT_V(4); PG8_BAR;
        PG8_STAGE(PG8_SB(1, 0), cB + kstep, voffB); PG8_STAGE(PG8_SA(1, 0), cA + kstep, voffA); PG8_STAGE(PG8_SB(1, 1), cB + hstep + kstep, voffB);
        PG8_WAIT_V(6); PG8_BAR;
    }
    for (;;) {
        const bool has_next = S.next(ui + 1, nxt);
        const char* nA = has_next ? (const char*)g.A + (size_t)nxt.pm * tstepA : cA; const char* nB = has_next ? (const char*)g.Bt + (size_t)nxt.pn * tstep : cB;
        for (int t = 0; t < nt; t += 2) {
            const bool last = (t == nt - 2);
            const char* a1 = cA + (size_t)(t + 1) * kstep;
            const char* a2 = last ? nA : cA + (size_t)(t + 2) * kstep; const char* b2 = last ? nB : cB + (size_t)(t + 2) * kstep;
            const char* a3 = a2 + kstep; const char* b3 = b2 + kstep;
            if (last && has_next) S.a_ready(nxt);
            if constexpr (SP2) {
            PG8_LDB(B0, 0, 0); PG8_LDB(B1, 0, 1); PG8_SCHED; PG8_LDA(At, 0, 0); PG8_STAGE(PG8_SA(1, 1), a1 + hstepA, voffA);
            PG8_WAIT_V(8); PG8_WAIT_L(0); PG8_BAR; PG8_MMA(0, 0, At, B0); PG8_MMA(0, 1, At, B1); PG8_BAR; PG8_SCHED;
            PG8_LDA(At, 0, 1); PG8_STAGE(PG8_SB(0, 0), b2, voffB); PG8_STAGE(PG8_SB(0, 1), b2 + hstep, voffB); PG8_STAGE(PG8_SA(0, 0), a2, voffA);
            PG8_WAIT_V(8); PG8_WAIT_L(0); PG8_BAR; PG8_MMA(1, 0, At, B0); PG8_MMA(1, 1, At, B1); PG8_BAR; PG8_SCHED;
            PG8_LDB(B0, 1, 0); PG8_LDB(B1, 1, 1); PG8_SCHED; PG8_LDA(At, 1, 0); PG8_STAGE(PG8_SA(0, 1), a2 + hstepA, voffA);
            PG8_WAIT_V(8); PG8_WAIT_L(0); PG8_BAR; PG8_MMA(0, 0, At, B0); PG8_MMA(0, 1, At, B1); PG8_BAR; PG8_SCHED;
            PG8_LDA(At, 1, 1); PG8_STAGE(PG8_SB(1, 0), b3, voffB); PG8_STAGE(PG8_SB(1, 1), b3 + hstep, voffB); PG8_STAGE(PG8_SA(1, 0), a3, voffA);
            PG8_WAIT_V(8); PG8_WAIT_L(0); PG8_BAR; PG8_MMA(1, 0, At, B0); PG8_MMA(1, 1, At, B1); PG8_BAR; PG8_SCHED;
            } else {
            PG8_LDB(B0, 0, 0); PG8_SCHED; PG8_LDA(At, 0, 0); PG8_STAGE(PG8_SA(1, 1), a1 + hstepA, voffA);
            PG8_WAIT_L(8); PG8_BAR; PG8_WAIT_L(0); PG8_MMA(0, 0, At, B0); PG8_BAR; PG8_SCHED;
            PG8_LDB(B1, 0, 1); PG8_STAGE(PG8_SB(0, 0), b2, voffB);
            PG8_BAR; PG8_WAIT_L(0); PG8_MMA(0, 1, At, B1); PG8_BAR;
            PG8_LDA(At, 0, 1); PG8_STAGE(PG8_SA(0, 0), a2, voffA);
            PG8_BAR; PG8_WAIT_L(0); PG8_MMA(1, 0, At, B0); PG8_BAR; PG8_SCHED;
            PG8_STAGE(PG8_SB(0, 1), b2 + hstep, voffB);
            PG8_WAIT_V(6); PG8_BAR; PG8_MMA(1, 1, At, B1); PG8_BAR;
            PG8_LDB(B0, 1, 0); PG8_SCHED; PG8_LDA(At, 1, 0); PG8_STAGE(PG8_SA(0, 1), a2 + hstepA, voffA);
            PG8_WAIT_L(8); PG8_BAR; PG8_WAIT_L(0); PG8_MMA(0, 0, At, B0); PG8_BAR; PG8_SCHED;
            PG8_LDB(B1, 1, 1); PG8_STAGE(PG8_SB(1, 0), b3, voffB);
            PG8_BAR; PG8_WAIT_L(0); PG8_MMA(0, 1, At, B1); PG8_BAR;
            PG8_LDA(At, 1, 1); PG8_STAGE(PG8_SA(1, 0), a3, voffA);
            PG8_BAR; PG8_WAIT_L(0); PG8_MMA(1, 0, At, B0); PG8_BAR; PG8_SCHED;
            PG8_STAGE(PG8_SB(1, 1), b3 + hstep, voffB);
            PG8_WAIT_V(6); PG8_BAR; PG8_MMA(1, 1, At, B1); PG8_BAR;
            }
        }
        if constexpr (ALIGN_EPI) { if (wr == 0) PG8_BAR; }
        if constexpr (!Epi::AFTER_DRAIN) { E(acc, cur, wr, wc, fr, fq); S.done(cur); }
        if (!has_next) break;
#pragma unroll
        for (int a = 0; a < 2; ++a)
#pragma unroll
            for (int b = 0; b < 2; ++b)
#pragma unroll
                for (int m = 0; m < 4; ++m)
#pragma unroll
                    for (int n = 0; n < 2; ++n) acc[a][b][m][n] = (f32x4){0.f, 0.f, 0.f, 0.f};
        cur = nxt; cA = nA; cB = nB; ++ui;
        if constexpr (ALIGN_EPI) { if (wr == 1) PG8_BAR; }
    }
    PG8_WAIT_V(0);
    if constexpr (!ALIGN_EPI) { if (wr == 0) PG8_BAR; }
    PG8_BAR;
    if constexpr (Epi::AFTER_DRAIN) { E.fused(acc, cur, wr, wc, fr, fq, lds, wid, lane); S.done(cur); }
#undef PG8_SA
#undef PG8_SB
#undef PG8_STAGE
#undef PG8_LDA
#undef PG8_LDB
#undef PG8_MMA
#undef PG8_WAIT_V
#undef PG8_WAIT_L
#undef PG8_BAR
#undef PG8_SCHED
}
}
namespace pg8 {
struct EpiStore {
    static constexpr bool PERM = true, AFTER_DRAIN = false;
    bf16_t* O; int ldc; int act;
    __device__ __forceinline__ void operator()(const f32x4 (&acc)[2][2][4][2], const Unit& u, int wr, int wc, int fr, int fq) const {
        const int row0 = u.pm * BM + wr * 64 + fr; const int col0 = u.pn * BM + wc * 32 + 8 * fq;
#pragma unroll
        for (int ai = 0; ai < 2; ++ai)
#pragma unroll
            for (int m = 0; m < 4; ++m) { bf16_t* rowp = O + (size_t)(row0 + ai * HALF + m * 16) * ldc + col0;
#pragma unroll
                for (int bj = 0; bj < 2; ++bj) { f32x4 v0 = acc[ai][bj][m][0], v1 = acc[ai][bj][m][1];
                    if (act == 1) {
#pragma unroll
                        for (int e = 0; e < 4; ++e) { float a = fmaxf(v0[e], 0.f), b = fmaxf(v1[e], 0.f); v0[e] = a * a; v1[e] = b * b; } }
                    u32x4 w; w.x = cvt_pk_bf16(v0[0], v0[1]); w.y = cvt_pk_bf16(v0[2], v0[3]); w.z = cvt_pk_bf16(v1[0], v1[1]); w.w = cvt_pk_bf16(v1[2], v1[3]);
                    *(u32x4*)(rowp + bj * HALF) = w; } }
    }
};
}
#define LAS __attribute__((address_space(3)))
typedef unsigned short bf16;
typedef short bf16x8 __attribute__((ext_vector_type(8)));
typedef short s16x4 __attribute__((ext_vector_type(4)));
typedef float f32x4 __attribute__((ext_vector_type(4)));
typedef float f32x16 __attribute__((ext_vector_type(16)));
typedef unsigned u32x4 __attribute__((ext_vector_type(4)));
typedef unsigned u32x2 __attribute__((ext_vector_type(2)));

constexpr int DM = 1024, NB = 32, SEQ = 2048, CTXL = 256, RPB = SEQ + CTXL, MROWS = NB * RPB;
constexpr int DFF = 4096, DEPTH = 4, NWAVES = 8, NTHR = 512;
constexpr int PE = 2048, PO = 2304;
constexpr int E_CKV = 256, E_KR = 384, E_DQ = 416, E_DK = 928, E_DV = 1440;
constexpr int O_GK = 512, O_GV = 640, O_NQ = 768, O_NK = 1280, O_NV = 1792;
constexpr float EPSN = 1e-6f, LOG2E = 1.4426950408889634f, LOG2_THETA = 13.287712379549449f;
constexpr float MLA_SC = 0.10206207261596575f  , HD_SC = 0.125f;

constexpr size_t MiB = 1u << 20;
constexpr size_t WS_MOD = 0;
constexpr size_t WS_HC = 4 * MiB;
constexpr size_t WS_WT = 36 * MiB;
constexpr size_t WS_AF = 132 * MiB;
constexpr size_t WS_P = 276 * MiB;
constexpr size_t WS_QM = 600 * MiB;
constexpr size_t WS_KVM = 708 * MiB;
constexpr size_t WS_O = 852 * MiB;
constexpr size_t WS_END = 996 * MiB;
constexpr size_t WS_H = WS_P;
constexpr size_t WL_STRIDE = 24 * MiB, WL_IN = 0, WL_OUT = 5 * MiB, WL_FF1 = 7 * MiB, WL_FF2 = 15 * MiB, WL_UQ = 23 * MiB, WL_UKV = 23 * MiB + 512 * 1024;
static_assert(WS_H + (size_t)MROWS * DFF * 2 <= WS_O, "H overlay");
constexpr int LDS_BYTES = 147456;

struct Args { const float* in[21]; float* out; unsigned char* ws; int ph_lo, ph_hi; };

__device__ __forceinline__ float bf2f(unsigned short b) { return __uint_as_float((unsigned)b << 16); }
typedef float f32x2_t __attribute__((ext_vector_type(2))); typedef __bf16 bf16x2_t __attribute__((ext_vector_type(2)));
__device__ __forceinline__ unsigned pk2(float lo, float hi) { f32x2_t v = {lo, hi}; bf16x2_t b = __builtin_convertvector(v, bf16x2_t); return __builtin_bit_cast(unsigned, b); }
__device__ __forceinline__ unsigned short f2bf(float f) { return (unsigned short)(pk2(f, 0.f) & 0xffffu); }
__device__ __forceinline__ float wave_sum(float v) {
#pragma unroll
    for (int o = 1; o < 64; o <<= 1) v += __shfl_xor(v, o);
    return v;
}
__device__ __forceinline__ float half_sum(float v) {
#pragma unroll
    for (int o = 1; o < 32; o <<= 1) v += __shfl_xor(v, o);
    return v;
}

__device__ __forceinline__ void transpose_item(const float* W, int K, int N, bf16* WT, LAS float* scr, int item, int lane, const float* kscale, float sc) {
    const int nblk = N / 32, kb = item / nblk, nb = item % nblk, k0 = 64 * kb, n0 = 32 * nb;
#pragma unroll 8
    for (int i = 0; i < 32; ++i) { const int kk = 2 * i + (lane >> 5); float w = W[(size_t)(k0 + kk) * N + n0 + (lane & 31)]; w *= (kscale ? kscale[k0 + kk] * sc : sc); scr[kk * 33 + (lane & 31)] = w; }
    asm volatile("s_waitcnt lgkmcnt(0)" ::: "memory");
    const int c = lane & 7;
#pragma unroll
    for (int j = 0; j < 4; ++j) { const int n = (lane >> 3) + 8 * j; const LAS float* s = scr + (8 * c) * 33 + n;
        u32x4 o; o.x = pk2(s[0 * 33], s[1 * 33]); o.y = pk2(s[2 * 33], s[3 * 33]); o.z = pk2(s[4 * 33], s[5 * 33]); o.w = pk2(s[6 * 33], s[7 * 33]);
        *(u32x4*)(WT + (size_t)(n0 + n) * K + k0 + 8 * c) = o; }
    asm volatile("s_waitcnt lgkmcnt(0)" ::: "memory");
}

struct Ctx {
    LAS unsigned char* lds; int tid, lane, wave, vcu, G;
    float* out; unsigned char* ws;
};

__device__ __forceinline__ void phase_prologue_a(const Ctx& F, const Args& args) {
    {
        LAS float* S = (LAS float*)F.lds;
        LAS float* R = (LAS float*)(F.lds + 33 * 512 * 4);
        const float* c = args.in[1]; const float* cc = args.in[3]; const float* wada = args.in[4]; const float* bada = args.in[5];
        float* MOD = (float*)(F.ws + WS_MOD);
        const int cg_ = F.lane & 31, kh = F.lane >> 5;
        for (int it = F.vcu; it < 4 * 192; it += F.G) {
            const int l = it / 192, n0 = (it % 192) * 32;
            float acc[33];
#pragma unroll
            for (int r = 0; r < 33; ++r) acc[r] = 0.f;
            for (int half = 0; half < 2; ++half) {
                __syncthreads();
                for (int e = F.tid; e < 33 * 512; e += NTHR) { const int r = e >> 9, k = (e & 511) + half * 512; const float v = (r < 32) ? c[r * 1024 + k] : cc[k]; S[e] = v / (1.f + __expf(-v)); }
                __syncthreads();
                const int kb = F.wave * 64 + kh * 32;
                const float* wp = wada + ((size_t)l * 1024 + half * 512 + kb) * 6144 + n0 + cg_;
                for (int kk = 0; kk < 32; kk += 4) {
                    const float w0 = wp[(size_t)(kk + 0) * 6144], w1 = wp[(size_t)(kk + 1) * 6144], w2 = wp[(size_t)(kk + 2) * 6144], w3 = wp[(size_t)(kk + 3) * 6144];
#pragma unroll
                    for (int r = 0; r < 33; ++r) { const f32x4 s = *(const LAS f32x4*)(S + r * 512 + kb + kk); acc[r] += s[0] * w0 + s[1] * w1 + s[2] * w2 + s[3] * w3; }
                }
            }
#pragma unroll
            for (int r = 0; r < 33; ++r) { acc[r] += __shfl_xor(acc[r], 32); if (kh == 0) R[(F.wave * 33 + r) * 32 + cg_] = acc[r]; }
            __syncthreads();
            for (int e = F.tid; e < 33 * 32; e += NTHR) { float s = 0.f;
#pragma unroll
                for (int w = 0; w < 8; ++w) s += R[w * 33 * 32 + e];
                const int r = e >> 5, n = n0 + (e & 31); MOD[((size_t)l * 33 + r) * 6144 + n] = s + bada[l * 6144 + n]; }
        }
        __syncthreads();
    }
    {
        LAS float* scr = (LAS float*)(F.lds + F.wave * 16384);
        const int gw = F.vcu * NWAVES + F.wave, NGW = F.G * NWAVES;
        constexpr int I_INE = 16 * 61, I_INO = 16 * 72, I_OUT = 16 * 32, I_FF1 = 16 * 128, I_FF2 = 64 * 32, I_UQ = 4 * 24, I_UKV = 2 * 32, I_Z = 96;
        constexpr int PER_E = I_INE + I_OUT + I_FF1 + I_FF2 + I_UQ + I_UKV + I_Z, PER_O = I_INO + I_OUT + I_FF1 + I_FF2;
        constexpr int NIT = 2 * (PER_E + PER_O);
        for (int it = gw; it < NIT; it += NGW) {
            int pr = it / (PER_E + PER_O), r = it % (PER_E + PER_O);
            const bool odd = r >= PER_E; if (odd) r -= PER_E;
            const int L = 2 * pr + (odd ? 1 : 0);
            unsigned char* wl = F.ws + WS_WT + (size_t)L * WL_STRIDE;
            const float* W; int K, N; size_t wo; const float* ks = nullptr; float sc = 1.f; bool zero = false;
            if (!odd) {
                if (r < I_INE) { W = args.in[9] + (size_t)pr * 1024 * 1952; K = 1024; N = 1952; wo = WL_IN; }
                else if ((r -= I_INE) < I_OUT) { W = args.in[10] + (size_t)pr * 1024 * 1024; K = 1024; N = 1024; wo = WL_OUT; }
                else if ((r -= I_OUT) < I_FF1) { W = args.in[7] + (size_t)L * 1024 * 4096; K = 1024; N = 4096; wo = WL_FF1; }
                else if ((r -= I_FF1) < I_FF2) { W = args.in[8] + (size_t)L * 4096 * 1024; K = 4096; N = 1024; wo = WL_FF2; }
                else if ((r -= I_FF2) < I_UQ) { W = args.in[12] + (size_t)pr * 256 * 768; K = 256; N = 768; wo = WL_UQ; ks = args.in[11] + pr * 256; sc = MLA_SC * LOG2E; }
                else if ((r -= I_UQ) < I_UKV) { W = args.in[14] + (size_t)pr * 128 * 1024; K = 128; N = 1024; wo = WL_UKV; ks = args.in[13] + pr * 128; }
                else { r -= I_UKV; zero = true; W = nullptr; K = 0; N = 0; wo = WL_IN; }
            } else {
                if (r < I_INO) { W = args.in[17] + (size_t)pr * 1024 * 2304; K = 1024; N = 2304; wo = WL_IN; }
                else if ((r -= I_INO) < I_OUT) { W = args.in[18] + (size_t)pr * 1024 * 1024; K = 1024; N = 1024; wo = WL_OUT; }
                else if ((r -= I_OUT) < I_FF1) { W = args.in[7] + (size_t)L * 1024 * 4096; K = 1024; N = 4096; wo = WL_FF1; }
                else { r -= I_FF1; W = args.in[8] + (size_t)L * 4096 * 1024; K = 4096; N = 1024; wo = WL_FF2; }
            }
            if (zero) { bf16* z = (bf16*)(wl + WL_IN) + (size_t)(1952 + r) * 1024; u32x4 zz = {0u, 0u, 0u, 0u}; *(u32x4*)(z + F.lane * 8) = zz; *(u32x4*)(z + 512 + F.lane * 8) = zz; }
            else transpose_item(W, K, N, (bf16*)(wl + wo), scr, r, F.lane, ks, sc);
        }
    }
}

struct RowPassP { const float* hin_lat; const float* hin_ctx; float* hout_lat; float* hout_ctx; bf16* AF; const float* g_post; const float* g_pre;
                  const float* mod_post; const float* mod_pre; int gate_chunk, shift_chunk, scale_chunk; int has_f, write_h, write_a, skip_ctx; };
__device__ __forceinline__ void phase_rowpass(const Ctx& F, const RowPassP p) {
    const int gw = F.vcu * NWAVES + F.wave, NGW = F.G * NWAVES;
    for (int r = gw; r < MROWS; r += NGW) {
        const int b = r / RPB, j = r - b * RPB; const bool isc = j < CTXL;
        if (isc && p.skip_ctx) continue;
        const int mrow = isc ? 32 : b;
        const float* hin = isc ? p.hin_ctx + (size_t)(b * CTXL + j) * DM : p.hin_lat + (size_t)(b * SEQ + j - CTXL) * DM;
        float h[16];
#pragma unroll
        for (int jj = 0; jj < 2; ++jj) { const f32x4 a = *(const f32x4*)(hin + jj * 512 + F.lane * 8), c = *(const f32x4*)(hin + jj * 512 + F.lane * 8 + 4);
#pragma unroll
            for (int e = 0; e < 4; ++e) { h[jj * 8 + e] = a[e]; h[jj * 8 + 4 + e] = c[e]; } }
        bf16* afrow = p.AF + (size_t)r * DM;
        if (p.has_f) {
            float f[16]; float ss = 0.f;
#pragma unroll
            for (int jj = 0; jj < 2; ++jj) { const bf16x8 v = *(const bf16x8*)(afrow + jj * 512 + F.lane * 8);
#pragma unroll
                for (int e = 0; e < 8; ++e) { f[jj * 8 + e] = bf2f((unsigned short)v[e]); ss += f[jj * 8 + e] * f[jj * 8 + e]; } }
            ss = wave_sum(ss); const float rs = rsqrtf(ss * (1.f / DM) + EPSN);
            const float* gate = p.mod_post + (size_t)mrow * 6144 + p.gate_chunk * 1024;
#pragma unroll
            for (int jj = 0; jj < 2; ++jj)
#pragma unroll
                for (int q = 0; q < 2; ++q) { const int c0 = jj * 512 + F.lane * 8 + q * 4; const f32x4 gp = *(const f32x4*)(p.g_post + c0), gt = *(const f32x4*)(gate + c0);
#pragma unroll
                    for (int e = 0; e < 4; ++e) h[jj * 8 + q * 4 + e] += gt[e] * (f[jj * 8 + q * 4 + e] * rs * gp[e]); }
        }
        if (p.write_h) {
            float* hout = isc ? p.hout_ctx + (size_t)(b * CTXL + j) * DM : p.hout_lat + (size_t)(b * SEQ + j - CTXL) * DM;
#pragma unroll
            for (int jj = 0; jj < 2; ++jj) { f32x4 a, c;
#pragma unroll
                for (int e = 0; e < 4; ++e) { a[e] = h[jj * 8 + e]; c[e] = h[jj * 8 + 4 + e]; }
                *(f32x4*)(hout + jj * 512 + F.lane * 8) = a; *(f32x4*)(hout + jj * 512 + F.lane * 8 + 4) = c; }
        }
        if (p.write_a) {
            float ss = 0.f;
#pragma unroll
            for (int e = 0; e < 16; ++e) ss += h[e] * h[e];
            ss = wave_sum(ss); const float rs = rsqrtf(ss * (1.f / DM) + EPSN);
            const float* sh = p.mod_pre + (size_t)mrow * 6144 + p.shift_chunk * 1024; const float* sc = p.mod_pre + (size_t)mrow * 6144 + p.scale_chunk * 1024;
#pragma unroll
            for (int jj = 0; jj < 2; ++jj) { float o[8];
#pragma unroll
                for (int q = 0; q < 2; ++q) { const int c0 = jj * 512 + F.lane * 8 + q * 4; const f32x4 gp = *(const f32x4*)(p.g_pre + c0), s1 = *(const f32x4*)(sh + c0), s2 = *(const f32x4*)(sc + c0);
#pragma unroll
                    for (int e = 0; e < 4; ++e) o[q * 4 + e] = (h[jj * 8 + q * 4 + e] * rs * gp[e]) * (1.f + s2[e]) + s1[e]; }
                u32x4 w; w.x = pk2(o[0], o[1]); w.y = pk2(o[2], o[3]); w.z = pk2(o[4], o[5]); w.w = pk2(o[6], o[7]);
                *(u32x4*)(afrow + jj * 512 + F.lane * 8) = w; }
        }
    }
}

__device__ __forceinline__ void rope_cs(int j, int i, int nfreq, float& cs, float& sn) {
    if (j < CTXL) { cs = 1.f; sn = 0.f; return; }
    const int t = j - CTXL; const int fi = (i < nfreq) ? i : i - nfreq; const float pos = (i < nfreq) ? (float)(t >> 6) : (float)(t & 63);
    const float ang = pos * exp2f(-(float)fi * (LOG2_THETA / (float)nfreq));
    cs = __cosf(ang); sn = __sinf(ang);
}
__device__ __forceinline__ void phase_prep_even(const Ctx& F) {
    bf16* P = (bf16*)(F.ws + WS_P); bf16* CQN = (bf16*)(F.ws + WS_AF); bf16* CKVN = (bf16*)(F.ws + WS_AF + 36 * MiB);
    const int gw = F.vcu * NWAVES + F.wave, NGW = F.G * NWAVES; const int lane = F.lane;
    for (int r = gw; r < MROWS; r += NGW) {
        const int j = r % RPB; bf16* pr = P + (size_t)r * PE;
        {
            const u32x2 v = *(const u32x2*)(pr + 4 * lane); const float a0 = bf2f(v.x & 0xffff), a1 = bf2f(v.x >> 16), a2 = bf2f(v.y & 0xffff), a3 = bf2f(v.y >> 16);
            const float ss = wave_sum(a0 * a0 + a1 * a1 + a2 * a2 + a3 * a3); const float rs = rsqrtf(ss * (1.f / 256.f) + EPSN);
            u32x2 o; o.x = pk2(a0 * rs, a1 * rs); o.y = pk2(a2 * rs, a3 * rs); *(u32x2*)(CQN + (size_t)r * 256 + 4 * lane) = o;
        }
        {
            const unsigned v = *(const unsigned*)(pr + E_CKV + 2 * lane); const float a0 = bf2f(v & 0xffff), a1 = bf2f(v >> 16);
            const float ss = wave_sum(a0 * a0 + a1 * a1); const float rs = rsqrtf(ss * (1.f / 128.f) + EPSN);
            *(unsigned*)(CKVN + (size_t)r * 128 + 2 * lane) = pk2(a0 * rs, a1 * rs);
        }
        if (lane < 16 && j >= CTXL) {
            float cs, sn; rope_cs(j, lane, 8, cs, sn);
            const float x1 = bf2f(pr[E_KR + lane]), x2 = bf2f(pr[E_KR + 16 + lane]);
            pr[E_KR + lane] = f2bf(x1 * cs - x2 * sn); pr[E_KR + 16 + lane] = f2bf(x2 * cs + x1 * sn);
        }
        {
            float cs, sn; rope_cs(j, lane & 31, 16, cs, sn);
#pragma unroll
            for (int jj = 0; jj < 4; ++jj) { const int v = (lane >> 5) + 2 * jj; bf16* q = pr + E_DQ + v * 64 + (lane & 31); bf16* k = pr + E_DK + v * 64 + (lane & 31);
                const float q1 = bf2f(q[0]), q2 = bf2f(q[32]), k1 = bf2f(k[0]), k2 = bf2f(k[32]);
                q[0] = f2bf((q1 * cs - q2 * sn) * (HD_SC * LOG2E)); q[32] = f2bf((q2 * cs + q1 * sn) * (HD_SC * LOG2E));
                if (j >= CTXL) { k[0] = f2bf(k1 * cs - k2 * sn); k[32] = f2bf(k2 * cs + k1 * sn); } }
        }
    }
}
__device__ __forceinline__ void phase_prep_odd(const Ctx& F, const float* qkn  ) {
    bf16* P = (bf16*)(F.ws + WS_P);
    const int gw = F.vcu * NWAVES + F.wave, NGW = F.G * NWAVES; const int lane = F.lane, i = lane & 31;
    const float gq1 = qkn[i], gq2 = qkn[32 + i], gk1 = qkn[64 + i], gk2 = qkn[96 + i];
    for (int r = gw; r < MROWS; r += NGW) {
        const int j = r % RPB; bf16* pr = P + (size_t)r * PO;
        float cs, sn; rope_cs(j, i, 16, cs, sn);
#pragma unroll
        for (int jj = 0; jj < 4; ++jj) { const int hh = (lane >> 5) + 2 * jj; bf16* q = pr + hh * 64 + i;
            const float x1 = bf2f(q[0]), x2 = bf2f(q[32]); const float rs = rsqrtf(half_sum(x1 * x1 + x2 * x2) * (1.f / 64.f) + EPSN);
            const float y1 = x1 * rs * gq1, y2 = x2 * rs * gq2;
            q[0] = f2bf((y1 * cs - y2 * sn) * (HD_SC * LOG2E)); q[32] = f2bf((y2 * cs + y1 * sn) * (HD_SC * LOG2E)); }
        {   const int hh = lane >> 5; bf16* k = pr + O_GK + hh * 64 + i;
            const float x1 = bf2f(k[0]), x2 = bf2f(k[32]); const float rs = rsqrtf(half_sum(x1 * x1 + x2 * x2) * (1.f / 64.f) + EPSN);
            const float y1 = x1 * rs * gk1, y2 = x2 * rs * gk2;
            k[0] = f2bf(y1 * cs - y2 * sn); k[32] = f2bf(y2 * cs + y1 * sn); }
        {   bf16x8 v = *(const bf16x8*)(pr + O_NQ + 8 * lane); float o[8];
#pragma unroll
            for (int e = 0; e < 8; ++e) o[e] = bf2f((unsigned short)v[e]) * (HD_SC * LOG2E);
            u32x4 w; w.x = pk2(o[0], o[1]); w.y = pk2(o[2], o[3]); w.z = pk2(o[4], o[5]); w.w = pk2(o[6], o[7]); *(u32x4*)(pr + O_NQ + 8 * lane) = w; }
    }
}

struct AttnP {
    const bf16* q; int qpitch; const bf16* ka; int kapitch; const bf16* kb; int kbpitch; const bf16* v; int vpitch; bf16* o; int opitch;
    int nA, tB0, nB;
    int rope_t0;
    int mode;
    float lam, post; const float* subln;
    int na_row0;
};
__device__ __forceinline__ int crow(int r, int hi) { return (r & 3) + 8 * (r >> 2) + 4 * hi; }

template <int DQK, int DV, bool NA>
__device__ __forceinline__ void attn_unit(const AttnP& a, LAS unsigned char* lds, const LAS float* biasT, int tid) {
    constexpr int KP = DQK * 2 + 16, KBYTES = 64 * KP, VBYTES = 64 * DV * 2, BUF = KBYTES + VBYTES;
    constexpr int KCH = DQK / 8, NKC = 64 * KCH, VCH = DV / 8, NVC = 64 * VCH, KN = (NKC + NTHR - 1) / NTHR, VN = NVC / NTHR, ND = DQK / 16, NDB = DV / 32;
    const int lane = tid & 63, wave = __builtin_amdgcn_readfirstlane(tid >> 6), r32 = lane & 31, hi = lane >> 5;
    bf16x8 qf[ND];
    { const bf16* qrow = a.q + (size_t)(wave * 32 + r32) * a.qpitch + hi * 8;
#pragma unroll
      for (int d0 = 0; d0 < ND; ++d0) qf[d0] = *(const bf16x8*)(qrow + d0 * 16); }
    if constexpr (DQK == 96) {
        if (a.rope_t0 >= 0) {
            const int t = a.rope_t0 + wave * 32 + r32; const float pos = hi ? (float)(t & 63) : (float)(t >> 6);
#pragma unroll
            for (int e = 0; e < 8; ++e) { const float ang = pos * exp2f(-(float)e * (LOG2_THETA / 8.f)); const float cs = __cosf(ang), sn = __sinf(ang);
                const float x1 = bf2f((unsigned short)qf[4][e]), x2 = bf2f((unsigned short)qf[5][e]);
                qf[4][e] = (short)f2bf(x1 * cs - x2 * sn); qf[5][e] = (short)f2bf(x2 * cs + x1 * sn); }
        }
    }
    const bf16* ksrc[KN]; int kdst[KN]; size_t kstep[KN];
#pragma unroll
    for (int i = 0; i < KN; ++i) { const int c = tid + i * NTHR; const int row = c / KCH, ch = c - row * KCH;
        if (DQK == 96 && ch >= 8) { ksrc[i] = a.kb + (size_t)row * a.kbpitch + (ch - 8) * 8; kstep[i] = (size_t)64 * a.kbpitch; }
        else { ksrc[i] = a.ka + (size_t)row * a.kapitch + ch * 8; kstep[i] = (size_t)64 * a.kapitch; }
        kdst[i] = row * KP + ch * 16; }
    const bf16* vsrc[VN]; int vdst[VN];
#pragma unroll
    for (int i = 0; i < VN; ++i) { const int c = tid + i * NTHR; const int row = c / VCH, ch = c - row * VCH;
        vsrc[i] = a.v + (size_t)row * a.vpitch + ch * 8; vdst[i] = KBYTES + ((row >> 3) * NDB + (ch >> 2)) * 512 + (row & 7) * 64 + (ch & 3) * 16; }
    const size_t vstep = (size_t)64 * a.vpitch;
    const int ntile = a.nA + a.nB;
    u32x4 kreg[KN], vreg[VN];
#define ATT_TILE(i_) ((i_) < a.nA ? (i_) : a.tB0 + ((i_) - a.nA))
#define ATT_LOAD(tt_) do { _Pragma("unroll") for (int i_ = 0; i_ < KN; ++i_) if (KN * NTHR == NKC || tid + i_ * NTHR < NKC) kreg[i_] = *(const u32x4*)(ksrc[i_] + (size_t)(tt_) * kstep[i_]); \
        _Pragma("unroll") for (int i_ = 0; i_ < VN; ++i_) vreg[i_] = *(const u32x4*)(vsrc[i_] + (size_t)(tt_) * vstep); } while (0)
#define ATT_STORE(buf_) do { _Pragma("unroll") for (int i_ = 0; i_ < KN; ++i_) if (KN * NTHR == NKC || tid + i_ * NTHR < NKC) *(LAS u32x4*)(lds + (buf_) * BUF + kdst[i_]) = kreg[i_]; \
        _Pragma("unroll") for (int i_ = 0; i_ < VN; ++i_) *(LAS u32x4*)(lds + (buf_) * BUF + vdst[i_]) = vreg[i_]; } while (0)
    ATT_LOAD(ATT_TILE(0)); ATT_STORE(0);
    __syncthreads();
    float mrun = -1e30f, lrun = 0.f;
    f32x16 o[NDB];
#pragma unroll
    for (int d = 0; d < NDB; ++d) o[d] = f32x16{};
    const int koff = r32 * KP + hi * 16;
    const int voff = KBYTES + (4 * hi + ((lane & 15) >> 2)) * 64 + ((lane >> 4) & 1) * 32 + (lane & 3) * 8;
    int na_rq = 0, na_r0 = 0, na_c = 0, na_ws = 0;
    if constexpr (NA) { na_rq = a.na_row0 + (wave >> 1); na_r0 = min(max(na_rq - 4, 0), 24); na_c = 32 * (wave & 1) + r32; na_ws = min(max(na_c - 8, 0), 48); }
    for (int it = 0; it < ntile; ++it) {
        const int buf = it & 1; const int tt = ATT_TILE(it);
        if (it + 1 < ntile) { const int tn = ATT_TILE(it + 1); ATT_LOAD(tn); }
        bool active = true; int rowoff = 0; bool local = false;
        if constexpr (NA) { if (tt >= 4) { const int kr = tt - 4; local = true; active = (kr >= na_r0) && (kr < na_r0 + 8); rowoff = (kr - na_rq + 7) * 32; } }
        if (active) {
            LAS unsigned char* kb_ = lds + buf * BUF;
            f32x16 p0 = f32x16{}, p1 = f32x16{};
#pragma unroll
            for (int d0 = 0; d0 < ND; ++d0) {
                const bf16x8 k0 = *(const LAS bf16x8*)(kb_ + koff + d0 * 32), k1 = *(const LAS bf16x8*)(kb_ + koff + 32 * KP + d0 * 32);
                p0 = __builtin_amdgcn_mfma_f32_32x32x16_bf16(k0, qf[d0], p0, 0, 0, 0);
                p1 = __builtin_amdgcn_mfma_f32_32x32x16_bf16(k1, qf[d0], p1, 0, 0, 0);
            }
            if constexpr (NA) {
                if (local) {
#pragma unroll
                    for (int r = 0; r < 16; ++r) {
                        const int kc0 = crow(r, hi), kc1 = 32 + kc0;
                        const int i0 = min(max(kc0 - na_c + 15, 0), 30), i1 = min(max(kc1 - na_c + 15, 0), 30);
                        const float b0 = biasT[rowoff + i0], b1 = biasT[rowoff + i1];
                        p0[r] = (kc0 >= na_ws && kc0 < na_ws + 16) ? p0[r] + b0 : -INFINITY;
                        p1[r] = (kc1 >= na_ws && kc1 < na_ws + 16) ? p1[r] + b1 : -INFINITY;
                    }
                }
            }
            float mx = fmaxf(p0[0], p1[0]);
#pragma unroll
            for (int r = 1; r < 16; ++r) mx = fmaxf(mx, fmaxf(p0[r], p1[r]));
            mx = fmaxf(mx, __shfl_xor(mx, 32));
            const float mnew = fmaxf(mrun, mx); const float alpha = exp2f(mrun - mnew); mrun = mnew;
            float rsum = 0.f;
#pragma unroll
            for (int r = 0; r < 16; ++r) { p0[r] = exp2f(p0[r] - mnew); p1[r] = exp2f(p1[r] - mnew); rsum += p0[r] + p1[r]; }
            lrun = lrun * alpha + rsum;
#pragma unroll
            for (int d = 0; d < NDB; ++d)
#pragma unroll
                for (int r = 0; r < 16; ++r) o[d][r] *= alpha;
            bf16x8 pw[4];
#pragma unroll
            for (int ks = 0; ks < 4; ++ks) { u32x4 w;
                if (ks < 2) { const int b = 8 * (ks & 1); w.x = pk2(p0[b], p0[b + 1]); w.y = pk2(p0[b + 2], p0[b + 3]); w.z = pk2(p0[b + 4], p0[b + 5]); w.w = pk2(p0[b + 6], p0[b + 7]); }
                else { const int b = 8 * (ks & 1); w.x = pk2(p1[b], p1[b + 1]); w.y = pk2(p1[b + 2], p1[b + 3]); w.z = pk2(p1[b + 4], p1[b + 5]); w.w = pk2(p1[b + 6], p1[b + 7]); }
                pw[ks] = __builtin_bit_cast(bf16x8, w); }
#pragma unroll
            for (int ks = 0; ks < 4; ++ks)
#pragma unroll
                for (int d = 0; d < NDB; ++d) {
                    const LAS unsigned char* vp = kb_ + voff + ((2 * ks) * NDB + d) * 512;
                    const s16x4 lo = __builtin_bit_cast(s16x4, __builtin_amdgcn_ds_read_tr16_b64_v4i16((LAS s16x4*)vp));
                    const s16x4 h4 = __builtin_bit_cast(s16x4, __builtin_amdgcn_ds_read_tr16_b64_v4i16((LAS s16x4*)(vp + NDB * 512)));
                    const bf16x8 vf = {lo[0], lo[1], lo[2], lo[3], h4[0], h4[1], h4[2], h4[3]};
                    o[d] = __builtin_amdgcn_mfma_f32_32x32x16_bf16(vf, pw[ks], o[d], 0, 0, 0);
                }
        }
        if (it + 1 < ntile) ATT_STORE(buf ^ 1);
        __syncthreads();
    }
#undef ATT_TILE
#undef ATT_LOAD
#undef ATT_STORE
    lrun += __shfl_xor(lrun, 32);
    const float inv = 1.f / lrun;
    bf16* orow = a.o + (size_t)(wave * 32 + r32) * a.opitch + 4 * hi;
    if (a.mode == 2) {
        float ss = 0.f;
#pragma unroll
        for (int d = 0; d < NDB; ++d)
#pragma unroll
            for (int g = 0; g < 4; ++g) { const u32x2 w = *(const u32x2*)(orow + 32 * d + 8 * g);
                const float o1[4] = {bf2f(w.x & 0xffff), bf2f(w.x >> 16), bf2f(w.y & 0xffff), bf2f(w.y >> 16)};
#pragma unroll
                for (int e = 0; e < 4; ++e) { const float dl = o1[e] - a.lam * (o[d][4 * g + e] * inv); o[d][4 * g + e] = dl; ss += dl * dl; } }
        ss += __shfl_xor(ss, 32);
        const float rs = rsqrtf(ss * (1.f / (float)DV) + EPSN) * a.post;
#pragma unroll
        for (int d = 0; d < NDB; ++d)
#pragma unroll
            for (int g = 0; g < 4; ++g) { const f32x4 sl = *(const f32x4*)(a.subln + 32 * d + 8 * g + 4 * hi);
                u32x2 w; w.x = pk2(o[d][4 * g] * rs * sl[0], o[d][4 * g + 1] * rs * sl[1]); w.y = pk2(o[d][4 * g + 2] * rs * sl[2], o[d][4 * g + 3] * rs * sl[3]);
                *(u32x2*)(orow + 32 * d + 8 * g) = w; }
    } else {
#pragma unroll
        for (int d = 0; d < NDB; ++d)
#pragma unroll
            for (int g = 0; g < 4; ++g) { u32x2 w; w.x = pk2(o[d][4 * g] * inv, o[d][4 * g + 1] * inv); w.y = pk2(o[d][4 * g + 2] * inv, o[d][4 * g + 3] * inv);
                *(u32x2*)(orow + 32 * d + 8 * g) = w; }
    }
}

__device__ __forceinline__ void phase_attn_even(const Ctx& F, const Args& args, int L, bool want_ctx) {
    const bf16* P = (const bf16*)(F.ws + WS_P); const bf16* QM = (const bf16*)(F.ws + WS_QM); const bf16* KVM = (const bf16*)(F.ws + WS_KVM); bf16* O = (bf16*)(F.ws + WS_O);
    const int pr = L >> 1;
    const float lam_init = (L == 0) ? 0.2f : 0.47071302f;
    float lam;
    { const float* lp = args.in[15] + pr * 256; const float sa = wave_sum(lp[F.lane] * lp[64 + F.lane]), sb = wave_sum(lp[128 + F.lane] * lp[192 + F.lane]); lam = __expf(sa) - __expf(sb) + lam_init; }
    const float* subln = args.in[16] + pr * 128;
    const int n0 = 1024, n1 = 2048, n2 = want_ctx ? 128 : 0, n3 = want_ctx ? 256 : 0, ntot = n0 + n1 + n2 + n3;
    for (int u = F.vcu; u < ntot; u += F.G) {
        AttnP a; a.kb = nullptr; a.kbpitch = 0; a.tB0 = 0; a.nB = 0; a.rope_t0 = -1; a.mode = 0; a.lam = lam; a.post = 1.f - lam_init; a.subln = subln; a.na_row0 = 0;
        int cls, uu = u;
        if (uu < n0) cls = 0; else if ((uu -= n0) < n1) cls = 1; else if ((uu -= n1) < n2) cls = 2; else { uu -= n2; cls = 3; }
        if (cls == 0 || cls == 2) {
            int b, h, row0;
            if (cls == 0) { const int bh = uu >> 3, qb = uu & 7; b = bh >> 2; h = bh & 3; row0 = b * RPB + CTXL + 256 * qb; a.nA = 36; }
            else { b = uu >> 2; h = uu & 3; row0 = b * RPB; a.nA = 4; }
            const size_t base = (size_t)b * RPB;
            a.qpitch = PE; a.kapitch = PE; a.vpitch = PE; a.opitch = DM;
            a.v = P + base * PE + E_DV + h * 128; a.o = O + (size_t)row0 * DM + 512 + h * 128;
            for (int m = 0; m < 2; ++m) {
                a.q = P + (size_t)row0 * PE + E_DQ + h * 128 + m * 64; a.ka = P + base * PE + E_DK + h * 128 + m * 64; a.mode = 1 + m;
                attn_unit<64, 128, false>(a, F.lds, nullptr, F.tid);
            }
        } else {
            int b, h, row0;
            if (cls == 1) { const int bh = uu >> 3, qb = uu & 7; b = bh >> 3; h = bh & 7; row0 = b * RPB + CTXL + 256 * qb; a.nA = 36; a.rope_t0 = 256 * qb; }
            else { b = uu >> 3; h = uu & 7; row0 = b * RPB; a.nA = 4; }
            const size_t base = (size_t)b * RPB;
            a.q = QM + (size_t)row0 * 768 + h * 96; a.qpitch = 768; a.ka = KVM + base * 1024 + h * 128; a.kapitch = 1024; a.kb = P + base * PE + E_KR; a.kbpitch = PE;
            a.v = KVM + base * 1024 + h * 128 + 64; a.vpitch = 1024; a.o = O + (size_t)row0 * DM + h * 64; a.opitch = DM;
            attn_unit<96, 64, false>(a, F.lds, nullptr, F.tid);
        }
    }
}
__device__ __forceinline__ void phase_attn_odd(const Ctx& F, const Args& args, int L, bool want_ctx) {
    const bf16* P = (const bf16*)(F.ws + WS_P); bf16* O = (bf16*)(F.ws + WS_O);
    const int pr = L >> 1;
    const float* rpb = args.in[20] + (size_t)pr * 8 * 15 * 31;
    LAS float* biasT = (LAS float*)(F.lds + 65536);
    const int n0 = 2048, n1 = 2048, n2 = want_ctx ? 256 : 0, n3 = want_ctx ? 256 : 0, ntot = n0 + n1 + n2 + n3;
    for (int u = F.vcu; u < ntot; u += F.G) {
        AttnP a; a.kb = nullptr; a.kbpitch = 0; a.tB0 = 0; a.nB = 0; a.rope_t0 = -1; a.mode = 0; a.lam = 0.f; a.post = 1.f; a.subln = nullptr; a.na_row0 = 0;
        a.qpitch = PO; a.kapitch = PO; a.vpitch = PO; a.opitch = DM;
        int cls, uu = u;
        if (uu < n0) cls = 0; else if ((uu -= n0) < n1) cls = 1; else if ((uu -= n1) < n2) cls = 2; else { uu -= n2; cls = 3; }
        int b, h, row0, qb = 0;
        if (cls < 2) { const int bh = uu >> 3; qb = uu & 7; b = bh >> 3; h = bh & 7; row0 = b * RPB + CTXL + 256 * qb; }
        else { b = uu >> 3; h = uu & 7; row0 = b * RPB; }
        const size_t base = (size_t)b * RPB;
        if (cls == 0 || cls == 2) {
            a.q = P + (size_t)row0 * PO + h * 64; a.ka = P + base * PO + O_GK + (h >> 2) * 64; a.v = P + base * PO + O_GV + (h >> 2) * 64; a.o = O + (size_t)row0 * DM + h * 64;
            a.nA = (cls == 0) ? 36 : 4;
            attn_unit<64, 64, false>(a, F.lds, nullptr, F.tid);
        } else {
            a.q = P + (size_t)row0 * PO + O_NQ + h * 64; a.ka = P + base * PO + O_NK + h * 64; a.v = P + base * PO + O_NV + h * 64; a.o = O + (size_t)row0 * DM + 512 + h * 64;
            a.nA = 4;
            if (cls == 1) {
                const int rlo = 4 * qb, rmin = min(max(rlo - 4, 0), 24), rmax = min(max(rlo + 3 - 4, 0), 24) + 7;
                a.tB0 = 4 + rmin; a.nB = rmax - rmin + 1; a.na_row0 = rlo;
                for (int e = F.tid; e < 15 * 32; e += NTHR) { const int rr = e >> 5, cc = e & 31; biasT[e] = (cc < 31) ? rpb[(h * 15 + rr) * 31 + cc] * LOG2E : 0.f; }
                attn_unit<64, 64, true>(a, F.lds, biasT, F.tid);
            } else {
                attn_unit<64, 64, false>(a, F.lds, nullptr, F.tid);
            }
        }
    }
}

constexpr int N_PHASES = 2 + 9 * DEPTH;
#ifndef EN_PRO
#define EN_PRO 1
#endif
#ifndef EN_ROW
#define EN_ROW 1
#endif
#ifndef EN_PREP
#define EN_PREP 1
#endif
#ifndef EN_AE
#define EN_AE 1
#endif
#ifndef EN_AO
#define EN_AO 1
#endif
#ifndef EN_GEMM
#define EN_GEMM 1
#endif
__global__ void __launch_bounds__(NTHR, 2) fwd_kernel(Args args) {
    extern __shared__ __attribute__((aligned(16))) unsigned char lds_raw[];
    cg::grid_group grid = cg::this_grid();
    Ctx F;
    F.lds = (LAS unsigned char*)lds_raw;
    F.G = gridDim.x; { const int bx = blockIdx.x; F.vcu = (F.G % 8 == 0) ? (bx % 8) * (F.G / 8) + bx / 8 : bx; }
    F.out = args.out; F.ws = args.ws;
    const int lo = args.ph_lo, hi = args.ph_hi;
    for (int ph = lo; ph < hi; ++ph) {
        { int t_ = threadIdx.x; asm volatile("" : "+v"(t_)); F.tid = t_; F.lane = t_ & 63; F.wave = __builtin_amdgcn_readfirstlane(t_ >> 6); }
        float* MOD = (float*)(F.ws + WS_MOD); float* HC = (float*)(F.ws + WS_HC); bf16* AF = (bf16*)(F.ws + WS_AF);
        const float* normg = args.in[6];
        const int L = (ph < 2) ? 0 : (ph - 2) / 9, k = (ph < 2) ? -1 : (ph - 2) % 9;
        const bool even = (L & 1) == 0, want_ctx = L < DEPTH - 1;
        unsigned char* wl = F.ws + WS_WT + (size_t)L * WL_STRIDE;
        if (ph == 0) { if (EN_PRO) phase_prologue_a(F, args); }
        else if (ph == 1 || k == 5 || k == 8) {
            const float* modL = MOD + (size_t)L * 33 * 6144;
            RowPassP p;
            p.AF = AF; p.hout_lat = F.out; p.hout_ctx = HC;
            if (ph == 1) { p.hin_lat = args.in[0]; p.hin_ctx = args.in[2]; p.g_post = normg; p.g_pre = normg; p.mod_post = MOD; p.mod_pre = MOD;
                p.gate_chunk = 0; p.shift_chunk = 0; p.scale_chunk = 1; p.has_f = 0; p.write_h = 0; p.write_a = 1; p.skip_ctx = 0; }
            else if (k == 5) { p.hin_lat = (L == 0) ? args.in[0] : F.out; p.hin_ctx = (L == 0) ? args.in[2] : HC; p.g_post = normg + (L * 4 + 1) * DM; p.g_pre = normg + (L * 4 + 2) * DM;
                p.mod_post = modL; p.mod_pre = modL; p.gate_chunk = 2; p.shift_chunk = 3; p.scale_chunk = 4; p.has_f = 1; p.write_h = 1; p.write_a = 1; p.skip_ctx = 0; }
            else { const int Ln = (L + 1 < DEPTH) ? L + 1 : L;
                p.hin_lat = F.out; p.hin_ctx = HC; p.g_post = normg + (L * 4 + 3) * DM; p.g_pre = normg + (Ln * 4 + 0) * DM; p.mod_post = modL; p.mod_pre = MOD + (size_t)Ln * 33 * 6144;
                p.gate_chunk = 5; p.shift_chunk = 0; p.scale_chunk = 1; p.has_f = 1; p.write_h = 1; p.write_a = want_ctx ? 1 : 0; p.skip_ctx = want_ctx ? 0 : 1; }
            if (EN_ROW) phase_rowpass(F, p);
        }
        else if (k == 1) { if (EN_PREP) { if (even) phase_prep_even(F); else phase_prep_odd(F, args.in[19] + (L >> 1) * 128); } }
        else if (k == 3) { if (even) { if (EN_AE) phase_attn_even(F, args, L, want_ctx); } else { if (EN_AO) phase_attn_odd(F, args, L, want_ctx); } }
        else {
            const int ng = (k == 2) ? (even ? 2 : 0) : 1;
            for (int gi = 0; gi < ng; ++gi) {
                pg8::Gemm g; pg8::EpiStore E; E.act = 0;
                g.M = MROWS;
                if (k == 0) { g.A = AF; g.Bt = (const bf16*)(wl + WL_IN); g.N = even ? PE : PO; g.K = DM; g.lda = DM; E.O = (bf16*)(F.ws + WS_P); E.ldc = g.N; }
                else if (k == 2) {
                    if (gi == 0) { g.A = AF; g.Bt = (const bf16*)(wl + WL_UQ); g.N = 768; g.K = 256; g.lda = 256; E.O = (bf16*)(F.ws + WS_QM); E.ldc = 768; }
                    else { g.A = (const bf16*)(F.ws + WS_AF + 36 * MiB); g.Bt = (const bf16*)(wl + WL_UKV); g.N = 1024; g.K = 128; g.lda = 128; E.O = (bf16*)(F.ws + WS_KVM); E.ldc = 1024; } }
                else if (k == 4) { g.A = (const bf16*)(F.ws + WS_O); g.Bt = (const bf16*)(wl + WL_OUT); g.N = DM; g.K = DM; g.lda = DM; E.O = AF; E.ldc = DM; }
                else if (k == 6) { g.A = AF; g.Bt = (const bf16*)(wl + WL_FF1); g.N = DFF; g.K = DM; g.lda = DM; E.O = (bf16*)(F.ws + WS_H); E.ldc = DFF; E.act = 1; }
                else { g.A = (const bf16*)(F.ws + WS_H); g.Bt = (const bf16*)(wl + WL_FF2); g.N = DM; g.K = DFF; g.lda = DFF; E.O = AF; E.ldc = DM; }
                pg8::StaticOrder S; S.init(MROWS, g.N, F.G, (int)blockIdx.x);
                if (EN_GEMM) pg8::gemm_phase<pg8::EpiStore, pg8::StaticOrder, true, true>(F.lds, g, S, E);
            }
        }
        if (ph + 1 < hi) grid.sync();
    }
}

#ifndef SINGLE_LAUNCH
#define SINGLE_LAUNCH 1
#endif
extern "C" void kernel_launch(void* const* d_in, const int* in_sizes, int n_in, void* d_out, int out_size, void* d_ws, size_t ws_size, hipStream_t stream) {
    static int grid = 0;
    if (grid == 0) {
        if (n_in != 21 || out_size != NB * SEQ * DM || ws_size < WS_END) { fprintf(stderr, "kernel_launch: unexpected problem (n_in %d, out %d, ws %zu)\n", n_in, out_size, ws_size); grid = -1; return; }
        int dev = 0, cus = 0, per_cu = 0;
        hipGetDevice(&dev); hipDeviceGetAttribute(&cus, hipDeviceAttributeMultiprocessorCount, dev);
        hipFuncSetAttribute((const void*)fwd_kernel, hipFuncAttributeMaxDynamicSharedMemorySize, LDS_BYTES);
        hipOccupancyMaxActiveBlocksPerMultiprocessor(&per_cu, (const void*)fwd_kernel, NTHR, LDS_BYTES);
        if (per_cu < 1) per_cu = 1;
        grid = cus;
        (void)hipGetLastError();
    }
    if (grid < 0) return;
    Args a{};
    for (int i = 0; i < 21; ++i) a.in[i] = (const float*)d_in[i];
    a.out = (float*)d_out; a.ws = (unsigned char*)d_ws;
#if SINGLE_LAUNCH
    a.ph_lo = 0; a.ph_hi = N_PHASES;
    void* kargs[] = {&a};
    hipError_t e = hipLaunchCooperativeKernel((const void*)fwd_kernel, dim3(grid), dim3(NTHR), kargs, LDS_BYTES, stream);
    if (e != hipSuccess) fprintf(stderr, "cooperative launch failed: %s (grid %d)\n", hipGetErrorString(e), grid);
#else
    for (int ph = 0; ph < N_PHASES; ++ph) {
        if (ph >= 2) { const int L = (ph - 2) / 9, k = (ph - 2) % 9; if (k == 2 && (L & 1)) continue; }
        a.ph_lo = ph; a.ph_hi = ph + 1;
        hipLaunchKernelGGL(fwd_kernel, dim3(grid), dim3(NTHR), LDS_BYTES, stream, a);
    }
#endif
}
```

```cpp
#include <hip/hip_runtime.h>
#include <hip/hip_cooperative_groups.h>
#include <cstdio>
#include <cstdint>
namespace cg = cooperative_groups;
namespace pg8 {
#define PG8_LAS __attribute__((address_space(3)))
typedef unsigned short bf16_t;
typedef short bf16x8 __attribute__((ext_vector_type(8)));
typedef float f32x4 __attribute__((ext_vector_type(4)));
typedef unsigned u32x4 __attribute__((ext_vector_type(4)));
constexpr int BM = 256, BK = 64, HALF = 128, HTB = HALF * BK * 2  , STAGE_BYTES = 8 * HTB, NXCD = 8, WGM = 8;

__host__ __device__ __forceinline__ int lds_byte(int r, int c) { const int st = (r >> 4) * 2 + (c >> 5), rr = r & 15, cc = c & 31, ob = rr * 64 + cc * 2; return st * 1024 + (ob ^ (((ob >> 9) & 1) << 5)); }
__host__ __device__ __forceinline__ void stage_rc(int b, int& R, int& C) { const int st = b / 1024, sb = b % 1024, swz = sb ^ (((sb >> 9) & 1) << 5); R = (st >> 1) * 16 + swz / 64; C = (st & 1) * 32 + (swz % 64) / 2; }
__host__ __device__ __forceinline__ int perm32(int rho) { const int n = rho >> 4, i = rho & 15; return 8 * (i >> 2) + 4 * n + (i & 3); }

struct Unit { int pm, pn; };
struct Gemm { const bf16_t* A; const bf16_t* Bt; int M, N, K, lda; };

struct StaticOrder {
    int nM, nN, nwg, G, c;
    __host__ __device__ void init(int M, int N, int G_, int c_) { nM = M / BM; nN = N / BM; nwg = nM * nN; G = G_; c = c_; }
    __host__ __device__ bool next(int i, Unit& u) const {
        const long L = (long)i * G + c; if (L >= nwg) return false;
        int wgid = (int)L; { const int q = nwg / NXCD, r = nwg % NXCD, xcd = wgid % NXCD, off = wgid / NXCD; wgid = (xcd < r ? xcd * (q + 1) : r * (q + 1) + (xcd - r) * q) + off; }
        const int nig = WGM * nN, gid = wgid / nig, fm = gid * WGM, gsz = (nM - fm) < WGM ? (nM - fm) : WGM;
        u.pm = fm + ((wgid % nig) % gsz); u.pn = (wgid % nig) / gsz; return true;
    }
    __device__ __forceinline__ void a_ready(const Unit&) const {}
    __device__ __forceinline__ void done(const Unit&) const {}
};

__device__ __forceinline__ unsigned cvt_pk_bf16(float lo, float hi) { unsigned r; asm volatile("v_cvt_pk_bf16_f32 %0, %1, %2" : "=v"(r) : "v"(lo), "v"(hi)); return r; }
template <class Epi, class Sched, bool ALIGN_EPI = false, bool SP2 = false>
__device__ __forceinline__ void gemm_phase(PG8_LAS unsigned char* lds, const Gemm g, const Sched& S, const Epi& E) {
    int tid_ = threadIdx.x; asm volatile("" : "+v"(tid_));
    const int tid = tid_, wid = __builtin_amdgcn_readfirstlane(tid >> 6), lane = tid & 63, wr = wid >> 2, wc = wid & 3, fr = lane & 15, fq = lane >> 4;
    const int K = g.K, nt = K / BK;
    unsigned voffA[2], voffB[2];
#pragma unroll
    for (int i = 0; i < 2; ++i) { int R, C; stage_rc(tid * 16 + i * 8192, R, C); const int Rb = Epi::PERM ? ((R & ~31) + perm32(R & 31)) : R;
        voffA[i] = (unsigned)(R * g.lda + C) * 2u; voffB[i] = (unsigned)(Rb * K + C) * 2u; }
    const size_t kstep = (size_t)(BK * 2);
    const size_t hstep = (size_t)HALF * K * 2, hstepA = (size_t)HALF * g.lda * 2;
    const size_t tstep = 2 * hstep, tstepA = 2 * hstepA;
    const unsigned ldsw = (unsigned)wid * 1024u;
    const int aoff = lds_byte(wr * 64 + fr, fq * 8), boff = lds_byte(wc * 32 + fr, fq * 8);
#define PG8_SA(b, h) (((b) * 2 + (h)) * HTB)
#define PG8_SB(b, h) ((4 + (b) * 2 + (h)) * HTB)
#define PG8_STAGE(bufoff, gbase, voff) do { _Pragma("unroll") for (int _i = 0; _i < 2; ++_i) \
        __builtin_amdgcn_global_load_lds((const unsigned*)((const char*)(gbase) + (voff)[_i]), (PG8_LAS unsigned*)(lds + (bufoff) + ldsw + _i * 8192), 16, 0, 0); } while (0)
#define PG8_LDA(dst, b, h) do { _Pragma("unroll") for (int m = 0; m < 4; ++m) _Pragma("unroll") for (int k = 0; k < 2; ++k) dst[m][k] = *(const PG8_LAS bf16x8*)(lds + PG8_SA(b, h) + aoff + m * 2048 + k * 1024); } while (0)
#define PG8_LDB(dst, b, h) do { _Pragma("unroll") for (int n = 0; n < 2; ++n) _Pragma("unroll") for (int k = 0; k < 2; ++k) dst[n][k] = *(const PG8_LAS bf16x8*)(lds + PG8_SB(b, h) + boff + n * 2048 + k * 1024); } while (0)
#define PG8_MMA(ai, bj, At, Bt) do { __builtin_amdgcn_s_setprio(1); _Pragma("unroll") for (int m = 0; m < 4; ++m) _Pragma("unroll") for (int n = 0; n < 2; ++n) _Pragma("unroll") for (int k = 0; k < 2; ++k) \
        acc[ai][bj][m][n] = __builtin_amdgcn_mfma_f32_16x16x32_bf16(Bt[n][k], At[m][k], acc[ai][bj][m][n], 0, 0, 0); __builtin_amdgcn_s_setprio(0); } while (0)
#define PG8_WAIT_V(n) asm volatile("s_waitcnt vmcnt(" #n ")" ::: "memory")
#define PG8_WAIT_L(n) asm volatile("s_waitcnt lgkmcnt(" #n ")" ::: "memory")
#define PG8_BAR __builtin_amdgcn_s_barrier()
#define PG8_SCHED __builtin_amdgcn_sched_barrier(0)
    Unit cur, nxt; int ui = 0;
    if (!S.next(0, cur)) return;
    f32x4 acc[2][2][4][2];
#pragma unroll
    for (int a = 0; a < 2; ++a)
#pragma unroll
        for (int b = 0; b < 2; ++b)
#pragma unroll
            for (int m = 0; m < 4; ++m)
#pragma unroll
                for (int n = 0; n < 2; ++n) acc[a][b][m][n] = (f32x4){0.f, 0.f, 0.f, 0.f};
    bf16x8 At[4][2], B0[2][2], B1[2][2];
    const char* cA = (const char*)g.A + (size_t)cur.pm * tstepA; const char* cB = (const char*)g.Bt + (size_t)cur.pn * tstep;
    S.a_ready(cur);
    if constexpr (SP2) {
        PG8_STAGE(PG8_SB(0, 0), cB, voffB); PG8_STAGE(PG8_SB(0, 1), cB + hstep, voffB); PG8_STAGE(PG8_SA(0, 0), cA, voffA); PG8_STAGE(PG8_SA(0, 1), cA + hstepA, voffA);
        if (wr == 1) PG8_BAR;
        PG8_WAIT_V(2); PG8_BAR;
        PG8_STAGE(PG8_SB(1, 0), cB + kstep, voffB); PG8_STAGE(PG8_SA(1, 0), cA + kstep, voffA); PG8_STAGE(PG8_SB(1, 1), cB + hstep + kstep, voffB);
        PG8_WAIT_V(6); PG8_BAR;
    } else {
        PG8_STAGE(PG8_SB(0, 0), cB, voffB); PG8_STAGE(PG8_SA(0, 0), cA, voffA); PG8_STAGE(PG8_SB(0, 1), cB + hstep, voffB); PG8_STAGE(PG8_SA(0, 1), cA + hstepA, voffA);
        if (wr == 1) PG8_BAR;
        PG8_WAIT_V(4); PG8_BAR;
        PG8_STAGE(PG8_SB(1, 0), cB + kstep, voffB); PG8_STAGE(PG8_SA(1, 0), cA + kstep, voffA); PG8_STAGE(PG8_SB(1, 1), cB + hstep + kstep, voffB);
        PG8_WAIT_V(6); PG8_BAR;
    }
    for (;;) {
        const bool has_next = S.next(ui + 1, nxt);
        const char* nA = has_next ? (const char*)g.A + (size_t)nxt.pm * tstepA : cA; const char* nB = has_next ? (const char*)g.Bt + (size_t)nxt.pn * tstep : cB;
        for (int t = 0; t < nt; t += 2) {
            const bool last = (t == nt - 2);
            const char* a1 = cA + (size_t)(t + 1) * kstep;
            const char* a2 = last ? nA : cA + (size_t)(t + 2) * kstep; const char* b2 = last ? nB : cB + (size_t)(t + 2) * kstep;
            const char* a3 = a2 + kstep; const char* b3 = b2 + kstep;
            if (last && has_next) S.a_ready(nxt);
            if constexpr (SP2) {
            PG8_LDB(B0, 0, 0); PG8_LDB(B1, 0, 1); PG8_SCHED; PG8_LDA(At, 0, 0); PG8_STAGE(PG8_SA(1, 1), a1 + hstepA, voffA);
            PG8_WAIT_V(8); PG8_WAIT_L(0); PG8_BAR; PG8_MMA(0, 0, At, B0); PG8_MMA(0, 1, At, B1); PG8_BAR; PG8_SCHED;
            PG8_LDA(At, 0, 1); PG8_STAGE(PG8_SB(0, 0), b2, voffB); PG8_STAGE(PG8_SB(0, 1), b2 + hstep, voffB); PG8_STAGE(PG8_SA(0, 0), a2, voffA);
            PG8_WAIT_V(8); PG8_WAIT_L(0); PG8_BAR; PG8_MMA(1, 0, At, B0); PG8_MMA(1, 1, At, B1); PG8_BAR; PG8_SCHED;
            PG8_LDB(B0, 1, 0); PG8_LDB(B1, 1, 1); PG8_SCHED; PG8_LDA(At, 1, 0); PG8_STAGE(PG8_SA(0, 1), a2 + hstepA, voffA);
            PG8_WAIT_V(8); PG8_WAIT_L(0); PG8_BAR; PG8_MMA(0, 0, At, B0); PG8_MMA(0, 1, At, B1); PG8_BAR; PG8_SCHED;
            PG8_LDA(At, 1, 1); PG8_STAGE(PG8_SB(1, 0), b3, voffB); PG8_STAGE(PG8_SB(1, 1), b3 + hstep, voffB); PG8_STAGE(PG8_SA(1, 0), a3, voffA);
            PG8_WAIT_V(8); PG8_WAIT_L(0); PG8_BAR; PG8_MMA(1, 0, At, B0); PG8_MMA(1, 1, At, B1); PG8_BAR; PG8_SCHED;
            } else {
            PG8_LDB(B0, 0, 0); PG8_SCHED; PG8_LDA(At, 0, 0); PG8_STAGE(PG8_SA(1, 1), a1 + hstepA, voffA);
            PG8_WAIT_L(8); PG8_BAR; PG8_WAIT_L(0); PG8_MMA(0, 0, At, B0); PG8_BAR; PG8_SCHED;
            PG8_LDB(B1, 0, 1); PG8_STAGE(PG8_SB(0, 0), b2, voffB);
            PG8_BAR; PG8_WAIT_L(0); PG8_MMA(0, 1, At, B1); PG8_BAR;
            PG8_LDA(At, 0, 1); PG8_STAGE(PG8_SA(0, 0), a2, voffA);
            PG8_BAR; PG8_WAIT_L(0); PG8_MMA(1, 0, At, B0); PG8_BAR; PG8_SCHED;
            PG8_STAGE(PG8_SB(0, 1), b2 + hstep, voffB);
            PG8_WAIT_V(6); PG8_BAR; PG8_MMA(1, 1, At, B1); PG8_BAR;
            PG8_LDB(B0, 1, 0); PG8_SCHED; PG8_LDA(At, 1, 0); PG8_STAGE(PG8_SA(0, 1), a2 + hstepA, voffA);
            PG8_WAIT_L(8); PG8_BAR; PG8_WAIT_L(0); PG8_MMA(0, 0, At, B0); PG8_BAR; PG8_SCHED;
            PG8_LDB(B1, 1, 1); PG8_STAGE(PG8_SB(1, 0), b3, voffB);
            PG8_BAR; PG8_WAIT_L(0); PG8_MMA(0, 1, At, B1); PG8_BAR;
            PG8_LDA(At, 1, 1); PG8_STAGE(PG8_SA(1, 0), a3, voffA);
            PG8_BAR; PG8_WAIT_L(0); PG8_MMA(1, 0, At, B0); PG8_BAR; PG8_SCHED;
            PG8_STAGE(PG8_SB(1, 1), b3 + hstep, voffB);
            PG8_WAIT_V(6); PG8_BAR; PG8_MMA(1, 1, At, B1); PG8_BAR;
            }
        }
        if constexpr (ALIGN_EPI) { if (wr == 0) PG8_BAR; }
        if constexpr (!Epi::AFTER_DRAIN) { E(acc, cur, wr, wc, fr, fq); S.done(cur); }
        if (!has_next) break;
#pragma unroll
        for (int a = 0; a < 2; ++a)
#pragma unroll
            for (int b = 0; b < 2; ++b)
#pragma unroll
                for (int m = 0; m < 4; ++m)
#pragma unroll
                    for (int n = 0; n < 2; ++n) acc[a][b][m][n] = (f32x4){0.f, 0.f, 0.f, 0.f};
        cur = nxt; cA = nA; cB = nB; ++ui;
        if constexpr (ALIGN_EPI) { if (wr == 1) PG8_BAR; }
    }
    PG8_WAIT_V(0);
    if constexpr (!ALIGN_EPI) { if (wr == 0) PG8_BAR; }
    PG8_BAR;
    if constexpr (Epi::AFTER_DRAIN) { E.fused(acc, cur, wr, wc, fr, fq, lds, wid, lane); S.done(cur); }
#undef PG8_SA
#undef PG8_SB
#undef PG8_STAGE
#undef PG8_LDA
#undef PG8_LDB
#undef PG8_MMA
#undef PG8_WAIT_V
#undef PG8_WAIT_L
#undef PG8_BAR
#undef PG8_SCHED
}
}
namespace pg8 {
struct EpiStore {
    static constexpr bool PERM = true, AFTER_DRAIN = false;
    bf16_t* O; int ldc; int act;
    __device__ __forceinline__ void operator()(const f32x4 (&acc)[2][2][4][2], const Unit& u, int wr, int wc, int fr, int fq) const {
        const int row0 = u.pm * BM + wr * 64 + fr; const int col0 = u.pn * BM + wc * 32 + 8 * fq;
#pragma unroll
        for (int ai = 0; ai < 2; ++ai)
#pragma unroll
            for (int m = 0; m < 4; ++m) { bf16_t* rowp = O + (size_t)(row0 + ai * HALF + m * 16) * ldc + col0;
#pragma unroll
                for (int bj = 0; bj < 2; ++bj) { f32x4 v0 = acc[ai][bj][m][0], v1 = acc[ai][bj][m][1];
                    if (act == 1) {
#pragma unroll
                        for (int e = 0; e < 4; ++e) { float a = fmaxf(v0[e], 0.f), b = fmaxf(v1[e], 0.f); v0[e] = a * a; v1[e] = b * b; } }
                    u32x4 w; w.x = cvt_pk_bf16(v0[0], v0[1]); w.y = cvt_pk_bf16(v0[2], v0[3]); w.z = cvt_pk_bf16(v1[0], v1[1]); w.w = cvt_pk_bf16(v1[2], v1[3]);
                    *(u32x4*)(rowp + bj * HALF) = w; } }
    }
};
}
#define LAS __attribute__((address_space(3)))
typedef unsigned short bf16;
typedef short bf16x8 __attribute__((ext_vector_type(8)));
typedef short s16x4 __attribute__((ext_vector_type(4)));
typedef float f32x4 __attribute__((ext_vector_type(4)));
typedef float f32x16 __attribute__((ext_vector_type(16)));
typedef unsigned u32x4 __attribute__((ext_vector_type(4)));
typedef unsigned u32x2 __attribute__((ext_vector_type(2)));

constexpr int DM = 1024, NB = 32, SEQ = 2048, CTXL = 256, RPB = SEQ + CTXL, MROWS = NB * RPB;
constexpr int DFF = 4096, DEPTH = 4, NWAVES = 8, NTHR = 512;
constexpr int PE = 2048, PO = 2304;
constexpr int E_CKV = 256, E_KR = 384, E_DQ = 416, E_DK = 928, E_DV = 1440;
constexpr int O_GK = 512, O_GV = 640, O_NQ = 768, O_NK = 1280, O_NV = 1792;
constexpr float EPSN = 1e-6f, LOG2E = 1.4426950408889634f, LOG2_THETA = 13.287712379549449f;
constexpr float MLA_SC = 0.10206207261596575f  , HD_SC = 0.125f;

constexpr size_t MiB = 1u << 20;
constexpr size_t WS_MOD = 0;
constexpr size_t WS_HC = 4 * MiB;
constexpr size_t WS_WT = 36 * MiB;
constexpr size_t WS_AF = 132 * MiB;
constexpr size_t WS_P = 276 * MiB;
constexpr size_t WS_QM = 600 * MiB;
constexpr size_t WS_KVM = 708 * MiB;
constexpr size_t WS_O = 852 * MiB;
constexpr size_t WS_END = 996 * MiB;
constexpr size_t WS_H = WS_P;
constexpr size_t WL_STRIDE = 24 * MiB, WL_IN = 0, WL_OUT = 5 * MiB, WL_FF1 = 7 * MiB, WL_FF2 = 15 * MiB, WL_UQ = 23 * MiB, WL_UKV = 23 * MiB + 512 * 1024;
static_assert(WS_H + (size_t)MROWS * DFF * 2 <= WS_O, "H overlay");
constexpr int LDS_BYTES = 147456;

struct Args { const float* in[21]; float* out; unsigned char* ws; int ph_lo, ph_hi; };

__device__ __forceinline__ float bf2f(unsigned short b) { return __uint_as_float((unsigned)b << 16); }
typedef float f32x2_t __attribute__((ext_vector_type(2))); typedef __bf16 bf16x2_t __attribute__((ext_vector_type(2)));
__device__ __forceinline__ unsigned pk2(float lo, float hi) { f32x2_t v = {lo, hi}; bf16x2_t b = __builtin_convertvector(v, bf16x2_t); return __builtin_bit_cast(unsigned, b); }
__device__ __forceinline__ unsigned short f2bf(float f) { return (unsigned short)(pk2(f, 0.f) & 0xffffu); }
__device__ __forceinline__ float wave_sum(float v) {
#pragma unroll
    for (int o = 1; o < 64; o <<= 1) v += __shfl_xor(v, o);
    return v;
}
__device__ __forceinline__ float half_sum(float v) {
#pragma unroll
    for (int o = 1; o < 32; o <<= 1) v += __shfl_xor(v, o);
    return v;
}

__device__ __forceinline__ void transpose_item(const float* W, int K, int N, bf16* WT, LAS float* scr, int item, int lane, const float* kscale, float sc) {
    const int nblk = N / 32, kb = item / nblk, nb = item % nblk, k0 = 64 * kb, n0 = 32 * nb;
#pragma unroll 8
    for (int i = 0; i < 32; ++i) { const int kk = 2 * i + (lane >> 5); float w = W[(size_t)(k0 + kk) * N + n0 + (lane & 31)]; w *= (kscale ? kscale[k0 + kk] * sc : sc); scr[kk * 33 + (lane & 31)] = w; }
    asm volatile("s_waitcnt lgkmcnt(0)" ::: "memory");
    const int c = lane & 7;
#pragma unroll
    for (int j = 0; j < 4; ++j) { const int n = (lane >> 3) + 8 * j; const LAS float* s = scr + (8 * c) * 33 + n;
        u32x4 o; o.x = pk2(s[0 * 33], s[1 * 33]); o.y = pk2(s[2 * 33], s[3 * 33]); o.z = pk2(s[4 * 33], s[5 * 33]); o.w = pk2(s[6 * 33], s[7 * 33]);
        *(u32x4*)(WT + (size_t)(n0 + n) * K + k0 + 8 * c) = o; }
    asm volatile("s_waitcnt lgkmcnt(0)" ::: "memory");
}

struct Ctx {
    LAS unsigned char* lds; int tid, lane, wave, vcu, G;
    float* out; unsigned char* ws;
};

__device__ __forceinline__ void phase_prologue_a(const Ctx& F, const Args& args) {
    {
        LAS float* S = (LAS float*)F.lds;
        LAS float* R = (LAS float*)(F.lds + 33 * 512 * 4);
        const float* c = args.in[1]; const float* cc = args.in[3]; const float* wada = args.in[4]; const float* bada = args.in[5];
        float* MOD = (float*)(F.ws + WS_MOD);
        const int cg_ = F.lane & 31, kh = F.lane >> 5;
        for (int it = F.vcu; it < 4 * 192; it += F.G) {
            const int l = it / 192, n0 = (it % 192) * 32;
            float acc[33];
#pragma unroll
            for (int r = 0; r < 33; ++r) acc[r] = 0.f;
            for (int half = 0; half < 2; ++half) {
                __syncthreads();
                for (int e = F.tid; e < 33 * 512; e += NTHR) { const int r = e >> 9, k = (e & 511) + half * 512; const float v = (r < 32) ? c[r * 1024 + k] : cc[k]; S[e] = v / (1.f + __expf(-v)); }
                __syncthreads();
                const int kb = F.wave * 64 + kh * 32;
                const float* wp = wada + ((size_t)l * 1024 + half * 512 + kb) * 6144 + n0 + cg_;
                for (int kk = 0; kk < 32; kk += 4) {
                    const float w0 = wp[(size_t)(kk + 0) * 6144], w1 = wp[(size_t)(kk + 1) * 6144], w2 = wp[(size_t)(kk + 2) * 6144], w3 = wp[(size_t)(kk + 3) * 6144];
#pragma unroll
                    for (int r = 0; r < 33; ++r) { const f32x4 s = *(const LAS f32x4*)(S + r * 512 + kb + kk); acc[r] += s[0] * w0 + s[1] * w1 + s[2] * w2 + s[3] * w3; }
                }
            }
#pragma unroll
            for (int r = 0; r < 33; ++r) { acc[r] += __shfl_xor(acc[r], 32); if (kh == 0) R[(F.wave * 33 + r) * 32 + cg_] = acc[r]; }
            __syncthreads();
            for (int e = F.tid; e < 33 * 32; e += NTHR) { float s = 0.f;
#pragma unroll
                for (int w = 0; w < 8; ++w) s += R[w * 33 * 32 + e];
                const int r = e >> 5, n = n0 + (e & 31); MOD[((size_t)l * 33 + r) * 6144 + n] = s + bada[l * 6144 + n]; }
        }
        __syncthreads();
    }
    {
        LAS float* scr = (LAS float*)(F.lds + F.wave * 16384);
        const int gw = F.vcu * NWAVES + F.wave, NGW = F.G * NWAVES;
        constexpr int I_INE = 16 * 61, I_INO = 16 * 72, I_OUT = 16 * 32, I_FF1 = 16 * 128, I_FF2 = 64 * 32, I_UQ = 4 * 24, I_UKV = 2 * 32, I_Z = 96;
        constexpr int PER_E = I_INE + I_OUT + I_FF1 + I_FF2 + I_UQ + I_UKV + I_Z, PER_O = I_INO + I_OUT + I_FF1 + I_FF2;
        constexpr int NIT = 2 * (PER_E + PER_O);
        for (int it = gw; it < NIT; it += NGW) {
            int pr = it / (PER_E + PER_O), r = it % (PER_E + PER_O);
            const bool odd = r >= PER_E; if (odd) r -= PER_E;
            const int L = 2 * pr + (odd ? 1 : 0);
            unsigned char* wl = F.ws + WS_WT + (size_t)L * WL_STRIDE;
            const float* W; int K, N; size_t wo; const float* ks = nullptr; float sc = 1.f; bool zero = false;
            if (!odd) {
                if (r < I_INE) { W = args.in[9] + (size_t)pr * 1024 * 1952; K = 1024; N = 1952; wo = WL_IN; }
                else if ((r -= I_INE) < I_OUT) { W = args.in[10] + (size_t)pr * 1024 * 1024; K = 1024; N = 1024; wo = WL_OUT; }
                else if ((r -= I_OUT) < I_FF1) { W = args.in[7] + (size_t)L * 1024 * 4096; K = 1024; N = 4096; wo = WL_FF1; }
                else if ((r -= I_FF1) < I_FF2) { W = args.in[8] + (size_t)L * 4096 * 1024; K = 4096; N = 1024; wo = WL_FF2; }
                else if ((r -= I_FF2) < I_UQ) { W = args.in[12] + (size_t)pr * 256 * 768; K = 256; N = 768; wo = WL_UQ; ks = args.in[11] + pr * 256; sc = MLA_SC * LOG2E; }
                else if ((r -= I_UQ) < I_UKV) { W = args.in[14] + (size_t)pr * 128 * 1024; K = 128; N = 1024; wo = WL_UKV; ks = args.in[13] + pr * 128; }
                else { r -= I_UKV; zero = true; W = nullptr; K = 0; N = 0; wo = WL_IN; }
            } else {
                if (r < I_INO) { W = args.in[17] + (size_t)pr * 1024 * 2304; K = 1024; N = 2304; wo = WL_IN; }
                else if ((r -= I_INO) < I_OUT) { W = args.in[18] + (size_t)pr * 1024 * 1024; K = 1024; N = 1024; wo = WL_OUT; }
                else if ((r -= I_OUT) < I_FF1) { W = args.in[7] + (size_t)L * 1024 * 4096; K = 1024; N = 4096; wo = WL_FF1; }
                else { r -= I_FF1; W = args.in[8] + (size_t)L * 4096 * 1024; K = 4096; N = 1024; wo = WL_FF2; }
            }
            if (zero) { bf16* z = (bf16*)(wl + WL_IN) + (size_t)(1952 + r) * 1024; u32x4 zz = {0u, 0u, 0u, 0u}; *(u32x4*)(z + F.lane * 8) = zz; *(u32x4*)(z + 512 + F.lane * 8) = zz; }
            else transpose_item(W, K, N, (bf16*)(wl + wo), scr, r, F.lane, ks, sc);
        }
    }
}

struct RowPassP { const float* hin_lat; const float* hin_ctx; float* hout_lat; float* hout_ctx; bf16* AF; const float* g_post; const float* g_pre;
                  const float* mod_post; const float* mod_pre; int gate_chunk, shift_chunk, scale_chunk; int has_f, write_h, write_a, skip_ctx; };
__device__ __forceinline__ const float* rp_hin(const RowPassP& p, int r) { const int b = r / RPB, j = r - b * RPB; return (j < CTXL) ? p.hin_ctx + (size_t)(b * CTXL + j) * DM : p.hin_lat + (size_t)(b * SEQ + j - CTXL) * DM; }
__device__ __forceinline__ void phase_rowpass(const Ctx& F, const RowPassP p) {
    const int gw = F.vcu * NWAVES + F.wave, NGW = F.G * NWAVES; const int chunk = (MROWS + NGW - 1) / NGW;
    const int r0 = gw * chunk, r1 = min(r0 + chunk, MROWS);
    if (r0 >= r1) return;
    const int c0 = F.lane * 8;
    float gpo[16], gpr[16], gt[16], sh[16], sc[16];
#pragma unroll
    for (int jj = 0; jj < 2; ++jj)
#pragma unroll
        for (int q = 0; q < 2; ++q) { const f32x4 a = *(const f32x4*)(p.g_post + jj * 512 + c0 + q * 4), b = *(const f32x4*)(p.g_pre + jj * 512 + c0 + q * 4);
#pragma unroll
            for (int e = 0; e < 4; ++e) { gpo[jj * 8 + q * 4 + e] = a[e]; gpr[jj * 8 + q * 4 + e] = b[e]; gt[jj * 8 + q * 4 + e] = 0.f; sh[jj * 8 + q * 4 + e] = 0.f; sc[jj * 8 + q * 4 + e] = 0.f; } }
    int cur_mrow = -1;
    f32x4 hn[4]; bf16x8 fn[2];
    { const float* hin = rp_hin(p, r0);
#pragma unroll
      for (int jj = 0; jj < 2; ++jj) { hn[jj * 2] = *(const f32x4*)(hin + jj * 512 + c0); hn[jj * 2 + 1] = *(const f32x4*)(hin + jj * 512 + c0 + 4); fn[jj] = *(const bf16x8*)(p.AF + (size_t)r0 * DM + jj * 512 + c0); } }
    for (int r = r0; r < r1; ++r) {
        float h[16]; bf16x8 fc[2];
#pragma unroll
        for (int jj = 0; jj < 2; ++jj) {
#pragma unroll
            for (int e = 0; e < 4; ++e) { h[jj * 8 + e] = hn[jj * 2][e]; h[jj * 8 + 4 + e] = hn[jj * 2 + 1][e]; }
            fc[jj] = fn[jj]; }
        if (r + 1 < r1) { const float* hin = rp_hin(p, r + 1);
#pragma unroll
            for (int jj = 0; jj < 2; ++jj) { hn[jj * 2] = *(const f32x4*)(hin + jj * 512 + c0); hn[jj * 2 + 1] = *(const f32x4*)(hin + jj * 512 + c0 + 4); fn[jj] = *(const bf16x8*)(p.AF + (size_t)(r + 1) * DM + jj * 512 + c0); } }
        const int b = r / RPB, j = r - b * RPB; const bool isc = j < CTXL;
        if (isc && p.skip_ctx) continue;
        const int mrow = isc ? 32 : b;
        if (mrow != cur_mrow) { cur_mrow = mrow;
            const float* gp = p.mod_post + (size_t)mrow * 6144 + p.gate_chunk * 1024; const float* sp = p.mod_pre + (size_t)mrow * 6144 + p.shift_chunk * 1024; const float* cp = p.mod_pre + (size_t)mrow * 6144 + p.scale_chunk * 1024;
#pragma unroll
            for (int jj = 0; jj < 2; ++jj)
#pragma unroll
                for (int q = 0; q < 2; ++q) { const f32x4 a = *(const f32x4*)(gp + jj * 512 + c0 + q * 4), s1 = *(const f32x4*)(sp + jj * 512 + c0 + q * 4), s2 = *(const f32x4*)(cp + jj * 512 + c0 + q * 4);
#pragma unroll
                    for (int e = 0; e < 4; ++e) { gt[jj * 8 + q * 4 + e] = a[e]; sh[jj * 8 + q * 4 + e] = s1[e]; sc[jj * 8 + q * 4 + e] = 1.f + s2[e]; } } }
        bf16* afrow = p.AF + (size_t)r * DM;
        if (p.has_f) {
            float f[16]; float ss = 0.f;
#pragma unroll
            for (int jj = 0; jj < 2; ++jj)
#pragma unroll
                for (int e = 0; e < 8; ++e) { f[jj * 8 + e] = bf2f((unsigned short)fc[jj][e]); ss += f[jj * 8 + e] * f[jj * 8 + e]; }
            ss = wave_sum(ss); const float rs = rsqrtf(ss * (1.f / DM) + EPSN);
#pragma unroll
            for (int e = 0; e < 16; ++e) h[e] += gt[e] * (f[e] * rs * gpo[e]);
        }
        if (p.write_h) {
            float* hout = isc ? p.hout_ctx + (size_t)(b * CTXL + j) * DM : p.hout_lat + (size_t)(b * SEQ + j - CTXL) * DM;
#pragma unroll
            for (int jj = 0; jj < 2; ++jj) { f32x4 a, c;
#pragma unroll
                for (int e = 0; e < 4; ++e) { a[e] = h[jj * 8 + e]; c[e] = h[jj * 8 + 4 + e]; }
                *(f32x4*)(hout + jj * 512 + c0) = a; *(f32x4*)(hout + jj * 512 + c0 + 4) = c; }
        }
        if (p.write_a) {
            float ss = 0.f;
#pragma unroll
            for (int e = 0; e < 16; ++e) ss += h[e] * h[e];
            ss = wave_sum(ss); const float rs = rsqrtf(ss * (1.f / DM) + EPSN);
#pragma unroll
            for (int jj = 0; jj < 2; ++jj) { float o[8];
#pragma unroll
                for (int e = 0; e < 8; ++e) o[e] = (h[jj * 8 + e] * rs * gpr[jj * 8 + e]) * sc[jj * 8 + e] + sh[jj * 8 + e];
                u32x4 w; w.x = pk2(o[0], o[1]); w.y = pk2(o[2], o[3]); w.z = pk2(o[4], o[5]); w.w = pk2(o[6], o[7]);
                *(u32x4*)(afrow + jj * 512 + c0) = w; }
        }
    }
}

__device__ __forceinline__ void rope_cs(int j, int i, int nfreq, float& cs, float& sn) {
    if (j < CTXL) { cs = 1.f; sn = 0.f; return; }
    const int t = j - CTXL; const int fi = (i < nfreq) ? i : i - nfreq; const float pos = (i < nfreq) ? (float)(t >> 6) : (float)(t & 63);
    const float ang = pos * exp2f(-(float)fi * (LOG2_THETA / (float)nfreq));
    cs = __cosf(ang); sn = __sinf(ang);
}
__device__ __forceinline__ void phase_prep_even(const Ctx& F) {
    bf16* P = (bf16*)(F.ws + WS_P); bf16* CQN = (bf16*)(F.ws + WS_AF); bf16* CKVN = (bf16*)(F.ws + WS_AF + 36 * MiB);
    const int gw = F.vcu * NWAVES + F.wave, NGW = F.G * NWAVES; const int lane = F.lane;
    for (int r = gw; r < MROWS; r += NGW) {
        const int j = r % RPB; bf16* pr = P + (size_t)r * PE;
        {
            const u32x2 v = *(const u32x2*)(pr + 4 * lane); const float a0 = bf2f(v.x & 0xffff), a1 = bf2f(v.x >> 16), a2 = bf2f(v.y & 0xffff), a3 = bf2f(v.y >> 16);
            const float ss = wave_sum(a0 * a0 + a1 * a1 + a2 * a2 + a3 * a3); const float rs = rsqrtf(ss * (1.f / 256.f) + EPSN);
            u32x2 o; o.x = pk2(a0 * rs, a1 * rs); o.y = pk2(a2 * rs, a3 * rs); *(u32x2*)(CQN + (size_t)r * 256 + 4 * lane) = o;
        }
        {
            const unsigned v = *(const unsigned*)(pr + E_CKV + 2 * lane); const float a0 = bf2f(v & 0xffff), a1 = bf2f(v >> 16);
            const float ss = wave_sum(a0 * a0 + a1 * a1); const float rs = rsqrtf(ss * (1.f / 128.f) + EPSN);
            *(unsigned*)(CKVN + (size_t)r * 128 + 2 * lane) = pk2(a0 * rs, a1 * rs);
        }
        if (lane < 16 && j >= CTXL) {
            float cs, sn; rope_cs(j, lane, 8, cs, sn);
            const float x1 = bf2f(pr[E_KR + lane]), x2 = bf2f(pr[E_KR + 16 + lane]);
            pr[E_KR + lane] = f2bf(x1 * cs - x2 * sn); pr[E_KR + 16 + lane] = f2bf(x2 * cs + x1 * sn);
        }
        {
            float cs, sn; rope_cs(j, lane & 31, 16, cs, sn);
#pragma unroll
            for (int jj = 0; jj < 4; ++jj) { const int v = (lane >> 5) + 2 * jj; bf16* q = pr + E_DQ + v * 64 + (lane & 31); bf16* k = pr + E_DK + v * 64 + (lane & 31);
                const float q1 = bf2f(q[0]), q2 = bf2f(q[32]), k1 = bf2f(k[0]), k2 = bf2f(k[32]);
                q[0] = f2bf((q1 * cs - q2 * sn) * (HD_SC * LOG2E)); q[32] = f2bf((q2 * cs + q1 * sn) * (HD_SC * LOG2E));
                if (j >= CTXL) { k[0] = f2bf(k1 * cs - k2 * sn); k[32] = f2bf(k2 * cs + k1 * sn); } }
        }
    }
}
__device__ __forceinline__ void phase_prep_odd(const Ctx& F, const float* qkn  ) {
    bf16* P = (bf16*)(F.ws + WS_P);
    const int gw = F.vcu * NWAVES + F.wave, NGW = F.G * NWAVES; const int lane = F.lane, i = lane & 31;
    const float gq1 = qkn[i], gq2 = qkn[32 + i], gk1 = qkn[64 + i], gk2 = qkn[96 + i];
    for (int r = gw; r < MROWS; r += NGW) {
        const int j = r % RPB; bf16* pr = P + (size_t)r * PO;
        float cs, sn; rope_cs(j, i, 16, cs, sn);
#pragma unroll
        for (int jj = 0; jj < 4; ++jj) { const int hh = (lane >> 5) + 2 * jj; bf16* q = pr + hh * 64 + i;
            const float x1 = bf2f(q[0]), x2 = bf2f(q[32]); const float rs = rsqrtf(half_sum(x1 * x1 + x2 * x2) * (1.f / 64.f) + EPSN);
            const float y1 = x1 * rs * gq1, y2 = x2 * rs * gq2;
            q[0] = f2bf((y1 * cs - y2 * sn) * (HD_SC * LOG2E)); q[32] = f2bf((y2 * cs + y1 * sn) * (HD_SC * LOG2E)); }
        {   const int hh = lane >> 5; bf16* k = pr + O_GK + hh * 64 + i;
            const float x1 = bf2f(k[0]), x2 = bf2f(k[32]); const float rs = rsqrtf(half_sum(x1 * x1 + x2 * x2) * (1.f / 64.f) + EPSN);
            const float y1 = x1 * rs * gk1, y2 = x2 * rs * gk2;
            k[0] = f2bf(y1 * cs - y2 * sn); k[32] = f2bf(y2 * cs + y1 * sn); }
        {   bf16x8 v = *(const bf16x8*)(pr + O_NQ + 8 * lane); float o[8];
#pragma unroll
            for (int e = 0; e < 8; ++e) o[e] = bf2f((unsigned short)v[e]) * (HD_SC * LOG2E);
            u32x4 w; w.x = pk2(o[0], o[1]); w.y = pk2(o[2], o[3]); w.z = pk2(o[4], o[5]); w.w = pk2(o[6], o[7]); *(u32x4*)(pr + O_NQ + 8 * lane) = w; }
    }
}

struct AttnP {
    const bf16* q; int qpitch; const bf16* ka; int kapitch; const bf16* kb; int kbpitch; const bf16* v; int vpitch; bf16* o; int opitch;
    int nA, tB0, nB;
    int rope_t0;
    int mode;
    float lam, post; const float* subln;
    int na_row0;
};
__device__ __forceinline__ int crow(int r, int hi) { return (r & 3) + 8 * (r >> 2) + 4 * hi; }

template <int DQK, int DV, bool NA>
__device__ __forceinline__ void attn_unit(const AttnP& a, LAS unsigned char* lds, const LAS float* biasT, int tid) {
    constexpr int KP = DQK * 2 + 16, KBYTES = 64 * KP, VBYTES = 64 * DV * 2, BUF = KBYTES + VBYTES;
    constexpr int KCH = DQK / 8, NKC = 64 * KCH, VCH = DV / 8, NVC = 64 * VCH, KN = (NKC + NTHR - 1) / NTHR, VN = NVC / NTHR, ND = DQK / 16, NDB = DV / 32;
    const int lane = tid & 63, wave = __builtin_amdgcn_readfirstlane(tid >> 6), r32 = lane & 31, hi = lane >> 5;
    bf16x8 qf[ND];
    { const bf16* qrow = a.q + (size_t)(wave * 32 + r32) * a.qpitch + hi * 8;
#pragma unroll
      for (int d0 = 0; d0 < ND; ++d0) qf[d0] = *(const bf16x8*)(qrow + d0 * 16); }
    if constexpr (DQK == 96) {
        if (a.rope_t0 >= 0) {
            const int t = a.rope_t0 + wave * 32 + r32; const float pos = hi ? (float)(t & 63) : (float)(t >> 6);
#pragma unroll
            for (int e = 0; e < 8; ++e) { const float ang = pos * exp2f(-(float)e * (LOG2_THETA / 8.f)); const float cs = __cosf(ang), sn = __sinf(ang);
                const float x1 = bf2f((unsigned short)qf[4][e]), x2 = bf2f((unsigned short)qf[5][e]);
                qf[4][e] = (short)f2bf(x1 * cs - x2 * sn); qf[5][e] = (short)f2bf(x2 * cs + x1 * sn); }
        }
    }
    const bf16* ksrc[KN]; int kdst[KN]; size_t kstep[KN];
#pragma unroll
    for (int i = 0; i < KN; ++i) { const int c = tid + i * NTHR; const int row = c / KCH, ch = c - row * KCH;
        if (DQK == 96 && ch >= 8) { ksrc[i] = a.kb + (size_t)row * a.kbpitch + (ch - 8) * 8; kstep[i] = (size_t)64 * a.kbpitch; }
        else { ksrc[i] = a.ka + (size_t)row * a.kapitch + ch * 8; kstep[i] = (size_t)64 * a.kapitch; }
        kdst[i] = row * KP + ch * 16; }
    const bf16* vsrc[VN]; int vdst[VN];
#pragma unroll
    for (int i = 0; i < VN; ++i) { const int c = tid + i * NTHR; const int row = c / VCH, ch = c - row * VCH;
        vsrc[i] = a.v + (size_t)row * a.vpitch + ch * 8; vdst[i] = KBYTES + ((row >> 3) * NDB + (ch >> 2)) * 512 + (row & 7) * 64 + (ch & 3) * 16; }
    const size_t vstep = (size_t)64 * a.vpitch;
    const int ntile = a.nA + a.nB;
    u32x4 kreg[KN], vreg[VN];
#define ATT_TILE(i_) ((i_) < a.nA ? (i_) : a.tB0 + ((i_) - a.nA))
#define ATT_LOAD(tt_) do { _Pragma("unroll") for (int i_ = 0; i_ < KN; ++i_) if (KN * NTHR == NKC || tid + i_ * NTHR < NKC) kreg[i_] = *(const u32x4*)(ksrc[i_] + (size_t)(tt_) * kstep[i_]); \
        _Pragma("unroll") for (int i_ = 0; i_ < VN; ++i_) vreg[i_] = *(const u32x4*)(vsrc[i_] + (size_t)(tt_) * vstep); } while (0)
#define ATT_STORE(buf_) do { _Pragma("unroll") for (int i_ = 0; i_ < KN; ++i_) if (KN * NTHR == NKC || tid + i_ * NTHR < NKC) *(LAS u32x4*)(lds + (buf_) * BUF + kdst[i_]) = kreg[i_]; \
        _Pragma("unroll") for (int i_ = 0; i_ < VN; ++i_) *(LAS u32x4*)(lds + (buf_) * BUF + vdst[i_]) = vreg[i_]; } while (0)
    ATT_LOAD(ATT_TILE(0)); ATT_STORE(0);
    __syncthreads();
    constexpr float THR = 8.f;
    constexpr bool NEGM = (DV == 64);
    float mrun = 0.f, lrun = 0.f;
    f32x16 negm = f32x16{};
    f32x16 o[NDB];
#pragma unroll
    for (int d = 0; d < NDB; ++d) o[d] = f32x16{};
    const int koff = r32 * KP + hi * 16;
    const int voff = KBYTES + (4 * hi + ((lane & 15) >> 2)) * 64 + ((lane >> 4) & 1) * 32 + (lane & 3) * 8;
    int na_rq = 0, na_r0 = 0, na_c = 0, na_ws = 0;
    if constexpr (NA) { na_rq = a.na_row0 + (wave >> 1); na_r0 = min(max(na_rq - 4, 0), 24); na_c = 32 * (wave & 1) + r32; na_ws = min(max(na_c - 8, 0), 48); }
    for (int it = 0; it < ntile; ++it) {
        const int buf = it & 1; const int tt = ATT_TILE(it);
        if (it + 1 < ntile) { const int tn = ATT_TILE(it + 1); ATT_LOAD(tn); }
        bool active = true; int rowoff = 0; bool local = false;
        if constexpr (NA) { if (tt >= 4) { const int kr = tt - 4; local = true; active = (kr >= na_r0) && (kr < na_r0 + 8); rowoff = (kr - na_rq + 7) * 32; } }
        if (active) {
            LAS unsigned char* kb_ = lds + buf * BUF;
            f32x16 p0, p1;
            if constexpr (NEGM) { p0 = negm; p1 = negm; } else { p0 = f32x16{}; p1 = f32x16{}; }
#pragma unroll
            for (int d0 = 0; d0 < ND; ++d0) {
                const bf16x8 k0 = *(const LAS bf16x8*)(kb_ + koff + d0 * 32), k1 = *(const LAS bf16x8*)(kb_ + koff + 32 * KP + d0 * 32);
                p0 = __builtin_amdgcn_mfma_f32_32x32x16_bf16(k0, qf[d0], p0, 0, 0, 0);
                p1 = __builtin_amdgcn_mfma_f32_32x32x16_bf16(k1, qf[d0], p1, 0, 0, 0);
            }
            if constexpr (NA) {
                if (local) {
#pragma unroll
                    for (int r = 0; r < 16; ++r) {
                        const int kc0 = crow(r, hi), kc1 = 32 + kc0;
                        const int i0 = min(max(kc0 - na_c + 15, 0), 30), i1 = min(max(kc1 - na_c + 15, 0), 30);
                        const float b0 = biasT[rowoff + i0], b1 = biasT[rowoff + i1];
                        p0[r] = (kc0 >= na_ws && kc0 < na_ws + 16) ? p0[r] + b0 : -INFINITY;
                        p1[r] = (kc1 >= na_ws && kc1 < na_ws + 16) ? p1[r] + b1 : -INFINITY;
                    }
                }
            }
            float mxa = fmaxf(fmaxf(p0[0], p0[1]), p1[0]), mxb = fmaxf(fmaxf(p0[2], p0[3]), p1[1]);
            mxa = fmaxf(fmaxf(mxa, p1[2]), p1[3]);
#pragma unroll
            for (int r = 4; r < 16; r += 4) { mxa = fmaxf(fmaxf(mxa, p0[r]), p0[r + 1]); mxb = fmaxf(fmaxf(mxb, p0[r + 2]), p0[r + 3]); mxa = fmaxf(fmaxf(mxa, p1[r]), p1[r + 1]); mxb = fmaxf(fmaxf(mxb, p1[r + 2]), p1[r + 3]); }
            float mx = fmaxf(mxa, mxb);
            mx = fmaxf(mx, __shfl_xor(mx, 32));
            if constexpr (!NEGM) mx -= mrun;
            if (it == 0 || __any(mx > THR)) {
                const float dl = (it == 0) ? mx : fmaxf(mx, 0.f);
                mrun += dl;
                const float alpha = __builtin_amdgcn_exp2f(-dl);
                lrun *= alpha;
#pragma unroll
                for (int d = 0; d < NDB; ++d)
#pragma unroll
                    for (int r = 0; r < 16; ++r) o[d][r] *= alpha;
                if constexpr (NEGM) {
#pragma unroll
                    for (int r = 0; r < 16; ++r) { p0[r] -= dl; p1[r] -= dl; negm[r] = -mrun; }
                }
            }
            float rs0 = 0.f, rs1 = 0.f, rs2 = 0.f, rs3 = 0.f;
#pragma unroll
            for (int r = 0; r < 16; r += 2) {
                if constexpr (NEGM) { p0[r] = __builtin_amdgcn_exp2f(p0[r]); p0[r + 1] = __builtin_amdgcn_exp2f(p0[r + 1]); p1[r] = __builtin_amdgcn_exp2f(p1[r]); p1[r + 1] = __builtin_amdgcn_exp2f(p1[r + 1]); }
                else { p0[r] = __builtin_amdgcn_exp2f(p0[r] - mrun); p0[r + 1] = __builtin_amdgcn_exp2f(p0[r + 1] - mrun); p1[r] = __builtin_amdgcn_exp2f(p1[r] - mrun); p1[r + 1] = __builtin_amdgcn_exp2f(p1[r + 1] - mrun); }
                rs0 += p0[r]; rs1 += p0[r + 1]; rs2 += p1[r]; rs3 += p1[r + 1];
            }
            lrun += (rs0 + rs1) + (rs2 + rs3);
            bf16x8 pw[4];
#pragma unroll
            for (int ks = 0; ks < 4; ++ks) { u32x4 w;
                if (ks < 2) { const int b = 8 * (ks & 1); w.x = pk2(p0[b], p0[b + 1]); w.y = pk2(p0[b + 2], p0[b + 3]); w.z = pk2(p0[b + 4], p0[b + 5]); w.w = pk2(p0[b + 6], p0[b + 7]); }
                else { const int b = 8 * (ks & 1); w.x = pk2(p1[b], p1[b + 1]); w.y = pk2(p1[b + 2], p1[b + 3]); w.z = pk2(p1[b + 4], p1[b + 5]); w.w = pk2(p1[b + 6], p1[b + 7]); }
                pw[ks] = __builtin_bit_cast(bf16x8, w); }
#pragma unroll
            for (int ks = 0; ks < 4; ++ks)
#pragma unroll
                for (int d = 0; d < NDB; ++d) {
                    const LAS unsigned char* vp = kb_ + voff + ((2 * ks) * NDB + d) * 512;
                    const s16x4 lo = __builtin_bit_cast(s16x4, __builtin_amdgcn_ds_read_tr16_b64_v4i16((LAS s16x4*)vp));
                    const s16x4 h4 = __builtin_bit_cast(s16x4, __builtin_amdgcn_ds_read_tr16_b64_v4i16((LAS s16x4*)(vp + NDB * 512)));
                    const bf16x8 vf = {lo[0], lo[1], lo[2], lo[3], h4[0], h4[1], h4[2], h4[3]};
                    o[d] = __builtin_amdgcn_mfma_f32_32x32x16_bf16(vf, pw[ks], o[d], 0, 0, 0);
                }
        }
        if (it + 1 < ntile) ATT_STORE(buf ^ 1);
        __syncthreads();
    }
#undef ATT_TILE
#undef ATT_LOAD
#undef ATT_STORE
    lrun += __shfl_xor(lrun, 32);
    const float inv = 1.f / lrun;
    bf16* orow = a.o + (size_t)(wave * 32 + r32) * a.opitch + 4 * hi;
    if (a.mode == 2) {
        float ss = 0.f;
#pragma unroll
        for (int d = 0; d < NDB; ++d)
#pragma unroll
            for (int g = 0; g < 4; ++g) { const u32x2 w = *(const u32x2*)(orow + 32 * d + 8 * g);
                const float o1[4] = {bf2f(w.x & 0xffff), bf2f(w.x >> 16), bf2f(w.y & 0xffff), bf2f(w.y >> 16)};
#pragma unroll
                for (int e = 0; e < 4; ++e) { const float dl = o1[e] - a.lam * (o[d][4 * g + e] * inv); o[d][4 * g + e] = dl; ss += dl * dl; } }
        ss += __shfl_xor(ss, 32);
        const float rs = rsqrtf(ss * (1.f / (float)DV) + EPSN) * a.post;
#pragma unroll
        for (int d = 0; d < NDB; ++d)
#pragma unroll
            for (int g = 0; g < 4; ++g) { const f32x4 sl = *(const f32x4*)(a.subln + 32 * d + 8 * g + 4 * hi);
                u32x2 w; w.x = pk2(o[d][4 * g] * rs * sl[0], o[d][4 * g + 1] * rs * sl[1]); w.y = pk2(o[d][4 * g + 2] * rs * sl[2], o[d][4 * g + 3] * rs * sl[3]);
                *(u32x2*)(orow + 32 * d + 8 * g) = w; }
    } else {
#pragma unroll
        for (int d = 0; d < NDB; ++d)
#pragma unroll
            for (int g = 0; g < 4; ++g) { u32x2 w; w.x = pk2(o[d][4 * g] * inv, o[d][4 * g + 1] * inv); w.y = pk2(o[d][4 * g + 2] * inv, o[d][4 * g + 3] * inv);
                *(u32x2*)(orow + 32 * d + 8 * g) = w; }
    }
}

__device__ __forceinline__ void phase_attn_even(const Ctx& F, const Args& args, int L, bool want_ctx) {
    const bf16* P = (const bf16*)(F.ws + WS_P); const bf16* QM = (const bf16*)(F.ws + WS_QM); const bf16* KVM = (const bf16*)(F.ws + WS_KVM); bf16* O = (bf16*)(F.ws + WS_O);
    const int pr = L >> 1;
    const float lam_init = (L == 0) ? 0.2f : 0.47071302f;
    float lam;
    { const float* lp = args.in[15] + pr * 256; const float sa = wave_sum(lp[F.lane] * lp[64 + F.lane]), sb = wave_sum(lp[128 + F.lane] * lp[192 + F.lane]); lam = __expf(sa) - __expf(sb) + lam_init; }
    const float* subln = args.in[16] + pr * 128;
    const int n0 = 1024, n1 = 2048, n2 = want_ctx ? 128 : 0, n3 = want_ctx ? 256 : 0, ntot = n0 + n1 + n2 + n3;
    for (int u = F.vcu; u < ntot; u += F.G) {
        AttnP a; a.kb = nullptr; a.kbpitch = 0; a.tB0 = 0; a.nB = 0; a.rope_t0 = -1; a.mode = 0; a.lam = lam; a.post = 1.f - lam_init; a.subln = subln; a.na_row0 = 0;
        int cls, uu = u;
        if (uu < n0) cls = 0; else if ((uu -= n0) < n1) cls = 1; else if ((uu -= n1) < n2) cls = 2; else { uu -= n2; cls = 3; }
        if (cls == 0 || cls == 2) {
            int b, h, row0;
            if (cls == 0) { const int bh = uu >> 3, qb = uu & 7; b = bh >> 2; h = bh & 3; row0 = b * RPB + CTXL + 256 * qb; a.nA = 36; }
            else { b = uu >> 2; h = uu & 3; row0 = b * RPB; a.nA = 4; }
            const size_t base = (size_t)b * RPB;
            a.qpitch = PE; a.kapitch = PE; a.vpitch = PE; a.opitch = DM;
            a.v = P + base * PE + E_DV + h * 128; a.o = O + (size_t)row0 * DM + 512 + h * 128;
            for (int m = 0; m < 2; ++m) {
                a.q = P + (size_t)row0 * PE + E_DQ + h * 128 + m * 64; a.ka = P + base * PE + E_DK + h * 128 + m * 64; a.mode = 1 + m;
                attn_unit<64, 128, false>(a, F.lds, nullptr, F.tid);
            }
        } else {
            int b, h, row0;
            if (cls == 1) { const int bh = uu >> 3, qb = uu & 7; b = bh >> 3; h = bh & 7; row0 = b * RPB + CTXL + 256 * qb; a.nA = 36; a.rope_t0 = 256 * qb; }
            else { b = uu >> 3; h = uu & 7; row0 = b * RPB; a.nA = 4; }
            const size_t base = (size_t)b * RPB;
            a.q = QM + (size_t)row0 * 768 + h * 96; a.qpitch = 768; a.ka = KVM + base * 1024 + h * 128; a.kapitch = 1024; a.kb = P + base * PE + E_KR; a.kbpitch = PE;
            a.v = KVM + base * 1024 + h * 128 + 64; a.vpitch = 1024; a.o = O + (size_t)row0 * DM + h * 64; a.opitch = DM;
            attn_unit<96, 64, false>(a, F.lds, nullptr, F.tid);
        }
    }
}
__device__ __forceinline__ void phase_attn_odd(const Ctx& F, const Args& args, int L, bool want_ctx) {
    const bf16* P = (const bf16*)(F.ws + WS_P); bf16* O = (bf16*)(F.ws + WS_O);
    const int pr = L >> 1;
    const float* rpb = args.in[20] + (size_t)pr * 8 * 15 * 31;
    LAS float* biasT = (LAS float*)(F.lds + 65536);
    const int n0 = 2048, n1 = 2048, n2 = want_ctx ? 256 : 0, n3 = want_ctx ? 256 : 0, ntot = n0 + n1 + n2 + n3;
    for (int u = F.vcu; u < ntot; u += F.G) {
        AttnP a; a.kb = nullptr; a.kbpitch = 0; a.tB0 = 0; a.nB = 0; a.rope_t0 = -1; a.mode = 0; a.lam = 0.f; a.post = 1.f; a.subln = nullptr; a.na_row0 = 0;
        a.qpitch = PO; a.kapitch = PO; a.vpitch = PO; a.opitch = DM;
        int cls, uu = u;
        if (uu < n0) cls = 0; else if ((uu -= n0) < n1) cls = 1; else if ((uu -= n1) < n2) cls = 2; else { uu -= n2; cls = 3; }
        int b, h, row0, qb = 0;
        if (cls < 2) { const int bh = uu >> 3; qb = uu & 7; b = bh >> 3; h = bh & 7; row0 = b * RPB + CTXL + 256 * qb; }
        else { b = uu >> 3; h = uu & 7; row0 = b * RPB; }
        const size_t base = (size_t)b * RPB;
        if (cls == 0 || cls == 2) {
            a.q = P + (size_t)row0 * PO + h * 64; a.ka = P + base * PO + O_GK + (h >> 2) * 64; a.v = P + base * PO + O_GV + (h >> 2) * 64; a.o = O + (size_t)row0 * DM + h * 64;
            a.nA = (cls == 0) ? 36 : 4;
            attn_unit<64, 64, false>(a, F.lds, nullptr, F.tid);
        } else {
            a.q = P + (size_t)row0 * PO + O_NQ + h * 64; a.ka = P + base * PO + O_NK + h * 64; a.v = P + base * PO + O_NV + h * 64; a.o = O + (size_t)row0 * DM + 512 + h * 64;
            a.nA = 4;
            if (cls == 1) {
                const int rlo = 4 * qb, rmin = min(max(rlo - 4, 0), 24), rmax = min(max(rlo + 3 - 4, 0), 24) + 7;
                a.tB0 = 4 + rmin; a.nB = rmax - rmin + 1; a.na_row0 = rlo;
                for (int e = F.tid; e < 15 * 32; e += NTHR) { const int rr = e >> 5, cc = e & 31; biasT[e] = (cc < 31) ? rpb[(h * 15 + rr) * 31 + cc] * LOG2E : 0.f; }
                attn_unit<64, 64, true>(a, F.lds, biasT, F.tid);
            } else {
                attn_unit<64, 64, false>(a, F.lds, nullptr, F.tid);
            }
        }
    }
}

constexpr int N_PHASES = 2 + 9 * DEPTH;
#ifndef REP_ATTN
#define REP_ATTN 1
#endif
#ifndef REP_GEMM
#define REP_GEMM 1
#endif
#ifndef EN_PRO
#define EN_PRO 1
#endif
#ifndef EN_ROW
#define EN_ROW 1
#endif
#ifndef EN_PREP
#define EN_PREP 1
#endif
#ifndef EN_AE
#define EN_AE 1
#endif
#ifndef EN_AO
#define EN_AO 1
#endif
#ifndef EN_GEMM
#define EN_GEMM 1
#endif
__global__ void __launch_bounds__(NTHR, 2) fwd_kernel(Args args) {
    extern __shared__ __attribute__((aligned(16))) unsigned char lds_raw[];
    cg::grid_group grid = cg::this_grid();
    Ctx F;
    F.lds = (LAS unsigned char*)lds_raw;
    F.G = gridDim.x; { const int bx = blockIdx.x; F.vcu = (F.G % 8 == 0) ? (bx % 8) * (F.G / 8) + bx / 8 : bx; }
    F.out = args.out; F.ws = args.ws;
    const int lo = args.ph_lo, hi = args.ph_hi;
    for (int ph = lo; ph < hi; ++ph) {
        { int t_ = threadIdx.x; asm volatile("" : "+v"(t_)); F.tid = t_; F.lane = t_ & 63; F.wave = __builtin_amdgcn_readfirstlane(t_ >> 6); }
        float* MOD = (float*)(F.ws + WS_MOD); float* HC = (float*)(F.ws + WS_HC); bf16* AF = (bf16*)(F.ws + WS_AF);
        const float* normg = args.in[6];
        const int L = (ph < 2) ? 0 : (ph - 2) / 9, k = (ph < 2) ? -1 : (ph - 2) % 9;
        const bool even = (L & 1) == 0, want_ctx = L < DEPTH - 1;
        unsigned char* wl = F.ws + WS_WT + (size_t)L * WL_STRIDE;
        if (ph == 0) { if (EN_PRO) phase_prologue_a(F, args); }
        else if (ph == 1 || k == 5 || k == 8) {
            const float* modL = MOD + (size_t)L * 33 * 6144;
            RowPassP p;
            p.AF = AF; p.hout_lat = F.out; p.hout_ctx = HC;
            if (ph == 1) { p.hin_lat = args.in[0]; p.hin_ctx = args.in[2]; p.g_post = normg; p.g_pre = normg; p.mod_post = MOD; p.mod_pre = MOD;
                p.gate_chunk = 0; p.shift_chunk = 0; p.scale_chunk = 1; p.has_f = 0; p.write_h = 0; p.write_a = 1; p.skip_ctx = 0; }
            else if (k == 5) { p.hin_lat = (L == 0) ? args.in[0] : F.out; p.hin_ctx = (L == 0) ? args.in[2] : HC; p.g_post = normg + (L * 4 + 1) * DM; p.g_pre = normg + (L * 4 + 2) * DM;
                p.mod_post = modL; p.mod_pre = modL; p.gate_chunk = 2; p.shift_chunk = 3; p.scale_chunk = 4; p.has_f = 1; p.write_h = 1; p.write_a = 1; p.skip_ctx = 0; }
            else { const int Ln = (L + 1 < DEPTH) ? L + 1 : L;
                p.hin_lat = F.out; p.hin_ctx = HC; p.g_post = normg + (L * 4 + 3) * DM; p.g_pre = normg + (Ln * 4 + 0) * DM; p.mod_post = modL; p.mod_pre = MOD + (size_t)Ln * 33 * 6144;
                p.gate_chunk = 5; p.shift_chunk = 0; p.scale_chunk = 1; p.has_f = 1; p.write_h = 1; p.write_a = want_ctx ? 1 : 0; p.skip_ctx = want_ctx ? 0 : 1; }
            if (EN_ROW) phase_rowpass(F, p);
        }
        else if (k == 1) { if (EN_PREP) { if (even) phase_prep_even(F); else phase_prep_odd(F, args.in[19] + (L >> 1) * 128); } }
        else if (k == 3) { for (int rep_ = 0; rep_ < REP_ATTN; ++rep_) { if (even) { if (EN_AE) phase_attn_even(F, args, L, want_ctx); } else { if (EN_AO) phase_attn_odd(F, args, L, want_ctx); } } }
        else {
            const int ng = (k == 2) ? (even ? 2 : 0) : 1;
            for (int gi_ = 0; gi_ < ng * REP_GEMM; ++gi_) { const int gi = gi_ % ng;
                pg8::Gemm g; pg8::EpiStore E; E.act = 0;
                g.M = MROWS;
                if (k == 0) { g.A = AF; g.Bt = (const bf16*)(wl + WL_IN); g.N = even ? PE : PO; g.K = DM; g.lda = DM; E.O = (bf16*)(F.ws + WS_P); E.ldc = g.N; }
                else if (k == 2) {
                    if (gi == 0) { g.A = AF; g.Bt = (const bf16*)(wl + WL_UQ); g.N = 768; g.K = 256; g.lda = 256; E.O = (bf16*)(F.ws + WS_QM); E.ldc = 768; }
                    else { g.A = (const bf16*)(F.ws + WS_AF + 36 * MiB); g.Bt = (const bf16*)(wl + WL_UKV); g.N = 1024; g.K = 128; g.lda = 128; E.O = (bf16*)(F.ws + WS_KVM); E.ldc = 1024; } }
                else if (k == 4) { g.A = (const bf16*)(F.ws + WS_O); g.Bt = (const bf16*)(wl + WL_OUT); g.N = DM; g.K = DM; g.lda = DM; E.O = AF; E.ldc = DM; }
                else if (k == 6) { g.A = AF; g.Bt = (const bf16*)(wl + WL_FF1); g.N = DFF; g.K = DM; g.lda = DM; E.O = (bf16*)(F.ws + WS_H); E.ldc = DFF; E.act = 1; }
                else { g.A = (const bf16*)(F.ws + WS_H); g.Bt = (const bf16*)(wl + WL_FF2); g.N = DM; g.K = DFF; g.lda = DFF; E.O = AF; E.ldc = DM; }
                pg8::StaticOrder S; S.init(MROWS, g.N, F.G, (int)blockIdx.x);
                if (EN_GEMM) pg8::gemm_phase<pg8::EpiStore, pg8::StaticOrder, true, true>(F.lds, g, S, E);
            }
        }
        if (ph + 1 < hi) grid.sync();
    }
}

#ifndef SINGLE_LAUNCH
#define SINGLE_LAUNCH 1
#endif
extern "C" void kernel_launch(void* const* d_in, const int* in_sizes, int n_in, void* d_out, int out_size, void* d_ws, size_t ws_size, hipStream_t stream) {
    static int grid = 0;
    if (grid == 0) {
        if (n_in != 21 || out_size != NB * SEQ * DM || ws_size < WS_END) { fprintf(stderr, "kernel_launch: unexpected problem (n_in %d, out %d, ws %zu)\n", n_in, out_size, ws_size); grid = -1; return; }
        int dev = 0, cus = 0, per_cu = 0;
        hipGetDevice(&dev); hipDeviceGetAttribute(&cus, hipDeviceAttributeMultiprocessorCount, dev);
        hipFuncSetAttribute((const void*)fwd_kernel, hipFuncAttributeMaxDynamicSharedMemorySize, LDS_BYTES);
        hipOccupancyMaxActiveBlocksPerMultiprocessor(&per_cu, (const void*)fwd_kernel, NTHR, LDS_BYTES);
        if (per_cu < 1) per_cu = 1;
        grid = cus;
        (void)hipGetLastError();
    }
    if (grid < 0) return;
    Args a{};
    for (int i = 0; i < 21; ++i) a.in[i] = (const float*)d_in[i];
    a.out = (float*)d_out; a.ws = (unsigned char*)d_ws;
#if SINGLE_LAUNCH
    a.ph_lo = 0; a.ph_hi = N_PHASES;
    void* kargs[] = {&a};
    hipError_t e = hipLaunchCooperativeKernel((const void*)fwd_kernel, dim3(grid), dim3(NTHR), kargs, LDS_BYTES, stream);
    if (e != hipSuccess) fprintf(stderr, "cooperative launch failed: %s (grid %d)\n", hipGetErrorString(e), grid);
#else
    for (int ph = 0; ph < N_PHASES; ++ph) {
        if (ph >= 2) { const int L = (ph - 2) / 9, k = (ph - 2) % 9; if (k == 2 && (L & 1)) continue; }
        a.ph_lo = ph; a.ph_hi = ph + 1;
        hipLaunchKernelGGL(fwd_kernel, dim3(grid), dim3(NTHR), LDS_BYTES, stream, a);
    }
#endif
}
```

```cpp
#include <hip/hip_runtime.h>
#include <hip/hip_cooperative_groups.h>
#include <cstdio>
#include <cstdint>
namespace cg = cooperative_groups;
namespace pg8 {
#define PG8_LAS __attribute__((address_space(3)))
typedef unsigned short bf16_t;
typedef short bf16x8 __attribute__((ext_vector_type(8)));
typedef float f32x4 __attribute__((ext_vector_type(4)));
typedef unsigned u32x4 __attribute__((ext_vector_type(4)));
constexpr int BM = 256, BK = 64, HALF = 128, HTB = HALF * BK * 2  , STAGE_BYTES = 8 * HTB, NXCD = 8, WGM = 8;

__host__ __device__ __forceinline__ int lds_byte(int r, int c) { const int st = (r >> 4) * 2 + (c >> 5), rr = r & 15, cc = c & 31, ob = rr * 64 + cc * 2; return st * 1024 + (ob ^ (((ob >> 9) & 1) << 5)); }
__host__ __device__ __forceinline__ void stage_rc(int b, int& R, int& C) { const int st = b / 1024, sb = b % 1024, swz = sb ^ (((sb >> 9) & 1) << 5); R = (st >> 1) * 16 + swz / 64; C = (st & 1) * 32 + (swz % 64) / 2; }
__host__ __device__ __forceinline__ int perm32(int rho) { const int n = rho >> 4, i = rho & 15; return 8 * (i >> 2) + 4 * n + (i & 3); }

struct Unit { int pm, pn; };
struct Gemm { const bf16_t* A; const bf16_t* Bt; int M, N, K, lda; };

struct StaticOrder {
    int rev;
    int nM, nN, nwg, G, c, skipc;
    __host__ __device__ void init(int M, int N, int G_, int c_, int skipc_ = 0) { nM = M / BM; if (skipc_) nM = nM / 9 * 8; nN = N / BM; nwg = nM * nN; G = G_; c = c_; skipc = skipc_; rev = 0; }
    __host__ __device__ bool next(int i, Unit& u) const {
        const long L = (long)i * G + c; if (L >= nwg) return false;
        int wgid = (int)L; { const int q = nwg / NXCD, r = nwg % NXCD, xcd = wgid % NXCD, off = wgid / NXCD; wgid = (xcd < r ? xcd * (q + 1) : r * (q + 1) + (xcd - r) * q) + off; }
        const int nig = WGM * nN, gid = wgid / nig, fm = gid * WGM, gsz = (nM - fm) < WGM ? (nM - fm) : WGM;
        u.pm = fm + ((wgid % nig) % gsz); u.pn = (wgid % nig) / gsz; if (rev) u.pm = nM - 1 - u.pm; if (skipc) u.pm = u.pm + u.pm / 8 + 1; return true;
    }
    __device__ __forceinline__ void a_ready(const Unit&) const {}
    __device__ __forceinline__ void done(const Unit&) const {}
};

__device__ __forceinline__ unsigned cvt_pk_bf16(float lo, float hi) { unsigned r; asm volatile("v_cvt_pk_bf16_f32 %0, %1, %2" : "=v"(r) : "v"(lo), "v"(hi)); return r; }
template <class Epi, class Sched, bool ALIGN_EPI = false, bool SP2 = false>
__device__ __forceinline__ void gemm_phase(PG8_LAS unsigned char* lds, const Gemm g, const Sched& S, const Epi& E) {
    int tid_ = threadIdx.x; asm volatile("" : "+v"(tid_));
    const int tid = tid_, wid = __builtin_amdgcn_readfirstlane(tid >> 6), lane = tid & 63, wr = wid >> 2, wc = wid & 3, fr = lane & 15, fq = lane >> 4;
    const int K = g.K, nt = K / BK;
    unsigned voffA[2], voffB[2];
#pragma unroll
    for (int i = 0; i < 2; ++i) { int R, C; stage_rc(tid * 16 + i * 8192, R, C); const int Rb = Epi::PERM ? ((R & ~31) + perm32(R & 31)) : R;
        voffA[i] = (unsigned)(R * g.lda + C) * 2u; voffB[i] = (unsigned)(Rb * K + C) * 2u; }
    const size_t kstep = (size_t)(BK * 2);
    const size_t hstep = (size_t)HALF * K * 2, hstepA = (size_t)HALF * g.lda * 2;
    const size_t tstep = 2 * hstep, tstepA = 2 * hstepA;
    const unsigned ldsw = (unsigned)wid * 1024u;
    const int aoff = lds_byte(wr * 64 + fr, fq * 8), boff = lds_byte(wc * 32 + fr, fq * 8);
#define PG8_SA(b, h) (((b) * 2 + (h)) * HTB)
#define PG8_SB(b, h) ((4 + (b) * 2 + (h)) * HTB)
#define PG8_STAGE(bufoff, gbase, voff) do { _Pragma("unroll") for (int _i = 0; _i < 2; ++_i) \
        __builtin_amdgcn_global_load_lds((const unsigned*)((const char*)(gbase) + (voff)[_i]), (PG8_LAS unsigned*)(lds + (bufoff) + ldsw + _i * 8192), 16, 0, 0); } while (0)
#define PG8_LDA(dst, b, h) do { _Pragma("unroll") for (int m = 0; m < 4; ++m) _Pragma("unroll") for (int k = 0; k < 2; ++k) dst[m][k] = *(const PG8_LAS bf16x8*)(lds + PG8_SA(b, h) + aoff + m * 2048 + k * 1024); } while (0)
#define PG8_LDB(dst, b, h) do { _Pragma("unroll") for (int n = 0; n < 2; ++n) _Pragma("unroll") for (int k = 0; k < 2; ++k) dst[n][k] = *(const PG8_LAS bf16x8*)(lds + PG8_SB(b, h) + boff + n * 2048 + k * 1024); } while (0)
#define PG8_MMA(ai, bj, At, Bt) do { __builtin_amdgcn_s_setprio(1); _Pragma("unroll") for (int m = 0; m < 4; ++m) _Pragma("unroll") for (int n = 0; n < 2; ++n) _Pragma("unroll") for (int k = 0; k < 2; ++k) \
        acc[ai][bj][m][n] = __builtin_amdgcn_mfma_f32_16x16x32_bf16(Bt[n][k], At[m][k], acc[ai][bj][m][n], 0, 0, 0); __builtin_amdgcn_s_setprio(0); } while (0)
#define PG8_WAIT_V(n) asm volatile("s_waitcnt vmcnt(" #n ")" ::: "memory")
#define PG8_WAIT_L(n) asm volatile("s_waitcnt lgkmcnt(" #n ")" ::: "memory")
#define PG8_BAR __builtin_amdgcn_s_barrier()
#define PG8_SCHED __builtin_amdgcn_sched_barrier(0)
    Unit cur, nxt; int ui = 0;
    if (!S.next(0, cur)) return;
    f32x4 acc[2][2][4][2];
#pragma unroll
    for (int a = 0; a < 2; ++a)
#pragma unroll
        for (int b = 0; b < 2; ++b)
#pragma unroll
            for (int m = 0; m < 4; ++m)
#pragma unroll
                for (int n = 0; n < 2; ++n) acc[a][b][m][n] = (f32x4){0.f, 0.f, 0.f, 0.f};
    bf16x8 At[4][2], B0[2][2], B1[2][2];
    const char* cA = (const char*)g.A + (size_t)cur.pm * tstepA; const char* cB = (const char*)g.Bt + (size_t)cur.pn * tstep;
    S.a_ready(cur);
    if constexpr (SP2) {
        PG8_STAGE(PG8_SB(0, 0), cB, voffB); PG8_STAGE(PG8_SB(0, 1), cB + hstep, voffB); PG8_STAGE(PG8_SA(0, 0), cA, voffA); PG8_STAGE(PG8_SA(0, 1), cA + hstepA, voffA);
        if (wr == 1) PG8_BAR;
        PG8_WAIT_V(2); PG8_BAR;
        PG8_STAGE(PG8_SB(1, 0), cB + kstep, voffB); PG8_STAGE(PG8_SA(1, 0), cA + kstep, voffA); PG8_STAGE(PG8_SB(1, 1), cB + hstep + kstep, voffB);
        PG8_WAIT_V(6); PG8_BAR;
    } else {
        PG8_STAGE(PG8_SB(0, 0), cB, voffB); PG8_STAGE(PG8_SA(0, 0), cA, voffA); PG8_STAGE(PG8_SB(0, 1), cB + hstep, voffB); PG8_STAGE(PG8_SA(0, 1), cA + hstepA, voffA);
        if (wr == 1) PG8_BAR;
        PG8_WAIT_V(4); PG8_BAR;
        PG8_STAGE(PG8_SB(1, 0), cB + kstep, voffB); PG8_STAGE(PG8_SA(1, 0), cA + kstep, voffA); PG8_STAGE(PG8_SB(1, 1), cB + hstep + kstep, voffB);
        PG8_WAIT_V(6); PG8_BAR;
    }
    for (;;) {
        const bool has_next = S.next(ui + 1, nxt);
        const char* nA = has_next ? (const char*)g.A + (size_t)nxt.pm * tstepA : cA; const char* nB = has_next ? (const char*)g.Bt + (size_t)nxt.pn * tstep : cB;
        for (int t = 0; t < nt; t += 2) {
            const bool last = (t == nt - 2);
            const char* a1 = cA + (size_t)(t + 1) * kstep;
            const char* a2 = last ? nA : cA + (size_t)(t + 2) * kstep; const char* b2 = last ? nB : cB + (size_t)(t + 2) * kstep;
            const char* a3 = a2 + kstep; const char* b3 = b2 + kstep;
            if (last && has_next) S.a_ready(nxt);
            if constexpr (SP2) {
            PG8_LDB(B0, 0, 0); PG8_LDB(B1, 0, 1); PG8_SCHED; PG8_LDA(At, 0, 0); PG8_STAGE(PG8_SA(1, 1), a1 + hstepA, voffA);
            PG8_WAIT_V(8); PG8_WAIT_L(0); PG8_BAR; PG8_MMA(0, 0, At, B0); PG8_MMA(0, 1, At, B1); PG8_BAR; PG8_SCHED;
            PG8_LDA(At, 0, 1); PG8_STAGE(PG8_SB(0, 0), b2, voffB); PG8_STAGE(PG8_SB(0, 1), b2 + hstep, voffB); PG8_STAGE(PG8_SA(0, 0), a2, voffA);
            PG8_WAIT_V(8); PG8_WAIT_L(0); PG8_BAR; PG8_MMA(1, 0, At, B0); PG8_MMA(1, 1, At, B1); PG8_BAR; PG8_SCHED;
            PG8_LDB(B0, 1, 0); PG8_LDB(B1, 1, 1); PG8_SCHED; PG8_LDA(At, 1, 0); PG8_STAGE(PG8_SA(0, 1), a2 + hstepA, voffA);
            PG8_WAIT_V(8); PG8_WAIT_L(0); PG8_BAR; PG8_MMA(0, 0, At, B0); PG8_MMA(0, 1, At, B1); PG8_BAR; PG8_SCHED;
            PG8_LDA(At, 1, 1); PG8_STAGE(PG8_SB(1, 0), b3, voffB); PG8_STAGE(PG8_SB(1, 1), b3 + hstep, voffB); PG8_STAGE(PG8_SA(1, 0), a3, voffA);
            PG8_WAIT_V(8); PG8_WAIT_L(0); PG8_BAR; PG8_MMA(1, 0, At, B0); PG8_MMA(1, 1, At, B1); PG8_BAR; PG8_SCHED;
            } else {
            PG8_LDB(B0, 0, 0); PG8_SCHED; PG8_LDA(At, 0, 0); PG8_STAGE(PG8_SA(1, 1), a1 + hstepA, voffA);
            PG8_WAIT_L(8); PG8_BAR; PG8_WAIT_L(0); PG8_MMA(0, 0, At, B0); PG8_BAR; PG8_SCHED;
            PG8_LDB(B1, 0, 1); PG8_STAGE(PG8_SB(0, 0), b2, voffB);
            PG8_BAR; PG8_WAIT_L(0); PG8_MMA(0, 1, At, B1); PG8_BAR;
            PG8_LDA(At, 0, 1); PG8_STAGE(PG8_SA(0, 0), a2, voffA);
            PG8_BAR; PG8_WAIT_L(0); PG8_MMA(1, 0, At, B0); PG8_BAR; PG8_SCHED;
            PG8_STAGE(PG8_SB(0, 1), b2 + hstep, voffB);
            PG8_WAIT_V(6); PG8_BAR; PG8_MMA(1, 1, At, B1); PG8_BAR;
            PG8_LDB(B0, 1, 0); PG8_SCHED; PG8_LDA(At, 1, 0); PG8_STAGE(PG8_SA(0, 1), a2 + hstepA, voffA);
            PG8_WAIT_L(8); PG8_BAR; PG8_WAIT_L(0); PG8_MMA(0, 0, At, B0); PG8_BAR; PG8_SCHED;
            PG8_LDB(B1, 1, 1); PG8_STAGE(PG8_SB(1, 0), b3, voffB);
            PG8_BAR; PG8_WAIT_L(0); PG8_MMA(0, 1, At, B1); PG8_BAR;
            PG8_LDA(At, 1, 1); PG8_STAGE(PG8_SA(1, 0), a3, voffA);
            PG8_BAR; PG8_WAIT_L(0); PG8_MMA(1, 0, At, B0); PG8_BAR; PG8_SCHED;
            PG8_STAGE(PG8_SB(1, 1), b3 + hstep, voffB);
            PG8_WAIT_V(6); PG8_BAR; PG8_MMA(1, 1, At, B1); PG8_BAR;
            }
        }
        if constexpr (ALIGN_EPI) { if (wr == 0) PG8_BAR; }
        if constexpr (!Epi::AFTER_DRAIN) { E(acc, cur, wr, wc, fr, fq); S.done(cur); }
        if (!has_next) break;
#pragma unroll
        for (int a = 0; a < 2; ++a)
#pragma unroll
            for (int b = 0; b < 2; ++b)
#pragma unroll
                for (int m = 0; m < 4; ++m)
#pragma unroll
                    for (int n = 0; n < 2; ++n) acc[a][b][m][n] = (f32x4){0.f, 0.f, 0.f, 0.f};
        cur = nxt; cA = nA; cB = nB; ++ui;
        if constexpr (ALIGN_EPI) { if (wr == 1) PG8_BAR; }
    }
    PG8_WAIT_V(0);
    if constexpr (!ALIGN_EPI) { if (wr == 0) PG8_BAR; }
    PG8_BAR;
    if constexpr (Epi::AFTER_DRAIN) { E.fused(acc, cur, wr, wc, fr, fq, lds, wid, lane); S.done(cur); }
#undef PG8_SA
#undef PG8_SB
#undef PG8_STAGE
#undef PG8_LDA
#undef PG8_LDB
#undef PG8_MMA
#undef PG8_WAIT_V
#undef PG8_WAIT_L
#undef PG8_BAR
#undef PG8_SCHED
}
}
namespace pg8 {
struct EpiStore {
    static constexpr bool PERM = true, AFTER_DRAIN = false;
    bf16_t* O; int ldc; int act;
    __device__ __forceinline__ void operator()(const f32x4 (&acc)[2][2][4][2], const Unit& u, int wr, int wc, int fr, int fq) const {
        const int row0 = u.pm * BM + wr * 64 + fr; const int col0 = u.pn * BM + wc * 32 + 8 * fq;
#pragma unroll
        for (int ai = 0; ai < 2; ++ai)
#pragma unroll
            for (int m = 0; m < 4; ++m) { bf16_t* rowp = O + (size_t)(row0 + ai * HALF + m * 16) * ldc + col0;
#pragma unroll
                for (int bj = 0; bj < 2; ++bj) { f32x4 v0 = acc[ai][bj][m][0], v1 = acc[ai][bj][m][1];
                    if (act == 1) {
#pragma unroll
                        for (int e = 0; e < 4; ++e) { float a = fmaxf(v0[e], 0.f), b = fmaxf(v1[e], 0.f); v0[e] = a * a; v1[e] = b * b; } }
                    u32x4 w; w.x = cvt_pk_bf16(v0[0], v0[1]); w.y = cvt_pk_bf16(v0[2], v0[3]); w.z = cvt_pk_bf16(v1[0], v1[1]); w.w = cvt_pk_bf16(v1[2], v1[3]);
                    *(u32x4*)(rowp + bj * HALF) = w; } }
    }
};
}
#define LAS __attribute__((address_space(3)))
#define GAS __attribute__((address_space(1)))
typedef unsigned v4u __attribute__((ext_vector_type(4)));
typedef GAS unsigned gu32;
typedef GAS unsigned long long gu64;
#define RLX_AGENT __ATOMIC_RELAXED, __HIP_MEMORY_SCOPE_AGENT
#define LDS_WAIT() asm volatile("s_waitcnt lgkmcnt(0)" ::: "memory")
#define VM_WAIT() asm volatile("s_waitcnt vmcnt(0)" ::: "memory")
__device__ __forceinline__ unsigned long long rt() { return __builtin_amdgcn_s_memrealtime(); }
#define XB_TMO      128
#define XB_XCNT(j)  (256  + 64 * (j))
#define XB_XSUB(j)  (1280 + 64 * (j))
#define XB_XGEN(j)  (2304 + 64 * (j))
#define XB_TOP      3328
#define XB_TOPGEN   3392
#define XCD_BAR_WORDS 3456
#define XB_SPIN_CAP (1u << 22)

__device__ __forceinline__ unsigned xb_ld(unsigned* p)              { return __hip_atomic_load(p, __ATOMIC_RELAXED, __HIP_MEMORY_SCOPE_AGENT); }
__device__ __forceinline__ unsigned xb_add(unsigned* p, unsigned v) { return __hip_atomic_fetch_add(p, v, __ATOMIC_RELAXED, __HIP_MEMORY_SCOPE_AGENT); }
__device__ __forceinline__ unsigned xb_xcc_id() { return (unsigned)__builtin_amdgcn_s_getreg((3 << 11) | 20) & 0xFu; }
#define XB_SPIN(cond, bar) do { unsigned _sp = 0; while (cond) { __builtin_amdgcn_s_sleep(1); \
    if ((++_sp & 255u) == 0u) { if (xb_ld(&(bar)[XB_TMO])) break; if (_sp > XB_SPIN_CAP) { atomicAdd(&(bar)[XB_TMO], 1u); break; } } } } while (0)

struct XcdBarrier {
    unsigned* bar; unsigned x;
    volatile LAS unsigned* st;
};

__device__ __forceinline__ XcdBarrier xcd_barrier_post(unsigned* bar, volatile LAS unsigned* st) {
    XcdBarrier b; b.bar = bar; b.x = xb_xcc_id(); b.st = st;
    if (threadIdx.x == 0) (void)xb_add(&bar[XB_XCNT(b.x)], 1u);
    return b;
}
__device__ __forceinline__ void xcd_barrier_complete(unsigned* bar, unsigned x, unsigned& nloc, unsigned& nx) {
    const unsigned G = gridDim.x * gridDim.y * gridDim.z;
    unsigned sum, cnt, mine, sp = 0u;
    for (;;) {
        sum = 0u; cnt = 0u; mine = 0u;
#pragma unroll
        for (unsigned j = 0; j < 16; ++j) { const unsigned c = xb_ld(&bar[XB_XCNT(j)]); sum += c; cnt += (c > 0u) ? 1u : 0u; mine = (j == x) ? c : mine; }
        if (sum == G) break;
        __builtin_amdgcn_s_sleep(1);
        if ((++sp & 255u) == 0u) { if (xb_ld(&bar[XB_TMO])) break; if (sp > XB_SPIN_CAP) { atomicAdd(&bar[XB_TMO], 1u); break; } }
    }
    nloc = mine > 0u ? mine : 1u; nx = cnt > 0u ? cnt : 1u;
}

__device__ __forceinline__ void xcd_barrier(const XcdBarrier& b) {
    asm volatile("s_waitcnt vmcnt(0)" ::: "memory");
    __syncthreads();
    if (threadIdx.x == 0) {
        unsigned* bar = b.bar;
        __builtin_amdgcn_s_waitcnt(0);
        unsigned nloc = b.st[0], nx = b.st[1];
        if (nloc == 0u) { xcd_barrier_complete(bar, b.x, nloc, nx); b.st[0] = nloc; b.st[1] = nx; }
        const unsigned old = xb_add(&bar[XB_XSUB(b.x)], 1u);
        const unsigned gen = old / nloc;
        if (old + 1u == (gen + 1u) * nloc) {
            __builtin_amdgcn_fence(__ATOMIC_RELEASE, "agent");
            asm volatile("s_waitcnt vmcnt(0)" ::: "memory");
            const unsigned og = xb_add(&bar[XB_TOP], 1u);
            const unsigned tg = og / nx;
            if (og + 1u == (tg + 1u) * nx) xb_add(&bar[XB_TOPGEN], 1u);
            else XB_SPIN(xb_ld(&bar[XB_TOPGEN]) == tg, bar);
            __builtin_amdgcn_fence(__ATOMIC_ACQUIRE, "agent");
            xb_add(&bar[XB_XGEN(b.x)], 1u);
            asm volatile("s_waitcnt vmcnt(0)" ::: "memory");
        } else {
            XB_SPIN(xb_ld(&bar[XB_XGEN(b.x)]) == gen, bar);
            __builtin_amdgcn_fence(__ATOMIC_ACQUIRE, "agent");
            asm volatile("s_waitcnt vmcnt(0)" ::: "memory");
        }
    }
    __syncthreads();
}

typedef unsigned short bf16;
typedef short bf16x8 __attribute__((ext_vector_type(8)));
typedef short s16x4 __attribute__((ext_vector_type(4)));
typedef float f32x4 __attribute__((ext_vector_type(4)));
typedef float f32x16 __attribute__((ext_vector_type(16)));
typedef unsigned u32x4 __attribute__((ext_vector_type(4)));
typedef unsigned u32x2 __attribute__((ext_vector_type(2)));

constexpr int DM = 1024, NB = 32, SEQ = 2048, CTXL = 256, RPB = SEQ + CTXL, MROWS = NB * RPB;
constexpr int DFF = 4096, DEPTH = 4, NWAVES = 8, NTHR = 512;
constexpr int PE = 2048, PO = 2304;
constexpr int E_CKV = 256, E_KR = 384, E_DQ = 416, E_DK = 928, E_DV = 1440;
constexpr int O_GK = 512, O_GV = 640, O_NQ = 768, O_NK = 1280, O_NV = 1792;
constexpr float EPSN = 1e-6f, LOG2E = 1.4426950408889634f, LOG2_THETA = 13.287712379549449f;
constexpr float MLA_SC = 0.10206207261596575f  , HD_SC = 0.125f;

constexpr size_t MiB = 1u << 20;
constexpr size_t WS_MOD = 0;
constexpr size_t WS_HB = 852 * MiB;
constexpr size_t WS_HCB = 980 * MiB;
constexpr size_t WS_WT = 36 * MiB;
constexpr size_t WS_AF = 132 * MiB;
constexpr size_t WS_P = 276 * MiB;
constexpr size_t WS_QM = 600 * MiB;
constexpr size_t WS_KVM = 708 * MiB;
constexpr size_t WS_O = WS_AF;
constexpr size_t WS_F1 = WS_P;
constexpr size_t WS_END = 996 * MiB;
constexpr size_t WS_H = WS_P;
constexpr size_t WL_STRIDE = 24 * MiB, WL_IN = 0, WL_OUT = 5 * MiB, WL_FF1 = 7 * MiB, WL_FF2 = 15 * MiB, WL_UQ = 23 * MiB, WL_UKV = 23 * MiB + 512 * 1024;
static_assert(WS_H + (size_t)MROWS * DFF * 2 <= WS_HB, "H overlay");
constexpr int LDS_BYTES = 147456, LDS_BARST = 147200;
constexpr size_t WS_BAR = 3 * MiB + 512 * 1024;

struct Args { const float* in[21]; float* out; unsigned char* ws; int ph_lo, ph_hi; };

__device__ __forceinline__ float bf2f(unsigned short b) { return __uint_as_float((unsigned)b << 16); }
typedef float f32x2_t __attribute__((ext_vector_type(2))); typedef __bf16 bf16x2_t __attribute__((ext_vector_type(2)));
__device__ __forceinline__ unsigned pk2(float lo, float hi) { f32x2_t v = {lo, hi}; bf16x2_t b = __builtin_convertvector(v, bf16x2_t); return __builtin_bit_cast(unsigned, b); }
__device__ __forceinline__ unsigned short f2bf(float f) { return (unsigned short)(pk2(f, 0.f) & 0xffffu); }
__device__ __forceinline__ float wave_sum(float v) {
#pragma unroll
    for (int o = 1; o < 64; o <<= 1) v += __shfl_xor(v, o);
    return v;
}
__device__ __forceinline__ float half_sum(float v) {
#pragma unroll
    for (int o = 1; o < 32; o <<= 1) v += __shfl_xor(v, o);
    return v;
}

__device__ __forceinline__ void transpose_item(const float* W, int K, int N, bf16* WT, LAS float* scr, int item, int lane, const float* kscale, float sc) {
    const int nblk = N / 32, kb = item / nblk, nb = item % nblk, k0 = 64 * kb, n0 = 32 * nb;
#pragma unroll
    for (int i = 0; i < 8; ++i) { const int kk = 8 * i + (lane >> 3); const f32x4 w = *(const f32x4*)(W + (size_t)(k0 + kk) * N + n0 + 4 * (lane & 7));
        const float s_ = kscale ? kscale[k0 + kk] * sc : sc;
#pragma unroll
        for (int j = 0; j < 4; ++j) scr[kk * 33 + 4 * (lane & 7) + j] = w[j] * s_; }
    asm volatile("s_waitcnt lgkmcnt(0)" ::: "memory");
    const int c = lane & 7;
#pragma unroll
    for (int j = 0; j < 4; ++j) { const int n = (lane >> 3) + 8 * j; const LAS float* s = scr + (8 * c) * 33 + n;
        u32x4 o; o.x = pk2(s[0 * 33], s[1 * 33]); o.y = pk2(s[2 * 33], s[3 * 33]); o.z = pk2(s[4 * 33], s[5 * 33]); o.w = pk2(s[6 * 33], s[7 * 33]);
        *(u32x4*)(WT + (size_t)(n0 + n) * K + k0 + 8 * c) = o; }
    asm volatile("s_waitcnt lgkmcnt(0)" ::: "memory");
}

struct Ctx {
    LAS unsigned char* lds; int tid, lane, wave, vcu, G;
    float* out; unsigned char* ws;
};

__device__ __forceinline__ void phase_prologue_a(const Ctx& F, const Args& args) {
    {
        LAS float* S = (LAS float*)F.lds;
        LAS float* R = (LAS float*)(F.lds + 33 * 512 * 4);
        const float* c = args.in[1]; const float* cc = args.in[3]; const float* wada = args.in[4]; const float* bada = args.in[5];
        float* MOD = (float*)(F.ws + WS_MOD);
        const int cg_ = F.lane & 31, kh = F.lane >> 5;
        for (int it = F.vcu; it < 4 * 192; it += F.G) {
            const int l = it / 192, n0 = (it % 192) * 32;
            float acc[33];
#pragma unroll
            for (int r = 0; r < 33; ++r) acc[r] = 0.f;
            for (int half = 0; half < 2; ++half) {
                __syncthreads();
                for (int e = F.tid; e < 33 * 512; e += NTHR) { const int r = e >> 9, k = (e & 511) + half * 512; const float v = (r < 32) ? c[r * 1024 + k] : cc[k]; S[e] = v / (1.f + __expf(-v)); }
                __syncthreads();
                const int kb = F.wave * 64 + kh * 32;
                const float* wp = wada + ((size_t)l * 1024 + half * 512 + kb) * 6144 + n0 + cg_;
                for (int kk = 0; kk < 32; kk += 4) {
                    const float w0 = wp[(size_t)(kk + 0) * 6144], w1 = wp[(size_t)(kk + 1) * 6144], w2 = wp[(size_t)(kk + 2) * 6144], w3 = wp[(size_t)(kk + 3) * 6144];
#pragma unroll
                    for (int r = 0; r < 33; ++r) { const f32x4 s = *(const LAS f32x4*)(S + r * 512 + kb + kk); acc[r] += s[0] * w0 + s[1] * w1 + s[2] * w2 + s[3] * w3; }
                }
            }
#pragma unroll
            for (int r = 0; r < 33; ++r) { acc[r] += __shfl_xor(acc[r], 32); if (kh == 0) R[(F.wave * 33 + r) * 32 + cg_] = acc[r]; }
            __syncthreads();
            for (int e = F.tid; e < 33 * 32; e += NTHR) { float s = 0.f;
#pragma unroll
                for (int w = 0; w < 8; ++w) s += R[w * 33 * 32 + e];
                const int r = e >> 5, n = n0 + (e & 31); MOD[((size_t)l * 33 + r) * 6144 + n] = s + bada[l * 6144 + n]; }
        }
        __syncthreads();
    }
    {
        LAS float* scr = (LAS float*)(F.lds + F.wave * 16384);
        const int gw = F.vcu * NWAVES + F.wave, NGW = F.G * NWAVES;
        constexpr int I_INE = 16 * 61, I_INO = 16 * 72, I_OUT = 16 * 32, I_FF1 = 16 * 128, I_FF2 = 64 * 32, I_UQ = 4 * 24, I_UKV = 2 * 32, I_Z = 96;
        constexpr int PER_E = I_INE + I_OUT + I_FF1 + I_FF2 + I_UQ + I_UKV + I_Z, PER_O = I_INO + I_OUT + I_FF1 + I_FF2;
        constexpr int NIT = 2 * (PER_E + PER_O);
        for (int it = gw; it < NIT; it += NGW) {
            int pr = it / (PER_E + PER_O), r = it % (PER_E + PER_O);
            const bool odd = r >= PER_E; if (odd) r -= PER_E;
            const int L = 2 * pr + (odd ? 1 : 0);
            unsigned char* wl = F.ws + WS_WT + (size_t)L * WL_STRIDE;
            const float* W; int K, N; size_t wo; const float* ks = nullptr; float sc = 1.f; bool zero = false;
            if (!odd) {
                if (r < I_INE) { W = args.in[9] + (size_t)pr * 1024 * 1952; K = 1024; N = 1952; wo = WL_IN; }
                else if ((r -= I_INE) < I_OUT) { W = args.in[10] + (size_t)pr * 1024 * 1024; K = 1024; N = 1024; wo = WL_OUT; }
                else if ((r -= I_OUT) < I_FF1) { W = args.in[7] + (size_t)L * 1024 * 4096; K = 1024; N = 4096; wo = WL_FF1; }
                else if ((r -= I_FF1) < I_FF2) { W = args.in[8] + (size_t)L * 4096 * 1024; K = 4096; N = 1024; wo = WL_FF2; }
                else if ((r -= I_FF2) < I_UQ) { W = args.in[12] + (size_t)pr * 256 * 768; K = 256; N = 768; wo = WL_UQ; ks = args.in[11] + pr * 256; sc = MLA_SC * LOG2E; }
                else if ((r -= I_UQ) < I_UKV) { W = args.in[14] + (size_t)pr * 128 * 1024; K = 128; N = 1024; wo = WL_UKV; ks = args.in[13] + pr * 128; }
                else { r -= I_UKV; zero = true; W = nullptr; K = 0; N = 0; wo = WL_IN; }
            } else {
                if (r < I_INO) { W = args.in[17] + (size_t)pr * 1024 * 2304; K = 1024; N = 2304; wo = WL_IN; }
                else if ((r -= I_INO) < I_OUT) { W = args.in[18] + (size_t)pr * 1024 * 1024; K = 1024; N = 1024; wo = WL_OUT; }
                else if ((r -= I_OUT) < I_FF1) { W = args.in[7] + (size_t)L * 1024 * 4096; K = 1024; N = 4096; wo = WL_FF1; }
                else { r -= I_FF1; W = args.in[8] + (size_t)L * 4096 * 1024; K = 4096; N = 1024; wo = WL_FF2; }
            }
            if (zero) { bf16* z = (bf16*)(wl + WL_IN) + (size_t)(1952 + r) * 1024; u32x4 zz = {0u, 0u, 0u, 0u}; *(u32x4*)(z + F.lane * 8) = zz; *(u32x4*)(z + 512 + F.lane * 8) = zz; }
            else transpose_item(W, K, N, (bf16*)(wl + wo), scr, r, F.lane, ks, sc);
        }
    }
}

__device__ __forceinline__ void unpack8(const u32x4 v, float* x) {
#pragma unroll
    for (int i = 0; i < 4; ++i) { x[2 * i] = __uint_as_float(v[i] << 16); x[2 * i + 1] = __uint_as_float(v[i] & 0xffff0000u); }
}
__device__ __forceinline__ u32x4 pack8(const float* x) { u32x4 w; w.x = pk2(x[0], x[1]); w.y = pk2(x[2], x[3]); w.z = pk2(x[4], x[5]); w.w = pk2(x[6], x[7]); return w; }
struct RowPassP { const void* hin_lat; const void* hin_ctx; bf16* hb_lat; bf16* hb_ctx; float* out32; const bf16* Fsrc; bf16* Adst; const float* g_post; const float* g_pre;
                  const float* mod_post; const float* mod_pre; int gate_chunk, shift_chunk, scale_chunk; int has_f, write_h, write_a, skip_ctx, final32; };
template <bool HIN32, bool HAS_F, bool WRITE_H, bool WRITE_A, bool FINAL32>
__device__ __forceinline__ void phase_rowpass(const Ctx& F, const RowPassP p) {
    const int nrows = p.skip_ctx ? NB * SEQ : MROWS;
    const int rpb_ = (nrows + F.G - 1) / F.G; const int cbeg = F.vcu * rpb_, cend = min(cbeg + rpb_, nrows);
    const int c0 = F.lane * 8;
    float gpo[16], gpr[16];
#pragma unroll
    for (int jj = 0; jj < 2; ++jj)
#pragma unroll
        for (int q = 0; q < 2; ++q) { const f32x4 a = *(const f32x4*)(p.g_post + jj * 512 + c0 + q * 4), b = *(const f32x4*)(p.g_pre + jj * 512 + c0 + q * 4);
#pragma unroll
            for (int e = 0; e < 4; ++e) { gpo[jj * 8 + q * 4 + e] = a[e]; gpr[jj * 8 + q * 4 + e] = b[e]; } }
    int cur = cbeg;
    while (cur < cend) {
        int b, j0, send;
        if (p.skip_ctx) { b = cur / SEQ; j0 = cur - b * SEQ + CTXL; send = min(cend, (b + 1) * SEQ); }
        else { b = cur / RPB; j0 = cur - b * RPB; send = min(cend, (j0 < CTXL) ? b * RPB + CTXL : (b + 1) * RPB); }
        const bool isc = j0 < CTXL; const int mrow = isc ? 32 : b; const int n = send - cur;
        const size_t hbase = isc ? (size_t)(b * CTXL + j0) * DM : (size_t)(b * SEQ + j0 - CTXL) * DM;
        const size_t rbase = (size_t)(b * RPB + j0) * DM;
        float gt[16], sh[16], sc[16];
        { const float* gp = p.mod_post + (size_t)mrow * 6144 + p.gate_chunk * 1024; const float* sp = p.mod_pre + (size_t)mrow * 6144 + p.shift_chunk * 1024; const float* cp = p.mod_pre + (size_t)mrow * 6144 + p.scale_chunk * 1024;
#pragma unroll
          for (int jj = 0; jj < 2; ++jj)
#pragma unroll
              for (int q = 0; q < 2; ++q) { const f32x4 a = *(const f32x4*)(gp + jj * 512 + c0 + q * 4), s1 = *(const f32x4*)(sp + jj * 512 + c0 + q * 4), s2 = *(const f32x4*)(cp + jj * 512 + c0 + q * 4);
#pragma unroll
                  for (int e = 0; e < 4; ++e) { gt[jj * 8 + q * 4 + e] = a[e]; sh[jj * 8 + q * 4 + e] = s1[e]; sc[jj * 8 + q * 4 + e] = 1.f + s2[e]; } } }
        const float* hin32 = (const float*)(isc ? p.hin_ctx : p.hin_lat) + hbase; const bf16* hinb = (const bf16*)(isc ? p.hin_ctx : p.hin_lat) + hbase;
        bf16* houtb = (isc ? p.hb_ctx : p.hb_lat) + hbase; float* hout32 = p.out32 + hbase;
        const bf16* fsrc = p.Fsrc + rbase; bf16* adst = p.Adst + rbase;
        f32x4 hn[HIN32 ? 4 : 1]; u32x4 hbn[HIN32 ? 1 : 2]; u32x4 fn[2];
#define RP_LOAD(i_) do { const size_t o_ = (size_t)(i_) * DM; \
            if constexpr (HIN32) { _Pragma("unroll") for (int jj_ = 0; jj_ < 2; ++jj_) { hn[jj_ * 2] = *(const f32x4*)(hin32 + o_ + jj_ * 512 + c0); hn[jj_ * 2 + 1] = *(const f32x4*)(hin32 + o_ + jj_ * 512 + c0 + 4); } } \
            else { _Pragma("unroll") for (int jj_ = 0; jj_ < 2; ++jj_) hbn[jj_] = __builtin_nontemporal_load((const u32x4*)(hinb + o_ + jj_ * 512 + c0)); } \
            if constexpr (HAS_F) { _Pragma("unroll") for (int jj_ = 0; jj_ < 2; ++jj_) fn[jj_] = *(const u32x4*)(fsrc + o_ + jj_ * 512 + c0); } } while (0)
        int i = F.wave;
        if (i < n) RP_LOAD(i);
        for (; i < n; i += NWAVES) {
            float h[16]; u32x4 fc[2];
#pragma unroll
            for (int jj = 0; jj < 2; ++jj) {
                if constexpr (HIN32) {
#pragma unroll
                    for (int e = 0; e < 4; ++e) { h[jj * 8 + e] = hn[jj * 2][e]; h[jj * 8 + 4 + e] = hn[jj * 2 + 1][e]; } }
                else unpack8(hbn[jj], h + jj * 8);
                if constexpr (HAS_F) fc[jj] = fn[jj]; }
            { const int inx = (i + NWAVES < n) ? i + NWAVES : i; RP_LOAD(inx); }
            const size_t ro = (size_t)i * DM;
            if constexpr (HAS_F) {
                float f[16]; float ss = 0.f;
                unpack8(fc[0], f); unpack8(fc[1], f + 8);
#pragma unroll
                for (int e = 0; e < 16; ++e) ss += f[e] * f[e];
                ss = wave_sum(ss); const float rs = rsqrtf(ss * (1.f / DM) + EPSN);
#pragma unroll
                for (int e = 0; e < 16; ++e) h[e] += gt[e] * (f[e] * rs * gpo[e]);
            }
            if constexpr (FINAL32) {
#pragma unroll
                for (int jj = 0; jj < 2; ++jj) { f32x4 a, c;
#pragma unroll
                    for (int e = 0; e < 4; ++e) { a[e] = h[jj * 8 + e]; c[e] = h[jj * 8 + 4 + e]; }
                    *(f32x4*)(hout32 + ro + jj * 512 + c0) = a; *(f32x4*)(hout32 + ro + jj * 512 + c0 + 4) = c; }
            }
            if constexpr (WRITE_H) {
#pragma unroll
                for (int jj = 0; jj < 2; ++jj) { const u32x4 w = pack8(h + jj * 8); __builtin_nontemporal_store(w, (u32x4*)(houtb + ro + jj * 512 + c0)); unpack8(w, h + jj * 8); }
            }
            if constexpr (WRITE_A) {
                float ss = 0.f;
#pragma unroll
                for (int e = 0; e < 16; ++e) ss += h[e] * h[e];
                ss = wave_sum(ss); const float rs = rsqrtf(ss * (1.f / DM) + EPSN);
#pragma unroll
                for (int jj = 0; jj < 2; ++jj) { float o[8];
#pragma unroll
                    for (int e = 0; e < 8; ++e) o[e] = (h[jj * 8 + e] * rs * gpr[jj * 8 + e]) * sc[jj * 8 + e] + sh[jj * 8 + e];
                    *(u32x4*)(adst + ro + jj * 512 + c0) = pack8(o); }
            }
        }
#undef RP_LOAD
        cur = send;
    }
}

__device__ __forceinline__ void rope_cs(int j, int i, int nfreq, float& cs, float& sn) {
    if (j < CTXL) { cs = 1.f; sn = 0.f; return; }
    const int t = j - CTXL; const int fi = (i < nfreq) ? i : i - nfreq; const float pos = (i < nfreq) ? (float)(t >> 6) : (float)(t & 63);
    const float ang = pos * exp2f(-(float)fi * (LOG2_THETA / (float)nfreq));
    cs = __cosf(ang); sn = __sinf(ang);
}
__device__ __forceinline__ void rope8(float* x, int lane, bool isx2, float pos, const float* finv, bool doit, float scale) {
    float y[8];
#pragma unroll
    for (int e = 0; e < 8; ++e) y[e] = __shfl_xor(x[e], 4);
    (void)lane;
#pragma unroll
    for (int e = 0; e < 8; ++e) {
        float cs = 1.f, sn = 0.f;
        if (doit) { const float ang = pos * finv[e]; cs = __cosf(ang); sn = __sinf(ang); }
        x[e] = (isx2 ? (x[e] * cs + y[e] * sn) : (x[e] * cs - y[e] * sn)) * scale;
    }
}
__device__ __forceinline__ void phase_prep_even(const Ctx& F) {
    bf16* P = (bf16*)(F.ws + WS_P); bf16* CQN = (bf16*)(F.ws + WS_AF); bf16* CKVN = (bf16*)(F.ws + WS_AF + 36 * MiB);
    const int gw = F.vcu * NWAVES + F.wave, NGW = F.G * NWAVES; const int lane = F.lane; const int chunk = (MROWS + NGW - 1) / NGW;
    const int r0 = gw * chunk, r1 = min(r0 + chunk, MROWS);
    if (r0 >= r1) return;
    const int ca = lane < 52 ? lane : 51;
    const int cv = lane & 7; const bool isx2 = (cv & 4) != 0; const bool colang = (cv & 2) != 0;
    float finv[8], finvk[8];
#pragma unroll
    for (int e = 0; e < 8; ++e) { finv[e] = exp2f(-(float)(8 * (cv & 1) + e) * (LOG2_THETA / 16.f)); finvk[e] = exp2f(-(float)e * (LOG2_THETA / 8.f)); }
    u32x4 na, nb, nc;
    { const bf16* pr = P + (size_t)r0 * PE; na = *(const u32x4*)(pr + 8 * ca); nb = *(const u32x4*)(pr + E_DQ + 8 * lane); nc = *(const u32x4*)(pr + E_DK + 8 * lane); }
    for (int r = r0; r < r1; ++r) {
        const u32x4 va = na, vb = nb, vc = nc;
        if (r + 1 < r1) { const bf16* pn = P + (size_t)(r + 1) * PE; na = *(const u32x4*)(pn + 8 * ca); nb = *(const u32x4*)(pn + E_DQ + 8 * lane); nc = *(const u32x4*)(pn + E_DK + 8 * lane); }
        const int j = r % RPB; const bool lat = j >= CTXL; const int t = j - CTXL;
        const float posh = colang ? (float)(t & 63) : (float)(t >> 6);
        bf16* pr = P + (size_t)r * PE;
        {
            float x[8]; unpack8(va, x);
            float ss = 0.f;
#pragma unroll
            for (int e = 0; e < 8; ++e) ss += x[e] * x[e];
            ss += __shfl_xor(ss, 1); ss += __shfl_xor(ss, 2); ss += __shfl_xor(ss, 4); ss += __shfl_xor(ss, 8);
            const float ss32 = ss + __shfl_xor(ss, 16);
            const float rs = (lane < 32) ? rsqrtf(ss32 * (1.f / 256.f) + EPSN) : rsqrtf(ss * (1.f / 128.f) + EPSN);
            float y[8];
#pragma unroll
            for (int e = 0; e < 8; ++e) y[e] = __shfl_xor(x[e], 2);
            if (lane < 32) { float o[8];
#pragma unroll
                for (int e = 0; e < 8; ++e) o[e] = x[e] * rs;
                *(u32x4*)(CQN + (size_t)r * 256 + 8 * lane) = pack8(o); }
            else if (lane < 48) { float o[8];
#pragma unroll
                for (int e = 0; e < 8; ++e) o[e] = x[e] * rs;
                *(u32x4*)(CKVN + (size_t)r * 128 + 8 * (lane - 32)) = pack8(o); }
            else if (lane < 52 && lat) { const float pos = (lane & 1) ? (float)(t & 63) : (float)(t >> 6); const bool x2 = (lane & 2) != 0; float o[8];
#pragma unroll
                for (int e = 0; e < 8; ++e) { const float ang = pos * finvk[e]; const float cs = __cosf(ang), sn = __sinf(ang); o[e] = x2 ? (x[e] * cs + y[e] * sn) : (x[e] * cs - y[e] * sn); }
                *(u32x4*)(pr + 8 * lane) = pack8(o); }
        }
        { float x[8]; unpack8(vb, x); rope8(x, lane, isx2, posh, finv, lat, HD_SC * LOG2E); *(u32x4*)(pr + E_DQ + 8 * lane) = pack8(x); }
        if (lat) { float x[8]; unpack8(vc, x); rope8(x, lane, isx2, posh, finv, true, 1.f); *(u32x4*)(pr + E_DK + 8 * lane) = pack8(x); }
    }
}
__device__ __forceinline__ void phase_prep_odd(const Ctx& F, const float* qkn  ) {
    bf16* P = (bf16*)(F.ws + WS_P);
    const int gw = F.vcu * NWAVES + F.wave, NGW = F.G * NWAVES; const int lane = F.lane; const int chunk = (MROWS + NGW - 1) / NGW;
    const int r0 = gw * chunk, r1 = min(r0 + chunk, MROWS);
    if (r0 >= r1) return;
    const int cv = lane & 7; const bool isx2 = (cv & 4) != 0; const bool colang = (cv & 2) != 0;
    float finv[8], gq[8], gk[8];
#pragma unroll
    for (int e = 0; e < 8; ++e) { finv[e] = exp2f(-(float)(8 * (cv & 1) + e) * (LOG2_THETA / 16.f)); gq[e] = qkn[8 * cv + e]; gk[e] = qkn[64 + 8 * cv + e]; }
    u32x4 na, nb, nc;
    { const bf16* pr = P + (size_t)r0 * PO; na = *(const u32x4*)(pr + 8 * lane); nb = *(const u32x4*)(pr + O_GK + 8 * (lane & 15)); nc = *(const u32x4*)(pr + O_NQ + 8 * lane); }
    for (int r = r0; r < r1; ++r) {
        const u32x4 va = na, vb = nb, vc = nc;
        if (r + 1 < r1) { const bf16* pn = P + (size_t)(r + 1) * PO; na = *(const u32x4*)(pn + 8 * lane); nb = *(const u32x4*)(pn + O_GK + 8 * (lane & 15)); nc = *(const u32x4*)(pn + O_NQ + 8 * lane); }
        const int j = r % RPB; const bool lat = j >= CTXL; const int t = j - CTXL;
        const float posh = colang ? (float)(t & 63) : (float)(t >> 6);
        bf16* pr = P + (size_t)r * PO;
        { float x[8]; unpack8(va, x); float ss = 0.f;
#pragma unroll
          for (int e = 0; e < 8; ++e) ss += x[e] * x[e];
          ss += __shfl_xor(ss, 1); ss += __shfl_xor(ss, 2); ss += __shfl_xor(ss, 4);
          const float rs = rsqrtf(ss * (1.f / 64.f) + EPSN);
#pragma unroll
          for (int e = 0; e < 8; ++e) x[e] *= rs * gq[e];
          rope8(x, lane, isx2, posh, finv, lat, HD_SC * LOG2E); *(u32x4*)(pr + 8 * lane) = pack8(x); }
        { float x[8]; unpack8(vb, x); float ss = 0.f;
#pragma unroll
          for (int e = 0; e < 8; ++e) ss += x[e] * x[e];
          ss += __shfl_xor(ss, 1); ss += __shfl_xor(ss, 2); ss += __shfl_xor(ss, 4);
          const float rs = rsqrtf(ss * (1.f / 64.f) + EPSN);
#pragma unroll
          for (int e = 0; e < 8; ++e) x[e] *= rs * gk[e];
          rope8(x, lane, isx2, posh, finv, lat, 1.f); if (lane < 16) *(u32x4*)(pr + O_GK + 8 * lane) = pack8(x); }
        { float x[8]; unpack8(vc, x);
#pragma unroll
          for (int e = 0; e < 8; ++e) x[e] *= (HD_SC * LOG2E);
          *(u32x4*)(pr + O_NQ + 8 * lane) = pack8(x); }
    }
}

struct AttnP {
    const bf16* q; int qpitch; const bf16* ka; int kapitch; const bf16* kb; int kbpitch; const bf16* v; int vpitch; bf16* o; int opitch;
    int nA, tB0, nB;
    int rope_t0;
    int mode;
    float lam, post; const float* subln;
    int na_row0;
};
__device__ __forceinline__ int crow(int r, int hi) { return (r & 3) + 8 * (r >> 2) + 4 * hi; }

struct AttnP2 { const bf16* qA; const bf16* qB; int qpitch; const bf16* ka; int kapitch; const bf16* v; int vpitch; bf16* oA; bf16* oB; int opitch; int ntile; };
__device__ __forceinline__ void attn_unit_gqa2(const AttnP2& a, LAS unsigned char* lds, int tid) {
    constexpr int DQK = 64, DV = 64, KP = DQK * 2 + 16, KBYTES = 64 * KP, VBYTES = 64 * DV * 2, BUF = KBYTES + VBYTES, KCH = DQK / 8, VCH = DV / 8, ND = DQK / 16, NDB = DV / 32;
    const int lane = tid & 63, wave = __builtin_amdgcn_readfirstlane(tid >> 6), r32 = lane & 31, hi = lane >> 5;
    bf16x8 qfA[ND], qfB[ND];
    { const size_t ro = (size_t)(wave * 32 + r32) * a.qpitch + hi * 8;
#pragma unroll
      for (int d0 = 0; d0 < ND; ++d0) { qfA[d0] = *(const bf16x8*)(a.qA + ro + d0 * 16); qfB[d0] = *(const bf16x8*)(a.qB + ro + d0 * 16); } }
    constexpr int KS = KP / 16, NIK = KS, NIV = VCH, NI = NIK + NIV, MAXI = (NI + 7) / 8;
    const bf16* gsrc[MAXI]; unsigned gstep[MAXI];
#pragma unroll
    for (int j = 0; j < MAXI; ++j) {
        const int ii = wave + 8 * j; const int s = ii * 64 + lane;
        if (ii < NIK) { const int row = s / KS; int ch = s - row * KS; if (ch >= KCH) ch = 0; gsrc[j] = a.ka + (size_t)row * a.kapitch + ch * 8; gstep[j] = 64u * (unsigned)a.kapitch; }
        else { const int s2 = (s - 64 * KS) & (64 * VCH - 1); const int st = s2 >> 5, rowin = (s2 & 31) >> 2, chin = s2 & 3; const int row = (st / NDB) * 8 + rowin, ch = (st % NDB) * 4 + chin;
            gsrc[j] = a.v + (size_t)row * a.vpitch + ch * 8; gstep[j] = 64u * (unsigned)a.vpitch; }
    }
    const int mycnt = (NI - 1 - wave) / 8 + 1;
    const int ntile = a.ntile;
#define ATT_ISSUE(tt_, slot_) do { _Pragma("unroll") for (int j_ = 0; j_ < MAXI; ++j_) if (wave + 8 * j_ < NI) \
        __builtin_amdgcn_global_load_lds((const unsigned*)(gsrc[j_] + (size_t)(tt_) * gstep[j_]), (LAS unsigned*)(lds + (slot_) * BUF + (wave + 8 * j_) * 1024), 16, 0, 0); } while (0)
#define ATT_WAITBAR(keep_) do { if (keep_) { if (mycnt == MAXI) asm volatile("s_waitcnt vmcnt(%0) lgkmcnt(0)\n\ts_barrier" :: "n"(MAXI) : "memory"); else asm volatile("s_waitcnt vmcnt(%0) lgkmcnt(0)\n\ts_barrier" :: "n"(MAXI - 1) : "memory"); } \
        else asm volatile("s_waitcnt vmcnt(0) lgkmcnt(0)\n\ts_barrier" ::: "memory"); } while (0)
    ATT_ISSUE(0, 0);
    if (ntile > 1) ATT_ISSUE(1, 1);
    ATT_WAITBAR(ntile > 1);
    constexpr float THR = 8.f;
    float mrunA = 0.f, lrunA = 0.f, mrunB = 0.f, lrunB = 0.f;
    f32x16 oA[NDB], oB[NDB];
#pragma unroll
    for (int d = 0; d < NDB; ++d) { oA[d] = f32x16{}; oB[d] = f32x16{}; }
    const int koff = r32 * KP + hi * 16;
    const int voff = KBYTES + (4 * hi + ((lane & 15) >> 2)) * 64 + ((lane >> 4) & 1) * 32 + (lane & 3) * 8;
    int slot0 = 0, slot2 = 2;
    for (int it = 0; it < ntile; ++it) {
        if (it + 2 < ntile) ATT_ISSUE(it + 2, slot2);
        LAS unsigned char* kb_ = lds + slot0 * BUF;
        bf16x8 kf0[ND], kf1[ND];
#pragma unroll
        for (int d0 = 0; d0 < ND; ++d0) { kf0[d0] = *(const LAS bf16x8*)(kb_ + koff + d0 * 32); kf1[d0] = *(const LAS bf16x8*)(kb_ + koff + 32 * KP + d0 * 32); }
        bf16x8 pwA[4], pwB[4];
#define GQ_HEAD(QF_, MRUN_, LRUN_, O_, PW_) do { \
            f32x16 p0 = f32x16{}, p1 = f32x16{}; \
            _Pragma("unroll") for (int d0 = 0; d0 < ND; ++d0) { p0 = __builtin_amdgcn_mfma_f32_32x32x16_bf16(kf0[d0], QF_[d0], p0, 0, 0, 0); p1 = __builtin_amdgcn_mfma_f32_32x32x16_bf16(kf1[d0], QF_[d0], p1, 0, 0, 0); } \
            float mxa = fmaxf(fmaxf(p0[0], p0[1]), p1[0]), mxb = fmaxf(fmaxf(p0[2], p0[3]), p1[1]); \
            mxa = fmaxf(fmaxf(mxa, p1[2]), p1[3]); \
            _Pragma("unroll") for (int r = 4; r < 16; r += 4) { mxa = fmaxf(fmaxf(mxa, p0[r]), p0[r + 1]); mxb = fmaxf(fmaxf(mxb, p0[r + 2]), p0[r + 3]); mxa = fmaxf(fmaxf(mxa, p1[r]), p1[r + 1]); mxb = fmaxf(fmaxf(mxb, p1[r + 2]), p1[r + 3]); } \
            float mx = fmaxf(mxa, mxb); \
            { const auto rr = __builtin_amdgcn_permlane32_swap(__float_as_uint(mx), __float_as_uint(mx), false, false); mx = fmaxf(__uint_as_float(rr[0]), __uint_as_float(rr[1])); } \
            mx -= MRUN_; \
            if (it == 0 || __any(mx > THR)) { const float dl = (it == 0) ? mx : fmaxf(mx, 0.f); MRUN_ += dl; const float alpha = __builtin_amdgcn_exp2f(-dl); LRUN_ *= alpha; \
                _Pragma("unroll") for (int d = 0; d < NDB; ++d) _Pragma("unroll") for (int r = 0; r < 16; ++r) O_[d][r] *= alpha; } \
            float rs0 = 0.f, rs1 = 0.f; \
            _Pragma("unroll") for (int r = 0; r < 16; ++r) { p0[r] = __builtin_amdgcn_exp2f(p0[r] - MRUN_); p1[r] = __builtin_amdgcn_exp2f(p1[r] - MRUN_); rs0 += p0[r]; rs1 += p1[r]; } \
            LRUN_ += rs0 + rs1; \
            _Pragma("unroll") for (int ks = 0; ks < 4; ++ks) { u32x4 w; const int b = 8 * (ks & 1); \
                if (ks < 2) { w.x = pk2(p0[b], p0[b + 1]); w.y = pk2(p0[b + 2], p0[b + 3]); w.z = pk2(p0[b + 4], p0[b + 5]); w.w = pk2(p0[b + 6], p0[b + 7]); } \
                else { w.x = pk2(p1[b], p1[b + 1]); w.y = pk2(p1[b + 2], p1[b + 3]); w.z = pk2(p1[b + 4], p1[b + 5]); w.w = pk2(p1[b + 6], p1[b + 7]); } \
                PW_[ks] = __builtin_bit_cast(bf16x8, w); } } while (0)
        GQ_HEAD(qfA, mrunA, lrunA, oA, pwA);
        GQ_HEAD(qfB, mrunB, lrunB, oB, pwB);
#undef GQ_HEAD
        {
            const unsigned vaddr = (unsigned)(size_t)kb_ + (unsigned)voff;
            s16x4 vlo[2][NDB], vhi[2][NDB];
#define ATT_VRD(set_, ks_) do { _Pragma("unroll") for (int d_ = 0; d_ < NDB; ++d_) { \
                asm volatile("ds_read_b64_tr_b16 %0, %1 offset:%2" : "=&v"(vlo[set_][d_]) : "v"(vaddr), "n"(((2 * (ks_)) * NDB + d_) * 512)); \
                asm volatile("ds_read_b64_tr_b16 %0, %1 offset:%2" : "=&v"(vhi[set_][d_]) : "v"(vaddr), "n"(((2 * (ks_) + 1) * NDB + d_) * 512)); } } while (0)
            ATT_VRD(0, 0);
#pragma unroll
            for (int ks = 0; ks < 4; ++ks) {
                const int cs = ks & 1;
                if (ks < 3) { if (ks == 0) ATT_VRD(1, 1); else if (ks == 1) ATT_VRD(0, 2); else ATT_VRD(1, 3); }
                if (ks < 3) asm volatile("s_waitcnt lgkmcnt(4)" : "+v"(vlo[cs][0]), "+v"(vhi[cs][0]), "+v"(vlo[cs][1]), "+v"(vhi[cs][1]));
                else asm volatile("s_waitcnt lgkmcnt(0)" : "+v"(vlo[cs][0]), "+v"(vhi[cs][0]), "+v"(vlo[cs][1]), "+v"(vhi[cs][1]));
#pragma unroll
                for (int d = 0; d < NDB; ++d) {
                    const bf16x8 vf = {vlo[cs][d][0], vlo[cs][d][1], vlo[cs][d][2], vlo[cs][d][3], vhi[cs][d][0], vhi[cs][d][1], vhi[cs][d][2], vhi[cs][d][3]};
                    oA[d] = __builtin_amdgcn_mfma_f32_32x32x16_bf16(vf, pwA[ks], oA[d], 0, 0, 0);
                    oB[d] = __builtin_amdgcn_mfma_f32_32x32x16_bf16(vf, pwB[ks], oB[d], 0, 0, 0);
                }
            }
#undef ATT_VRD
        }
        ATT_WAITBAR(it + 2 < ntile);
        slot0 = (slot0 == 2) ? 0 : slot0 + 1; slot2 = (slot2 == 2) ? 0 : slot2 + 1;
    }
#undef ATT_ISSUE
#undef ATT_WAITBAR
    lrunA += __shfl_xor(lrunA, 32); lrunB += __shfl_xor(lrunB, 32);
    const float invA = 1.f / lrunA, invB = 1.f / lrunB;
    const size_t oo = (size_t)(wave * 32 + r32) * a.opitch + 4 * hi;
#pragma unroll
    for (int d = 0; d < NDB; ++d)
#pragma unroll
        for (int g = 0; g < 4; ++g) { u32x2 w; w.x = pk2(oA[d][4 * g] * invA, oA[d][4 * g + 1] * invA); w.y = pk2(oA[d][4 * g + 2] * invA, oA[d][4 * g + 3] * invA); *(u32x2*)(a.oA + oo + 32 * d + 8 * g) = w;
            u32x2 w2; w2.x = pk2(oB[d][4 * g] * invB, oB[d][4 * g + 1] * invB); w2.y = pk2(oB[d][4 * g + 2] * invB, oB[d][4 * g + 3] * invB); *(u32x2*)(a.oB + oo + 32 * d + 8 * g) = w2; }
}

template <int DQK, int DV, bool NA>
__device__ __forceinline__ void attn_unit(const AttnP& a, LAS unsigned char* lds, const LAS float* biasT, int tid) {
    constexpr int KP = DQK * 2 + 16, KBYTES = 64 * KP, VBYTES = 64 * DV * 2, BUF = KBYTES + VBYTES;
    constexpr int KCH = DQK / 8, VCH = DV / 8, ND = DQK / 16, NDB = DV / 32;
    const int lane = tid & 63, wave = __builtin_amdgcn_readfirstlane(tid >> 6), r32 = lane & 31, hi = lane >> 5;
    bf16x8 qf[ND];
    { const bf16* qrow = a.q + (size_t)(wave * 32 + r32) * a.qpitch + hi * 8;
#pragma unroll
      for (int d0 = 0; d0 < ND; ++d0) qf[d0] = *(const bf16x8*)(qrow + d0 * 16); }
    if constexpr (DQK == 96) {
        if (a.rope_t0 >= 0) {
            const int t = a.rope_t0 + wave * 32 + r32; const float pos = hi ? (float)(t & 63) : (float)(t >> 6);
#pragma unroll
            for (int e = 0; e < 8; ++e) { const float ang = pos * exp2f(-(float)e * (LOG2_THETA / 8.f)); const float cs = __cosf(ang), sn = __sinf(ang);
                const float x1 = bf2f((unsigned short)qf[4][e]), x2 = bf2f((unsigned short)qf[5][e]);
                qf[4][e] = (short)f2bf(x1 * cs - x2 * sn); qf[5][e] = (short)f2bf(x2 * cs + x1 * sn); }
        }
    }
    constexpr int KS = KP / 16, NIK = KS, NIV = VCH, NI = NIK + NIV, MAXI = (NI + 7) / 8;
    const bf16* gsrc[MAXI]; unsigned gstep[MAXI];
#pragma unroll
    for (int j = 0; j < MAXI; ++j) {
        const int ii = wave + 8 * j; const int s = ii * 64 + lane;
        if (ii < NIK) { const int row = s / KS; int ch = s - row * KS; if (ch >= KCH) ch = 0;
            if (DQK == 96 && ch >= 8) { gsrc[j] = a.kb + (size_t)row * a.kbpitch + (ch - 8) * 8; gstep[j] = 64u * (unsigned)a.kbpitch; }
            else { gsrc[j] = a.ka + (size_t)row * a.kapitch + ch * 8; gstep[j] = 64u * (unsigned)a.kapitch; } }
        else { const int s2 = (s - 64 * KS) & (64 * VCH - 1); const int st = s2 >> 5, rowin = (s2 & 31) >> 2, chin = s2 & 3; const int row = (st / NDB) * 8 + rowin, ch = (st % NDB) * 4 + chin;
            gsrc[j] = a.v + (size_t)row * a.vpitch + ch * 8; gstep[j] = 64u * (unsigned)a.vpitch; }
    }
    const int mycnt = (NI - 1 - wave) / 8 + 1;
    const int ntile = a.nA + a.nB;
#define ATT_TILE(i_) ((i_) < a.nA ? (i_) : a.tB0 + ((i_) - a.nA))
#define ATT_ISSUE(tt_, slot_) do { _Pragma("unroll") for (int j_ = 0; j_ < MAXI; ++j_) if (wave + 8 * j_ < NI) \
        __builtin_amdgcn_global_load_lds((const unsigned*)(gsrc[j_] + (size_t)(tt_) * gstep[j_]), (LAS unsigned*)(lds + (slot_) * BUF + (wave + 8 * j_) * 1024), 16, 0, 0); } while (0)
#define ATT_WAITBAR(keep_) do { if (keep_) { if (mycnt == MAXI) asm volatile("s_waitcnt vmcnt(%0) lgkmcnt(0)\n\ts_barrier" :: "n"(MAXI) : "memory"); else asm volatile("s_waitcnt vmcnt(%0) lgkmcnt(0)\n\ts_barrier" :: "n"(MAXI - 1) : "memory"); } \
        else asm volatile("s_waitcnt vmcnt(0) lgkmcnt(0)\n\ts_barrier" ::: "memory"); } while (0)
    ATT_ISSUE(ATT_TILE(0), 0);
    if (ntile > 1) ATT_ISSUE(ATT_TILE(1), 1);
    ATT_WAITBAR(ntile > 1);
    constexpr float THR = 8.f;
    constexpr bool NEGM = (DV == 64) && !NA;
    float mrun = 0.f, lrun = 0.f;
    f32x16 negm = f32x16{};
    f32x16 o[NDB];
#pragma unroll
    for (int d = 0; d < NDB; ++d) o[d] = f32x16{};
    const int koff = r32 * KP + hi * 16;
    const int voff = KBYTES + (4 * hi + ((lane & 15) >> 2)) * 64 + ((lane >> 4) & 1) * 32 + (lane & 3) * 8;
    int na_rq = 0, na_r0 = 0, na_c = 0, na_ws = 0;
    if constexpr (NA) { na_rq = a.na_row0 + (wave >> 1); na_r0 = min(max(na_rq - 4, 0), 24); na_c = 32 * (wave & 1) + r32; na_ws = min(max(na_c - 8, 0), 48); }
    float mv[NA ? 20 : 1]; const LAS float* tb0 = nullptr; const int napar = wave & 1;
    if constexpr (NA) {
        tb0 = biasT + (64 + 15 - na_c + 4 * hi);
        if (napar == 0) {
#pragma unroll
            for (int r = 0; r < 16; ++r) { const int kc0 = crow(r, hi); mv[r] = (kc0 >= na_ws && kc0 < na_ws + 16) ? 0.f : -INFINITY; }
#pragma unroll
            for (int r = 0; r < 4; ++r) { const int kc1 = 32 + crow(r, hi); mv[16 + r] = (kc1 >= na_ws && kc1 < na_ws + 16) ? 0.f : -INFINITY; }
        } else {
#pragma unroll
            for (int r = 0; r < 16; ++r) { const int kc1 = 32 + crow(r, hi); mv[r] = (kc1 >= na_ws && kc1 < na_ws + 16) ? 0.f : -INFINITY; }
#pragma unroll
            for (int r = 0; r < 4; ++r) { const int kc0 = crow(12 + r, hi); mv[16 + r] = (kc0 >= na_ws && kc0 < na_ws + 16) ? 0.f : -INFINITY; }
        }
    }
    int slot0 = 0, slot2 = 2;
    for (int it = 0; it < ntile; ++it) {
        const int tt = ATT_TILE(it);
        if (it + 2 < ntile) { const int tn = ATT_TILE(it + 2); ATT_ISSUE(tn, slot2); }
        bool active = true; int rowoff = 0; bool local = false;
        if constexpr (NA) { if (tt >= 4) { const int kr = tt - 4; local = true; active = (kr >= na_r0) && (kr < na_r0 + 8); rowoff = (kr - na_rq + 7) * 32; } }
        if (active) {
            LAS unsigned char* kb_ = lds + slot0 * BUF;
            f32x16 p0, p1;
            if constexpr (NEGM) { p0 = negm; p1 = negm; } else { p0 = f32x16{}; p1 = f32x16{}; }
            {
                bf16x8 kf0[ND], kf1[ND];
#pragma unroll
                for (int d0 = 0; d0 < ND; ++d0) { kf0[d0] = *(const LAS bf16x8*)(kb_ + koff + d0 * 32); kf1[d0] = *(const LAS bf16x8*)(kb_ + koff + 32 * KP + d0 * 32); }
                __builtin_amdgcn_sched_barrier(0);
#pragma unroll
                for (int d0 = 0; d0 < ND; ++d0) {
                    p0 = __builtin_amdgcn_mfma_f32_32x32x16_bf16(kf0[d0], qf[d0], p0, 0, 0, 0);
                    p1 = __builtin_amdgcn_mfma_f32_32x32x16_bf16(kf1[d0], qf[d0], p1, 0, 0, 0);
                }
            }
            if constexpr (NA) {
                if (local) {
                    const LAS float* tb = tb0 + rowoff;
                    if (napar == 0) {
#pragma unroll
                        for (int r = 0; r < 16; ++r) p0[r] = (p0[r] + tb[(r & 3) + 8 * (r >> 2)]) + mv[r];
#pragma unroll
                        for (int r = 0; r < 4; ++r) p1[r] = (p1[r] + tb[32 + (r & 3)]) + mv[16 + r];
#pragma unroll
                        for (int r = 4; r < 16; ++r) p1[r] = -INFINITY;
                    } else {
#pragma unroll
                        for (int r = 0; r < 12; ++r) p0[r] = -INFINITY;
#pragma unroll
                        for (int r = 12; r < 16; ++r) p0[r] = (p0[r] + tb[(r & 3) + 24]) + mv[16 + r - 12];
#pragma unroll
                        for (int r = 0; r < 16; ++r) p1[r] = (p1[r] + tb[32 + (r & 3) + 8 * (r >> 2)]) + mv[r];
                    }
                }
            }
            float mxa = fmaxf(fmaxf(p0[0], p0[1]), p1[0]), mxb = fmaxf(fmaxf(p0[2], p0[3]), p1[1]);
            mxa = fmaxf(fmaxf(mxa, p1[2]), p1[3]);
#pragma unroll
            for (int r = 4; r < 16; r += 4) { mxa = fmaxf(fmaxf(mxa, p0[r]), p0[r + 1]); mxb = fmaxf(fmaxf(mxb, p0[r + 2]), p0[r + 3]); mxa = fmaxf(fmaxf(mxa, p1[r]), p1[r + 1]); mxb = fmaxf(fmaxf(mxb, p1[r + 2]), p1[r + 3]); }
            float mx = fmaxf(mxa, mxb);
            { const auto rr = __builtin_amdgcn_permlane32_swap(__float_as_uint(mx), __float_as_uint(mx), false, false); mx = fmaxf(__uint_as_float(rr[0]), __uint_as_float(rr[1])); }
            if constexpr (!NEGM) mx -= mrun;
            if (it == 0 || __any(mx > THR)) {
                const float dl = (it == 0) ? mx : fmaxf(mx, 0.f);
                mrun += dl;
                const float alpha = __builtin_amdgcn_exp2f(-dl);
                lrun *= alpha;
#pragma unroll
                for (int d = 0; d < NDB; ++d)
#pragma unroll
                    for (int r = 0; r < 16; ++r) o[d][r] *= alpha;
                if constexpr (NEGM) {
#pragma unroll
                    for (int r = 0; r < 16; ++r) { p0[r] -= dl; p1[r] -= dl; negm[r] = -mrun; }
                }
            }
            float rs0 = 0.f, rs1 = 0.f, rs2 = 0.f, rs3 = 0.f;
#pragma unroll
            for (int r = 0; r < 16; r += 2) {
                if constexpr (NEGM) { p0[r] = __builtin_amdgcn_exp2f(p0[r]); p0[r + 1] = __builtin_amdgcn_exp2f(p0[r + 1]); p1[r] = __builtin_amdgcn_exp2f(p1[r]); p1[r + 1] = __builtin_amdgcn_exp2f(p1[r + 1]); }
                else { p0[r] = __builtin_amdgcn_exp2f(p0[r] - mrun); p0[r + 1] = __builtin_amdgcn_exp2f(p0[r + 1] - mrun); p1[r] = __builtin_amdgcn_exp2f(p1[r] - mrun); p1[r + 1] = __builtin_amdgcn_exp2f(p1[r + 1] - mrun); }
                rs0 += p0[r]; rs1 += p0[r + 1]; rs2 += p1[r]; rs3 += p1[r + 1];
            }
            lrun += (rs0 + rs1) + (rs2 + rs3);
            bf16x8 pw[4];
#pragma unroll
            for (int ks = 0; ks < 4; ++ks) { u32x4 w;
                if (ks < 2) { const int b = 8 * (ks & 1); w.x = pk2(p0[b], p0[b + 1]); w.y = pk2(p0[b + 2], p0[b + 3]); w.z = pk2(p0[b + 4], p0[b + 5]); w.w = pk2(p0[b + 6], p0[b + 7]); }
                else { const int b = 8 * (ks & 1); w.x = pk2(p1[b], p1[b + 1]); w.y = pk2(p1[b + 2], p1[b + 3]); w.z = pk2(p1[b + 4], p1[b + 5]); w.w = pk2(p1[b + 6], p1[b + 7]); }
                pw[ks] = __builtin_bit_cast(bf16x8, w); }
            {
                const unsigned vaddr = (unsigned)(size_t)kb_ + (unsigned)voff;
                s16x4 vlo[2][NDB], vhi[2][NDB];
#define ATT_VRD(set_, ks_) do { _Pragma("unroll") for (int d_ = 0; d_ < NDB; ++d_) { \
                    asm volatile("ds_read_b64_tr_b16 %0, %1 offset:%2" : "=&v"(vlo[set_][d_]) : "v"(vaddr), "n"(((2 * (ks_)) * NDB + d_) * 512)); \
                    asm volatile("ds_read_b64_tr_b16 %0, %1 offset:%2" : "=&v"(vhi[set_][d_]) : "v"(vaddr), "n"(((2 * (ks_) + 1) * NDB + d_) * 512)); } } while (0)
                ATT_VRD(0, 0);
#pragma unroll
                for (int ks = 0; ks < 4; ++ks) {
                    const int cs = ks & 1;
                    if (ks < 3) { if (ks == 0) ATT_VRD(1, 1); else if (ks == 1) ATT_VRD(0, 2); else ATT_VRD(1, 3); }
                    if (ks < 3) { if constexpr (NDB == 2) asm volatile("s_waitcnt lgkmcnt(4)" : "+v"(vlo[cs][0]), "+v"(vhi[cs][0]), "+v"(vlo[cs][1]), "+v"(vhi[cs][1]));
                                  else asm volatile("s_waitcnt lgkmcnt(8)" : "+v"(vlo[cs][0]), "+v"(vhi[cs][0]), "+v"(vlo[cs][1]), "+v"(vhi[cs][1]), "+v"(vlo[cs][NDB - 2]), "+v"(vhi[cs][NDB - 2]), "+v"(vlo[cs][NDB - 1]), "+v"(vhi[cs][NDB - 1])); }
                    else { if constexpr (NDB == 2) asm volatile("s_waitcnt lgkmcnt(0)" : "+v"(vlo[cs][0]), "+v"(vhi[cs][0]), "+v"(vlo[cs][1]), "+v"(vhi[cs][1]));
                           else asm volatile("s_waitcnt lgkmcnt(0)" : "+v"(vlo[cs][0]), "+v"(vhi[cs][0]), "+v"(vlo[cs][1]), "+v"(vhi[cs][1]), "+v"(vlo[cs][NDB - 2]), "+v"(vhi[cs][NDB - 2]), "+v"(vlo[cs][NDB - 1]), "+v"(vhi[cs][NDB - 1])); }
#pragma unroll
                    for (int d = 0; d < NDB; ++d) {
                        const bf16x8 vf = {vlo[cs][d][0], vlo[cs][d][1], vlo[cs][d][2], vlo[cs][d][3], vhi[cs][d][0], vhi[cs][d][1], vhi[cs][d][2], vhi[cs][d][3]};
                        o[d] = __builtin_amdgcn_mfma_f32_32x32x16_bf16(vf, pw[ks], o[d], 0, 0, 0);
                    }
                }
#undef ATT_VRD
            }
        }
        ATT_WAITBAR(it + 2 < ntile);
        slot0 = (slot0 == 2) ? 0 : slot0 + 1; slot2 = (slot2 == 2) ? 0 : slot2 + 1;
    }
#undef ATT_TILE
#undef ATT_ISSUE
#undef ATT_WAITBAR
    lrun += __shfl_xor(lrun, 32);
    const float inv = 1.f / lrun;
    bf16* orow = a.o + (size_t)(wave * 32 + r32) * a.opitch + 4 * hi;
    if (a.mode == 2) {
        float ss = 0.f;
#pragma unroll
        for (int d = 0; d < NDB; ++d)
#pragma unroll
            for (int g = 0; g < 4; ++g) { const u32x2 w = *(const u32x2*)(orow + 32 * d + 8 * g);
                const float o1[4] = {bf2f(w.x & 0xffff), bf2f(w.x >> 16), bf2f(w.y & 0xffff), bf2f(w.y >> 16)};
#pragma unroll
                for (int e = 0; e < 4; ++e) { const float dl = o1[e] - a.lam * (o[d][4 * g + e] * inv); o[d][4 * g + e] = dl; ss += dl * dl; } }
        ss += __shfl_xor(ss, 32);
        const float rs = rsqrtf(ss * (1.f / (float)DV) + EPSN) * a.post;
#pragma unroll
        for (int d = 0; d < NDB; ++d)
#pragma unroll
            for (int g = 0; g < 4; ++g) { const f32x4 sl = *(const f32x4*)(a.subln + 32 * d + 8 * g + 4 * hi);
                u32x2 w; w.x = pk2(o[d][4 * g] * rs * sl[0], o[d][4 * g + 1] * rs * sl[1]); w.y = pk2(o[d][4 * g + 2] * rs * sl[2], o[d][4 * g + 3] * rs * sl[3]);
                *(u32x2*)(orow + 32 * d + 8 * g) = w; }
    } else {
#pragma unroll
        for (int d = 0; d < NDB; ++d)
#pragma unroll
            for (int g = 0; g < 4; ++g) { u32x2 w; w.x = pk2(o[d][4 * g] * inv, o[d][4 * g + 1] * inv); w.y = pk2(o[d][4 * g + 2] * inv, o[d][4 * g + 3] * inv);
                *(u32x2*)(orow + 32 * d + 8 * g) = w; }
    }
}

__device__ __forceinline__ void phase_attn_even(const Ctx& F, const Args& args, int L, bool want_ctx) {
    const bf16* P = (const bf16*)(F.ws + WS_P); const bf16* QM = (const bf16*)(F.ws + WS_QM); const bf16* KVM = (const bf16*)(F.ws + WS_KVM); bf16* O = (bf16*)(F.ws + WS_O);
    const int pr = L >> 1;
    const float lam_init = (L == 0) ? 0.2f : 0.47071302f;
    float lam;
    { const float* lp = args.in[15] + pr * 256; const float sa = wave_sum(lp[F.lane] * lp[64 + F.lane]), sb = wave_sum(lp[128 + F.lane] * lp[192 + F.lane]); lam = __expf(sa) - __expf(sb) + lam_init; }
    const float* subln = args.in[16] + pr * 128;
    const int n0 = 1024, n1 = 2048, n2 = want_ctx ? 128 : 0, n3 = want_ctx ? 256 : 0, ntot = n0 + n1 + n2 + n3;
    for (int u = F.vcu; u < ntot; u += F.G) {
        AttnP a; a.kb = nullptr; a.kbpitch = 0; a.tB0 = 0; a.nB = 0; a.rope_t0 = -1; a.mode = 0; a.lam = lam; a.post = 1.f - lam_init; a.subln = subln; a.na_row0 = 0;
        int cls, uu = u;
        if (uu < n0) cls = 0; else if ((uu -= n0) < n1) cls = 1; else if ((uu -= n1) < n2) cls = 2; else { uu -= n2; cls = 3; }
        if (cls == 0 || cls == 2) {
            int b, h, row0;
            if (cls == 0) { const int bh = uu >> 3, qb = uu & 7; b = bh >> 2; h = bh & 3; row0 = b * RPB + CTXL + 256 * qb; a.nA = 36; }
            else { b = uu >> 2; h = uu & 3; row0 = b * RPB; a.nA = 4; }
            const size_t base = (size_t)b * RPB;
            a.qpitch = PE; a.kapitch = PE; a.vpitch = PE; a.opitch = DM;
            a.v = P + base * PE + E_DV + h * 128; a.o = O + (size_t)row0 * DM + 512 + h * 128;
            for (int m = 0; m < 2; ++m) {
                a.q = P + (size_t)row0 * PE + E_DQ + h * 128 + m * 64; a.ka = P + base * PE + E_DK + h * 128 + m * 64; a.mode = 1 + m;
                attn_unit<64, 128, false>(a, F.lds, nullptr, F.tid);
            }
        } else {
            int b, h, row0;
            if (cls == 1) { const int bh = uu >> 3, qb = uu & 7; b = bh >> 3; h = bh & 7; row0 = b * RPB + CTXL + 256 * qb; a.nA = 36; a.rope_t0 = 256 * qb; }
            else { b = uu >> 3; h = uu & 7; row0 = b * RPB; a.nA = 4; }
            const size_t base = (size_t)b * RPB;
            a.q = QM + (size_t)row0 * 768 + h * 96; a.qpitch = 768; a.ka = KVM + base * 1024 + h * 128; a.kapitch = 1024; a.kb = P + base * PE + E_KR; a.kbpitch = PE;
            a.v = KVM + base * 1024 + h * 128 + 64; a.vpitch = 1024; a.o = O + (size_t)row0 * DM + h * 64; a.opitch = DM;
            attn_unit<96, 64, false>(a, F.lds, nullptr, F.tid);
        }
    }
}
__device__ __forceinline__ void phase_attn_odd(const Ctx& F, const Args& args, int L, bool want_ctx) {
    const bf16* P = (const bf16*)(F.ws + WS_P); bf16* O = (bf16*)(F.ws + WS_O);
    const int pr = L >> 1;
    const float* rpb = args.in[20] + (size_t)pr * 8 * 15 * 31;
    LAS float* biasT = (LAS float*)(F.lds + 98304);
    const int n0 = 1024, n1 = 2048, n2 = want_ctx ? 256 : 0, n3 = want_ctx ? 256 : 0, ntot = n0 + n1 + n2 + n3;
    for (int u = F.vcu; u < ntot; u += F.G) {
        if (u < n0) {
            const int qb = u & 7, bhp = u >> 3, pair = bhp & 1, hkv = (bhp >> 1) & 1, b = bhp >> 2; const int hA = 4 * hkv + 2 * pair;
            const int row0 = b * RPB + CTXL + 256 * qb; const size_t base = (size_t)b * RPB;
            AttnP2 a2; a2.qA = P + (size_t)row0 * PO + hA * 64; a2.qB = a2.qA + 64; a2.qpitch = PO; a2.ka = P + base * PO + O_GK + hkv * 64; a2.kapitch = PO; a2.v = P + base * PO + O_GV + hkv * 64; a2.vpitch = PO;
            a2.oA = O + (size_t)row0 * DM + hA * 64; a2.oB = a2.oA + 64; a2.opitch = DM; a2.ntile = 36;
            attn_unit_gqa2(a2, F.lds, F.tid);
            continue;
        }
        AttnP a; a.kb = nullptr; a.kbpitch = 0; a.tB0 = 0; a.nB = 0; a.rope_t0 = -1; a.mode = 0; a.lam = 0.f; a.post = 1.f; a.subln = nullptr; a.na_row0 = 0;
        a.qpitch = PO; a.kapitch = PO; a.vpitch = PO; a.opitch = DM;
        int cls, uu = u - n0;
        if (uu < n1) cls = 1; else if ((uu -= n1) < n2) cls = 2; else { uu -= n2; cls = 3; }
        int b, h, row0, qb = 0;
        if (cls < 2) { const int bh = uu >> 3; qb = uu & 7; b = bh >> 3; h = bh & 7; row0 = b * RPB + CTXL + 256 * qb; }
        else { b = uu >> 3; h = uu & 7; row0 = b * RPB; }
        const size_t base = (size_t)b * RPB;
        if (cls == 0 || cls == 2) {
            a.q = P + (size_t)row0 * PO + h * 64; a.ka = P + base * PO + O_GK + (h >> 2) * 64; a.v = P + base * PO + O_GV + (h >> 2) * 64; a.o = O + (size_t)row0 * DM + h * 64;
            a.nA = (cls == 0) ? 36 : 4;
            attn_unit<64, 64, false>(a, F.lds, nullptr, F.tid);
        } else {
            a.q = P + (size_t)row0 * PO + O_NQ + h * 64; a.ka = P + base * PO + O_NK + h * 64; a.v = P + base * PO + O_NV + h * 64; a.o = O + (size_t)row0 * DM + 512 + h * 64;
            a.nA = 4;
            if (cls == 1) {
                const int rlo = 4 * qb, rmin = min(max(rlo - 4, 0), 24), rmax = min(max(rlo + 3 - 4, 0), 24) + 7;
                a.tB0 = 4 + rmin; a.nB = rmax - rmin + 1; a.na_row0 = rlo;
                int tl_ = F.tid; asm volatile("" : "+v"(tl_));
                for (int e = tl_; e < 704; e += NTHR) { const int j = e - 64, rr = j >> 5, cc = j & 31; biasT[e] = (j >= 0 && j < 15 * 32 && cc < 31) ? rpb[(h * 15 + rr) * 31 + cc] * LOG2E : 0.f; }
                attn_unit<64, 64, true>(a, F.lds, biasT, tl_);
            } else {
                attn_unit<64, 64, false>(a, F.lds, nullptr, F.tid);
            }
        }
    }
}

constexpr int N_PHASES = 2 + 9 * DEPTH;
#ifndef REP_A0
#define REP_A0 1
#endif
#ifndef REP_SYNC
#define REP_SYNC 1
#endif
#ifndef REP_PRO
#define REP_PRO 1
#endif
#ifndef REP_ATTN
#define REP_ATTN 1
#endif
#ifndef REP_GEMM
#define REP_GEMM 1
#endif
#ifndef EN_PRO
#define EN_PRO 1
#endif
#ifndef EN_ROW
#define EN_ROW 1
#endif
#ifndef EN_PREP
#define EN_PREP 1
#endif
#ifndef EN_AE
#define EN_AE 1
#endif
#ifndef EN_AO
#define EN_AO 1
#endif
#ifndef EN_GEMM
#define EN_GEMM 1
#endif
__global__ void __launch_bounds__(NTHR, 2) fwd_kernel(Args args) {
    extern __shared__ __attribute__((aligned(16))) unsigned char lds_raw[];
    cg::grid_group grid = cg::this_grid();
    Ctx F;
    F.lds = (LAS unsigned char*)lds_raw;
    F.G = gridDim.x; { const int bx = blockIdx.x; F.vcu = (F.G % 8 == 0) ? (bx % 8) * (F.G / 8) + bx / 8 : bx; }
    F.out = args.out; F.ws = args.ws;
    const int lo = args.ph_lo, hi = args.ph_hi;
    volatile LAS unsigned* barst = (volatile LAS unsigned*)(F.lds + LDS_BARST);
    if (threadIdx.x == 0) { barst[0] = 0u; barst[1] = 0u; }
    __syncthreads();
    unsigned* barw = (unsigned*)(F.ws + WS_BAR);
    XcdBarrier xbar; xbar.bar = barw; xbar.x = 0; xbar.st = barst;
    int nsync = 0;
    for (int ph = lo; ph < hi; ++ph) {
        { int t_ = threadIdx.x; asm volatile("" : "+v"(t_)); F.tid = t_; F.lane = t_ & 63; F.wave = __builtin_amdgcn_readfirstlane(t_ >> 6); }
        float* MOD = (float*)(F.ws + WS_MOD); bf16* AF = (bf16*)(F.ws + WS_AF);
        const float* normg = args.in[6];
        const int L = (ph < 2) ? 0 : (ph - 2) / 9, k = (ph < 2) ? -1 : (ph - 2) % 9;
        const bool even = (L & 1) == 0, want_ctx = L < DEPTH - 1;
        unsigned char* wl = F.ws + WS_WT + (size_t)L * WL_STRIDE;
        if (ph == lo && hi - lo > 1 && blockIdx.x == 0) { for (int w_ = threadIdx.x; w_ < XCD_BAR_WORDS; w_ += NTHR) barw[w_] = 0u; }
        if (ph == 0) { for (int rep_ = 0; rep_ < REP_PRO; ++rep_) { if (EN_PRO) phase_prologue_a(F, args); __syncthreads(); } }
        else if (ph == 1 || k == 5 || k == 8) {
            const float* modL = MOD + (size_t)L * 33 * 6144;
            RowPassP p;
            bf16* HB = (bf16*)(F.ws + WS_HB); bf16* HCB = (bf16*)(F.ws + WS_HCB);
            p.Adst = AF; p.Fsrc = AF; p.hb_lat = HB; p.hb_ctx = HCB; p.out32 = F.out; p.final32 = 0; p.hin_lat = HB; p.hin_ctx = HCB;
            bool hin32 = false;
            if (ph == 1) { p.hin_lat = args.in[0]; p.hin_ctx = args.in[2]; hin32 = true; p.g_post = normg; p.g_pre = normg; p.mod_post = MOD; p.mod_pre = MOD;
                p.gate_chunk = 0; p.shift_chunk = 0; p.scale_chunk = 1; p.has_f = 0; p.write_h = 0; p.write_a = 1; p.skip_ctx = 0; }
            else if (k == 5) { if (L == 0) { p.hin_lat = args.in[0]; p.hin_ctx = args.in[2]; hin32 = true; } p.Fsrc = (const bf16*)(F.ws + WS_F1); p.g_post = normg + (L * 4 + 1) * DM; p.g_pre = normg + (L * 4 + 2) * DM;
                p.mod_post = modL; p.mod_pre = modL; p.gate_chunk = 2; p.shift_chunk = 3; p.scale_chunk = 4; p.has_f = 1; p.write_h = 1; p.write_a = 1; p.skip_ctx = want_ctx ? 0 : 1; }
            else { const int Ln = (L + 1 < DEPTH) ? L + 1 : L;
                p.g_post = normg + (L * 4 + 3) * DM; p.g_pre = normg + (Ln * 4 + 0) * DM; p.mod_post = modL; p.mod_pre = MOD + (size_t)Ln * 33 * 6144;
                p.gate_chunk = 5; p.shift_chunk = 0; p.scale_chunk = 1; p.has_f = 1; p.write_h = 1; p.write_a = want_ctx ? 1 : 0; p.skip_ctx = want_ctx ? 0 : 1; p.final32 = want_ctx ? 0 : 1; }
            if (EN_ROW) {
                if (ph == 1) { for (int rep_ = 0; rep_ < REP_A0; ++rep_) { phase_rowpass<true, false, false, true, false>(F, p); __syncthreads(); } }
                else if (hin32) phase_rowpass<true, true, true, true, false>(F, p);
                else if (p.final32) phase_rowpass<false, true, false, false, true>(F, p);
                else phase_rowpass<false, true, true, true, false>(F, p);
            }
        }
        else if (k == 1) { if (EN_PREP) { if (even) phase_prep_even(F); else phase_prep_odd(F, args.in[19] + (L >> 1) * 128); } }
        else if (k == 3) { for (int rep_ = 0; rep_ < REP_ATTN; ++rep_) { if (even) { if (EN_AE) phase_attn_even(F, args, L, want_ctx); } else { if (EN_AO) phase_attn_odd(F, args, L, want_ctx); } } }
        else {
            const int ng = (k == 2) ? (even ? 2 : 0) : 1;
            for (int gi_ = 0; gi_ < ng * REP_GEMM; ++gi_) { const int gi = gi_ % ng;
                pg8::Gemm g; pg8::EpiStore E; E.act = 0;
                g.M = MROWS;
                if (k == 0) { g.A = AF; g.Bt = (const bf16*)(wl + WL_IN); g.N = even ? PE : PO; g.K = DM; g.lda = DM; E.O = (bf16*)(F.ws + WS_P); E.ldc = g.N; }
                else if (k == 2) {
                    if (gi == 0) { g.A = AF; g.Bt = (const bf16*)(wl + WL_UQ); g.N = 768; g.K = 256; g.lda = 256; E.O = (bf16*)(F.ws + WS_QM); E.ldc = 768; }
                    else { g.A = (const bf16*)(F.ws + WS_AF + 36 * MiB); g.Bt = (const bf16*)(wl + WL_UKV); g.N = 1024; g.K = 128; g.lda = 128; E.O = (bf16*)(F.ws + WS_KVM); E.ldc = 1024; } }
                else if (k == 4) { g.A = (const bf16*)(F.ws + WS_O); g.Bt = (const bf16*)(wl + WL_OUT); g.N = DM; g.K = DM; g.lda = DM; E.O = (bf16*)(F.ws + WS_F1); E.ldc = DM; }
                else if (k == 6) { g.A = AF; g.Bt = (const bf16*)(wl + WL_FF1); g.N = DFF; g.K = DM; g.lda = DM; E.O = (bf16*)(F.ws + WS_H); E.ldc = DFF; E.act = 1; }
                else { g.A = (const bf16*)(F.ws + WS_H); g.Bt = (const bf16*)(wl + WL_FF2); g.N = DM; g.K = DFF; g.lda = DFF; E.O = AF; E.ldc = DM; }
                const int skipc = (L == DEPTH - 1 && k >= 4) ? 1 : 0;
                pg8::StaticOrder S; S.init(MROWS, g.N, F.G, (int)blockIdx.x, skipc); S.rev = (k == 7) ? 1 : 0;
                if (EN_GEMM) pg8::gemm_phase<pg8::EpiStore, pg8::StaticOrder, true, true>(F.lds, g, S, E);
            }
        }
        if (ph + 1 < hi) {
            for (int s_ = 0; s_ < REP_SYNC; ++s_) {
                if (nsync == 0) { grid.sync(); xbar = xcd_barrier_post(barw, barst); }
                else xcd_barrier(xbar);
                ++nsync;
            }
        }
    }
}

#ifndef SINGLE_LAUNCH
#define SINGLE_LAUNCH 1
#endif
extern "C" void kernel_launch(void* const* d_in, const int* in_sizes, int n_in, void* d_out, int out_size, void* d_ws, size_t ws_size, hipStream_t stream) {
    static int grid = 0;
    if (grid == 0) {
        if (n_in != 21 || out_size != NB * SEQ * DM || ws_size < WS_END) { fprintf(stderr, "kernel_launch: unexpected problem (n_in %d, out %d, ws %zu)\n", n_in, out_size, ws_size); grid = -1; return; }
        int dev = 0, cus = 0, per_cu = 0;
        hipGetDevice(&dev); hipDeviceGetAttribute(&cus, hipDeviceAttributeMultiprocessorCount, dev);
        hipFuncSetAttribute((const void*)fwd_kernel, hipFuncAttributeMaxDynamicSharedMemorySize, LDS_BYTES);
        hipOccupancyMaxActiveBlocksPerMultiprocessor(&per_cu, (const void*)fwd_kernel, NTHR, LDS_BYTES);
        if (per_cu < 1) per_cu = 1;
        grid = cus;
        (void)hipGetLastError();
    }
    if (grid < 0) return;
    Args a{};
    for (int i = 0; i < 21; ++i) a.in[i] = (const float*)d_in[i];
    a.out = (float*)d_out; a.ws = (unsigned char*)d_ws;
#if SINGLE_LAUNCH
    a.ph_lo = 0; a.ph_hi = N_PHASES;
    void* kargs[] = {&a};
    hipError_t e = hipLaunchCooperativeKernel((const void*)fwd_kernel, dim3(grid), dim3(NTHR), kargs, LDS_BYTES, stream);
    if (e != hipSuccess) fprintf(stderr, "cooperative launch failed: %s (grid %d)\n", hipGetErrorString(e), grid);
#else
    for (int ph = 0; ph < N_PHASES; ++ph) {
        if (ph >= 2) { const int L = (ph - 2) / 9, k = (ph - 2) % 9; if (k == 2 && (L & 1)) continue; }
        a.ph_lo = ph; a.ph_hi = ph + 1;
        hipLaunchKernelGGL(fwd_kernel, dim3(grid), dim3(NTHR), LDS_BYTES, stream, a);
    }
#endif
}
```

```cpp
#include <hip/hip_runtime.h>
#include <hip/hip_cooperative_groups.h>
#include <cstdio>
#include <cstdint>
namespace cg = cooperative_groups;
namespace pg8 {
#define PG8_LAS __attribute__((address_space(3)))
typedef unsigned short bf16_t;
typedef short bf16x8 __attribute__((ext_vector_type(8)));
typedef float f32x4 __attribute__((ext_vector_type(4)));
typedef unsigned u32x4 __attribute__((ext_vector_type(4)));
constexpr int BM = 256, BK = 64, HALF = 128, HTB = HALF * BK * 2  , STAGE_BYTES = 8 * HTB, NXCD = 8, WGM = 8;

__host__ __device__ __forceinline__ int lds_byte(int r, int c) { const int st = (r >> 4) * 2 + (c >> 5), rr = r & 15, cc = c & 31, ob = rr * 64 + cc * 2; return st * 1024 + (ob ^ (((ob >> 9) & 1) << 5)); }
__host__ __device__ __forceinline__ void stage_rc(int b, int& R, int& C) { const int st = b / 1024, sb = b % 1024, swz = sb ^ (((sb >> 9) & 1) << 5); R = (st >> 1) * 16 + swz / 64; C = (st & 1) * 32 + (swz % 64) / 2; }
__host__ __device__ __forceinline__ int perm32(int rho) { const int n = rho >> 4, i = rho & 15; return 8 * (i >> 2) + 4 * n + (i & 3); }

struct Unit { int pm, pn; };
struct Gemm { const bf16_t* A; const bf16_t* Bt; int M, N, K, lda; };

struct StaticOrder {
    int nM, nN, nwg, G, c, skipc;
    __host__ __device__ void init(int M, int N, int G_, int c_, int skipc_ = 0) { nM = M / BM; if (skipc_) nM = nM / 9 * 8; nN = N / BM; nwg = nM * nN; G = G_; c = c_; skipc = skipc_; }
    __host__ __device__ bool next(int i, Unit& u) const {
        const long L = (long)i * G + c; if (L >= nwg) return false;
        int wgid = (int)L; { const int q = nwg / NXCD, r = nwg % NXCD, xcd = wgid % NXCD, off = wgid / NXCD; wgid = (xcd < r ? xcd * (q + 1) : r * (q + 1) + (xcd - r) * q) + off; }
        const int nig = WGM * nN, gid = wgid / nig, fm = gid * WGM, gsz = (nM - fm) < WGM ? (nM - fm) : WGM;
        u.pm = fm + ((wgid % nig) % gsz); u.pn = (wgid % nig) / gsz; if (skipc) u.pm = u.pm + u.pm / 8 + 1; return true;
    }
    __device__ __forceinline__ void a_ready(const Unit&) const {}
    __device__ __forceinline__ void done(const Unit&) const {}
};

__device__ __forceinline__ unsigned cvt_pk_bf16(float lo, float hi) { unsigned r; asm volatile("v_cvt_pk_bf16_f32 %0, %1, %2" : "=v"(r) : "v"(lo), "v"(hi)); return r; }
template <class Epi, class Sched, bool ALIGN_EPI = false, bool SP2 = false>
__device__ __forceinline__ void gemm_phase(PG8_LAS unsigned char* lds, const Gemm g, const Sched& S, const Epi& E) {
    int tid_ = threadIdx.x; asm volatile("" : "+v"(tid_));
    const int tid = tid_, wid = __builtin_amdgcn_readfirstlane(tid >> 6), lane = tid & 63, wr = wid >> 2, wc = wid & 3, fr = lane & 15, fq = lane >> 4;
    const int K = g.K, nt = K / BK;
    unsigned voffA[2], voffB[2];
#pragma unroll
    for (int i = 0; i < 2; ++i) { int R, C; stage_rc(tid * 16 + i * 8192, R, C); const int Rb = Epi::PERM ? ((R & ~31) + perm32(R & 31)) : R;
        voffA[i] = (unsigned)(R * g.lda + C) * 2u; voffB[i] = (unsigned)(Rb * K + C) * 2u; }
    const size_t kstep = (size_t)(BK * 2);
    const size_t hstep = (size_t)HALF * K * 2, hstepA = (size_t)HALF * g.lda * 2;
    const size_t tstep = 2 * hstep, tstepA = 2 * hstepA;
    const unsigned ldsw = (unsigned)wid * 1024u;
    const int aoff = lds_byte(wr * 64 + fr, fq * 8), boff = lds_byte(wc * 32 + fr, fq * 8);
#define PG8_SA(b, h) (((b) * 2 + (h)) * HTB)
#define PG8_SB(b, h) ((4 + (b) * 2 + (h)) * HTB)
#define PG8_STAGE(bufoff, gbase, voff) do { _Pragma("unroll") for (int _i = 0; _i < 2; ++_i) \
        __builtin_amdgcn_global_load_lds((const unsigned*)((const char*)(gbase) + (voff)[_i]), (PG8_LAS unsigned*)(lds + (bufoff) + ldsw + _i * 8192), 16, 0, 0); } while (0)
#define PG8_LDA(dst, b, h) do { _Pragma("unroll") for (int m = 0; m < 4; ++m) _Pragma("unroll") for (int k = 0; k < 2; ++k) dst[m][k] = *(const PG8_LAS bf16x8*)(lds + PG8_SA(b, h) + aoff + m * 2048 + k * 1024); } while (0)
#define PG8_LDB(dst, b, h) do { _Pragma("unroll") for (int n = 0; n < 2; ++n) _Pragma("unroll") for (int k = 0; k < 2; ++k) dst[n][k] = *(const PG8_LAS bf16x8*)(lds + PG8_SB(b, h) + boff + n * 2048 + k * 1024); } while (0)
#define PG8_MMA(ai, bj, At, Bt) do { __builtin_amdgcn_s_setprio(1); _Pragma("unroll") for (int m = 0; m < 4; ++m) _Pragma("unroll") for (int n = 0; n < 2; ++n) _Pragma("unroll") for (int k = 0; k < 2; ++k) \
        acc[ai][bj][m][n] = __builtin_amdgcn_mfma_f32_16x16x32_bf16(Bt[n][k], At[m][k], acc[ai][bj][m][n], 0, 0, 0); __builtin_amdgcn_s_setprio(0); } while (0)
#define PG8_WAIT_V(n) asm volatile("s_waitcnt vmcnt(" #n ")" ::: "memory")
#define PG8_WAIT_L(n) asm volatile("s_waitcnt lgkmcnt(" #n ")" ::: "memory")
#define PG8_BAR __builtin_amdgcn_s_barrier()
#define PG8_SCHED __builtin_amdgcn_sched_barrier(0)
    Unit cur, nxt; int ui = 0;
    if (!S.next(0, cur)) return;
    f32x4 acc[2][2][4][2];
#pragma unroll
    for (int a = 0; a < 2; ++a)
#pragma unroll
        for (int b = 0; b < 2; ++b)
#pragma unroll
            for (int m = 0; m < 4; ++m)
#pragma unroll
                for (int n = 0; n < 2; ++n) acc[a][b][m][n] = (f32x4){0.f, 0.f, 0.f, 0.f};
    bf16x8 At[4][2], B0[2][2], B1[2][2];
    const char* cA = (const char*)g.A + (size_t)cur.pm * tstepA; const char* cB = (const char*)g.Bt + (size_t)cur.pn * tstep;
    S.a_ready(cur);
    if constexpr (SP2) {
        PG8_STAGE(PG8_SB(0, 0), cB, voffB); PG8_STAGE(PG8_SB(0, 1), cB + hstep, voffB); PG8_STAGE(PG8_SA(0, 0), cA, voffA); PG8_STAGE(PG8_SA(0, 1), cA + hstepA, voffA);
        if (wr == 1) PG8_BAR;
        PG8_WAIT_V(2); PG8_BAR;
        PG8_STAGE(PG8_SB(1, 0), cB + kstep, voffB); PG8_STAGE(PG8_SA(1, 0), cA + kstep, voffA); PG8_STAGE(PG8_SB(1, 1), cB + hstep + kstep, voffB);
        PG8_WAIT_V(6); PG8_BAR;
    } else {
        PG8_STAGE(PG8_SB(0, 0), cB, voffB); PG8_STAGE(PG8_SA(0, 0), cA, voffA); PG8_STAGE(PG8_SB(0, 1), cB + hstep, voffB); PG8_STAGE(PG8_SA(0, 1), cA + hstepA, voffA);
        if (wr == 1) PG8_BAR;
        PG8_WAIT_V(4); PG8_BAR;
        PG8_STAGE(PG8_SB(1, 0), cB + kstep, voffB); PG8_STAGE(PG8_SA(1, 0), cA + kstep, voffA); PG8_STAGE(PG8_SB(1, 1), cB + hstep + kstep, voffB);
        PG8_WAIT_V(6); PG8_BAR;
    }
    for (;;) {
        const bool has_next = S.next(ui + 1, nxt);
        const char* nA = has_next ? (const char*)g.A + (size_t)nxt.pm * tstepA : cA; const char* nB = has_next ? (const char*)g.Bt + (size_t)nxt.pn * tstep : cB;
        for (int t = 0; t < nt; t += 2) {
            const bool last = (t == nt - 2);
            const char* a1 = cA + (size_t)(t + 1) * kstep;
            const char* a2 = last ? nA : cA + (size_t)(t + 2) * kstep; const char* b2 = last ? nB : cB + (size_t)(t + 2) * kstep;
            const char* a3 = a2 + kstep; const char* b3 = b2 + kstep;
            if (last && has_next) S.a_ready(nxt);
            if constexpr (SP2) {
            PG8_LDB(B0, 0, 0); PG8_LDB(B1, 0, 1); PG8_SCHED; PG8_LDA(At, 0, 0); PG8_STAGE(PG8_SA(1, 1), a1 + hstepA, voffA);
            PG8_WAIT_V(8); PG8_WAIT_L(0); PG8_BAR; PG8_MMA(0, 0, At, B0); PG8_MMA(0, 1, At, B1); PG8_BAR; PG8_SCHED;
            PG8_LDA(At, 0, 1); PG8_STAGE(PG8_SB(0, 0), b2, voffB); PG8_STAGE(PG8_SB(0, 1), b2 + hstep, voffB); PG8_STAGE(PG8_SA(0, 0), a2, voffA);
            PG8_WAIT_V(8); PG8_WAIT_L(0); PG8_BAR; PG8_MMA(1, 0, At, B0); PG8_MMA(1, 1, At, B1); PG8_BAR; PG8_SCHED;
            PG8_LDB(B0, 1, 0); PG8_LDB(B1, 1, 1); PG8_SCHED; PG8_LDA(At, 1, 0); PG8_STAGE(PG8_SA(0, 1), a2 + hstepA, voffA);
            PG8_WAIT_V(8); PG8_WAIT_L(0); PG8_BAR; PG8_MMA(0, 0, At, B0); PG8_MMA(0, 1, At, B1); PG8_BAR; PG8_SCHED;
            PG8_LDA(At, 1, 1); PG8_STAGE(PG8_SB(1, 0), b3, voffB); PG8_STAGE(PG8_SB(1, 1), b3 + hstep, voffB); PG8_STAGE(PG8_SA(1, 0), a3, voffA);
            PG8_WAIT_V(8); PG8_WAIT_L(0); PG8_BAR; PG8_MMA(1, 0, At, B0); PG8_MMA(1, 1, At, B1); PG8_BAR; PG8_SCHED;
            } else {
            PG8_LDB(B0, 0, 0); PG8_SCHED; PG8_LDA(At, 0, 0); PG8_STAGE(PG8_SA(1, 1), a1 + hstepA, voffA);
            PG8_WAIT_L(8); PG8_BAR; PG8_WAIT_L(0); PG8_MMA(0, 0, At, B0); PG8_BAR; PG8_SCHED;
            PG8_LDB(B1, 0, 1); PG8_STAGE(PG8_SB(0, 0), b2, voffB);
            PG8_BAR; PG8_WAIT_L(0); PG8_MMA(0, 1, At, B1); PG8_BAR;
            PG8_LDA(At, 0, 1); PG8_STAGE(PG8_SA(0, 0), a2, voffA);
            PG8_BAR; PG8_WAIT_L(0); PG8_MMA(1, 0, At, B0); PG8_BAR; PG8_SCHED;
            PG8_STAGE(PG8_SB(0, 1), b2 + hstep, voffB);
            PG8_WAIT_V(6); PG8_BAR; PG8_MMA(1, 1, At, B1); PG8_BAR;
            PG8_LDB(B0, 1, 0); PG8_SCHED; PG8_LDA(At, 1, 0); PG8_STAGE(PG8_SA(0, 1), a2 + hstepA, voffA);
            PG8_WAIT_L(8); PG8_BAR; PG8_WAIT_L(0); PG8_MMA(0, 0, At, B0); PG8_BAR; PG8_SCHED;
            PG8_LDB(B1, 1, 1); PG8_STAGE(PG8_SB(1, 0), b3, voffB);
            PG8_BAR; PG8_WAIT_L(0); PG8_MMA(0, 1, At, B1); PG8_BAR;
            PG8_LDA(At, 1, 1); PG8_STAGE(PG8_SA(1, 0), a3, voffA);
            PG8_BAR; PG8_WAIT_L(0); PG8_MMA(1, 0, At, B0); PG8_BAR; PG8_SCHED;
            PG8_STAGE(PG8_SB(1, 1), b3 + hstep, voffB);
            PG8_WAIT_V(6); PG8_BAR; PG8_MMA(1, 1, At, B1); PG8_BAR;
            }
        }
        if constexpr (ALIGN_EPI) { if (wr == 0) PG8_BAR; }
        if constexpr (!Epi::AFTER_DRAIN) { E(acc, cur, wr, wc, fr, fq); S.done(cur); }
        if (!has_next) break;
#pragma unroll
        for (int a = 0; a < 2; ++a)
#pragma unroll
            for (int b = 0; b < 2; ++b)
#pragma unroll
                for (int m = 0; m < 4; ++m)
#pragma unroll
                    for (int n = 0; n < 2; ++n) acc[a][b][m][n] = (f32x4){0.f, 0.f, 0.f, 0.f};
        cur = nxt; cA = nA; cB = nB; ++ui;
        if constexpr (ALIGN_EPI) { if (wr == 1) PG8_BAR; }
    }
    PG8_WAIT_V(0);
    if constexpr (!ALIGN_EPI) { if (wr == 0) PG8_BAR; }
    PG8_BAR;
    if constexpr (Epi::AFTER_DRAIN) { E.fused(acc, cur, wr, wc, fr, fq, lds, wid, lane); S.done(cur); }
#undef PG8_SA
#undef PG8_SB
#undef PG8_STAGE
#undef PG8_LDA
#undef PG8_LDB
#undef PG8_MMA
#undef PG8_WAIT_V
#undef PG8_WAIT_L
#undef PG8_BAR
#undef PG8_SCHED
}
}
namespace pg8 {
struct EpiStore {
    static constexpr bool PERM = true, AFTER_DRAIN = false;
    bf16_t* O; int ldc; int act;
    __device__ __forceinline__ void operator()(const f32x4 (&acc)[2][2][4][2], const Unit& u, int wr, int wc, int fr, int fq) const {
        const int row0 = u.pm * BM + wr * 64 + fr; const int col0 = u.pn * BM + wc * 32 + 8 * fq;
#pragma unroll
        for (int ai = 0; ai < 2; ++ai)
#pragma unroll
            for (int m = 0; m < 4; ++m) { bf16_t* rowp = O + (size_t)(row0 + ai * HALF + m * 16) * ldc + col0;
#pragma unroll
                for (int bj = 0; bj < 2; ++bj) { f32x4 v0 = acc[ai][bj][m][0], v1 = acc[ai][bj][m][1];
                    if (act == 1) {
#pragma unroll
                        for (int e = 0; e < 4; ++e) { float a = fmaxf(v0[e], 0.f), b = fmaxf(v1[e], 0.f); v0[e] = a * a; v1[e] = b * b; } }
                    u32x4 w; w.x = cvt_pk_bf16(v0[0], v0[1]); w.y = cvt_pk_bf16(v0[2], v0[3]); w.z = cvt_pk_bf16(v1[0], v1[1]); w.w = cvt_pk_bf16(v1[2], v1[3]);
                    *(u32x4*)(rowp + bj * HALF) = w; } }
    }
};
}
#define LAS __attribute__((address_space(3)))
#define GAS __attribute__((address_space(1)))
typedef unsigned v4u __attribute__((ext_vector_type(4)));
typedef GAS unsigned gu32;
typedef GAS unsigned long long gu64;
#define RLX_AGENT __ATOMIC_RELAXED, __HIP_MEMORY_SCOPE_AGENT
#define LDS_WAIT() asm volatile("s_waitcnt lgkmcnt(0)" ::: "memory")
#define VM_WAIT() asm volatile("s_waitcnt vmcnt(0)" ::: "memory")
__device__ __forceinline__ unsigned long long rt() { return __builtin_amdgcn_s_memrealtime(); }
#define XB_TMO      128
#define XB_XCNT(j)  (256  + 64 * (j))
#define XB_XSUB(j)  (1280 + 64 * (j))
#define XB_XGEN(j)  (2304 + 64 * (j))
#define XB_TOP      3328
#define XB_TOPGEN   3392
#define XCD_BAR_WORDS 3456
#define XB_SPIN_CAP (1u << 22)

__device__ __forceinline__ unsigned xb_ld(unsigned* p)              { return __hip_atomic_load(p, __ATOMIC_RELAXED, __HIP_MEMORY_SCOPE_AGENT); }
__device__ __forceinline__ unsigned xb_add(unsigned* p, unsigned v) { return __hip_atomic_fetch_add(p, v, __ATOMIC_RELAXED, __HIP_MEMORY_SCOPE_AGENT); }
__device__ __forceinline__ unsigned xb_xcc_id() { return (unsigned)__builtin_amdgcn_s_getreg((3 << 11) | 20) & 0xFu; }
#define XB_SPIN(cond, bar) do { unsigned _sp = 0; while (cond) { __builtin_amdgcn_s_sleep(1); \
    if ((++_sp & 255u) == 0u) { if (xb_ld(&(bar)[XB_TMO])) break; if (_sp > XB_SPIN_CAP) { atomicAdd(&(bar)[XB_TMO], 1u); break; } } } } while (0)

struct XcdBarrier {
    unsigned* bar; unsigned x;
    volatile LAS unsigned* st;
};

__device__ __forceinline__ XcdBarrier xcd_barrier_post(unsigned* bar, volatile LAS unsigned* st) {
    XcdBarrier b; b.bar = bar; b.x = xb_xcc_id(); b.st = st;
    if (threadIdx.x == 0) (void)xb_add(&bar[XB_XCNT(b.x)], 1u);
    return b;
}
__device__ __forceinline__ void xcd_barrier_complete(unsigned* bar, unsigned x, unsigned& nloc, unsigned& nx) {
    const unsigned G = gridDim.x * gridDim.y * gridDim.z;
    unsigned sum, cnt, mine, sp = 0u;
    for (;;) {
        sum = 0u; cnt = 0u; mine = 0u;
#pragma unroll
        for (unsigned j = 0; j < 16; ++j) { const unsigned c = xb_ld(&bar[XB_XCNT(j)]); sum += c; cnt += (c > 0u) ? 1u : 0u; mine = (j == x) ? c : mine; }
        if (sum == G) break;
        __builtin_amdgcn_s_sleep(1);
        if ((++sp & 255u) == 0u) { if (xb_ld(&bar[XB_TMO])) break; if (sp > XB_SPIN_CAP) { atomicAdd(&bar[XB_TMO], 1u); break; } }
    }
    nloc = mine > 0u ? mine : 1u; nx = cnt > 0u ? cnt : 1u;
}

__device__ __forceinline__ void xcd_barrier(const XcdBarrier& b) {
    asm volatile("s_waitcnt vmcnt(0)" ::: "memory");
    __syncthreads();
    if (threadIdx.x == 0) {
        unsigned* bar = b.bar;
        __builtin_amdgcn_s_waitcnt(0);
        unsigned nloc = b.st[0], nx = b.st[1];
        if (nloc == 0u) { xcd_barrier_complete(bar, b.x, nloc, nx); b.st[0] = nloc; b.st[1] = nx; }
        const unsigned old = xb_add(&bar[XB_XSUB(b.x)], 1u);
        const unsigned gen = old / nloc;
        if (old + 1u == (gen + 1u) * nloc) {
            __builtin_amdgcn_fence(__ATOMIC_RELEASE, "agent");
            asm volatile("s_waitcnt vmcnt(0)" ::: "memory");
            const unsigned og = xb_add(&bar[XB_TOP], 1u);
            const unsigned tg = og / nx;
            if (og + 1u == (tg + 1u) * nx) xb_add(&bar[XB_TOPGEN], 1u);
            else XB_SPIN(xb_ld(&bar[XB_TOPGEN]) == tg, bar);
            __builtin_amdgcn_fence(__ATOMIC_ACQUIRE, "agent");
            xb_add(&bar[XB_XGEN(b.x)], 1u);
            asm volatile("s_waitcnt vmcnt(0)" ::: "memory");
        } else {
            XB_SPIN(xb_ld(&bar[XB_XGEN(b.x)]) == gen, bar);
            __builtin_amdgcn_fence(__ATOMIC_ACQUIRE, "agent");
            asm volatile("s_waitcnt vmcnt(0)" ::: "memory");
        }
    }
    __syncthreads();
}

typedef unsigned short bf16;
typedef short bf16x8 __attribute__((ext_vector_type(8)));
typedef short s16x4 __attribute__((ext_vector_type(4)));
typedef float f32x4 __attribute__((ext_vector_type(4)));
typedef float f32x16 __attribute__((ext_vector_type(16)));
typedef unsigned u32x4 __attribute__((ext_vector_type(4)));
typedef unsigned u32x2 __attribute__((ext_vector_type(2)));

constexpr int DM = 1024, NB = 32, SEQ = 2048, CTXL = 256, RPB = SEQ + CTXL, MROWS = NB * RPB;
constexpr int DFF = 4096, DEPTH = 4, NWAVES = 8, NTHR = 512;
constexpr int PE = 2048, PO = 2304;
constexpr int E_CKV = 256, E_KR = 384, E_DQ = 416, E_DK = 928, E_DV = 1440;
constexpr int O_GK = 512, O_GV = 640, O_NQ = 768, O_NK = 1280, O_NV = 1792;
constexpr float EPSN = 1e-6f, LOG2E = 1.4426950408889634f, LOG2_THETA = 13.287712379549449f;
constexpr float MLA_SC = 0.10206207261596575f  , HD_SC = 0.125f;

constexpr size_t MiB = 1u << 20;
constexpr size_t WS_MOD = 0;
constexpr size_t WS_HB = 852 * MiB;
constexpr size_t WS_HCB = 980 * MiB;
constexpr size_t WS_WT = 36 * MiB;
constexpr size_t WS_AF = 132 * MiB;
constexpr size_t WS_P = 276 * MiB;
constexpr size_t WS_QM = 600 * MiB;
constexpr size_t WS_KVM = 708 * MiB;
constexpr size_t WS_O = WS_AF;
constexpr size_t WS_F1 = WS_P;
constexpr size_t WS_END = 996 * MiB;
constexpr size_t WS_H = WS_P;
constexpr size_t WL_STRIDE = 24 * MiB, WL_IN = 0, WL_OUT = 5 * MiB, WL_FF1 = 7 * MiB, WL_FF2 = 15 * MiB, WL_UQ = 23 * MiB, WL_UKV = 23 * MiB + 512 * 1024;
static_assert(WS_H + (size_t)MROWS * DFF * 2 <= WS_HB, "H overlay");
constexpr int LDS_BYTES = 147456, LDS_BARST = 147200;
constexpr size_t WS_BAR = 3 * MiB + 512 * 1024;

struct Args { const float* in[21]; float* out; unsigned char* ws; int ph_lo, ph_hi; };

__device__ __forceinline__ float bf2f(unsigned short b) { return __uint_as_float((unsigned)b << 16); }
typedef float f32x2_t __attribute__((ext_vector_type(2))); typedef __bf16 bf16x2_t __attribute__((ext_vector_type(2)));
__device__ __forceinline__ unsigned pk2(float lo, float hi) { f32x2_t v = {lo, hi}; bf16x2_t b = __builtin_convertvector(v, bf16x2_t); return __builtin_bit_cast(unsigned, b); }
__device__ __forceinline__ unsigned short f2bf(float f) { return (unsigned short)(pk2(f, 0.f) & 0xffffu); }
__device__ __forceinline__ float dpp_add(float v, int ctrl_qp1, int) { return v; }
template <int CTRL> __device__ __forceinline__ float dpp_mov(float v) { return __int_as_float(__builtin_amdgcn_update_dpp(0, __float_as_int(v), CTRL, 0xF, 0xF, true)); }
__device__ __forceinline__ float sum8(float v) {
    v += dpp_mov<0xB1>(v);
    v += dpp_mov<0x4E>(v);
    v += dpp_mov<0x141>(v);
    return v;
}
__device__ __forceinline__ float sum16(float v) { v = sum8(v); v += dpp_mov<0x140>(v); return v; }
__device__ __forceinline__ float wave_sum(float v) { v = sum16(v); v += __shfl_xor(v, 16); v += __shfl_xor(v, 32); return v; }
__device__ __forceinline__ float half_sum(float v) {
#pragma unroll
    for (int o = 1; o < 32; o <<= 1) v += __shfl_xor(v, o);
    return v;
}

__device__ __forceinline__ void transpose_item(const float* W, int K, int N, bf16* WT, LAS float* scr, int item, int lane, const float* kscale, float sc) {
    const int nblk = N / 32, kb = item / nblk, nb = item % nblk, k0 = 64 * kb, n0 = 32 * nb;
#pragma unroll
    for (int i = 0; i < 8; ++i) { const int kk = 8 * i + (lane >> 3); const f32x4 w = *(const f32x4*)(W + (size_t)(k0 + kk) * N + n0 + 4 * (lane & 7));
        const float s_ = kscale ? kscale[k0 + kk] * sc : sc;
#pragma unroll
        for (int j = 0; j < 4; ++j) scr[kk * 33 + 4 * (lane & 7) + j] = w[j] * s_; }
    asm volatile("s_waitcnt lgkmcnt(0)" ::: "memory");
    const int c = lane & 7;
#pragma unroll
    for (int j = 0; j < 4; ++j) { const int n = (lane >> 3) + 8 * j; const LAS float* s = scr + (8 * c) * 33 + n;
        u32x4 o; o.x = pk2(s[0 * 33], s[1 * 33]); o.y = pk2(s[2 * 33], s[3 * 33]); o.z = pk2(s[4 * 33], s[5 * 33]); o.w = pk2(s[6 * 33], s[7 * 33]);
        *(u32x4*)(WT + (size_t)(n0 + n) * K + k0 + 8 * c) = o; }
    asm volatile("s_waitcnt lgkmcnt(0)" ::: "memory");
}

struct Ctx {
    LAS unsigned char* lds; int tid, lane, wave, vcu, G;
    float* out; unsigned char* ws;
};

__device__ __forceinline__ void phase_prologue_a(const Ctx& F, const Args& args) {
    {
        LAS float* S = (LAS float*)F.lds;
        LAS float* R = (LAS float*)(F.lds + 33 * 512 * 4);
        const float* c = args.in[1]; const float* cc = args.in[3]; const float* wada = args.in[4]; const float* bada = args.in[5];
        float* MOD = (float*)(F.ws + WS_MOD);
        const int cg_ = F.lane & 31, kh = F.lane >> 5;
        for (int it = F.vcu; it < 4 * 192; it += F.G) {
            const int l = it / 192, n0 = (it % 192) * 32;
            float acc[33];
#pragma unroll
            for (int r = 0; r < 33; ++r) acc[r] = 0.f;
            for (int half = 0; half < 2; ++half) {
                __syncthreads();
                for (int e = F.tid; e < 33 * 512; e += NTHR) { const int r = e >> 9, k = (e & 511) + half * 512; const float v = (r < 32) ? c[r * 1024 + k] : cc[k]; S[e] = v / (1.f + __expf(-v)); }
                __syncthreads();
                const int kb = F.wave * 64 + kh * 32;
                const float* wp = wada + ((size_t)l * 1024 + half * 512 + kb) * 6144 + n0 + cg_;
                for (int kk = 0; kk < 32; kk += 4) {
                    const float w0 = wp[(size_t)(kk + 0) * 6144], w1 = wp[(size_t)(kk + 1) * 6144], w2 = wp[(size_t)(kk + 2) * 6144], w3 = wp[(size_t)(kk + 3) * 6144];
#pragma unroll
                    for (int r = 0; r < 33; ++r) { const f32x4 s = *(const LAS f32x4*)(S + r * 512 + kb + kk); acc[r] += s[0] * w0 + s[1] * w1 + s[2] * w2 + s[3] * w3; }
                }
            }
#pragma unroll
            for (int r = 0; r < 33; ++r) { acc[r] += __shfl_xor(acc[r], 32); if (kh == 0) R[(F.wave * 33 + r) * 32 + cg_] = acc[r]; }
            __syncthreads();
            for (int e = F.tid; e < 33 * 32; e += NTHR) { float s = 0.f;
#pragma unroll
                for (int w = 0; w < 8; ++w) s += R[w * 33 * 32 + e];
                const int r = e >> 5, n = n0 + (e & 31); MOD[((size_t)l * 33 + r) * 6144 + n] = s + bada[l * 6144 + n]; }
        }
        __syncthreads();
    }
    {
        LAS float* scr = (LAS float*)(F.lds + F.wave * 16384);
        const int gw = F.vcu * NWAVES + F.wave, NGW = F.G * NWAVES;
        constexpr int I_INE = 16 * 61, I_INO = 16 * 72, I_OUT = 16 * 32, I_FF1 = 16 * 128, I_FF2 = 64 * 32, I_UQ = 4 * 24, I_UKV = 2 * 32, I_Z = 96;
        constexpr int PER_E = I_INE + I_OUT + I_FF1 + I_FF2 + I_UQ + I_UKV + I_Z, PER_O = I_INO + I_OUT + I_FF1 + I_FF2;
        constexpr int NIT = 2 * (PER_E + PER_O);
        for (int it = gw; it < NIT; it += NGW) {
            int pr = it / (PER_E + PER_O), r = it % (PER_E + PER_O);
            const bool odd = r >= PER_E; if (odd) r -= PER_E;
            const int L = 2 * pr + (odd ? 1 : 0);
            unsigned char* wl = F.ws + WS_WT + (size_t)L * WL_STRIDE;
            const float* W; int K, N; size_t wo; const float* ks = nullptr; float sc = 1.f; bool zero = false;
            if (!odd) {
                if (r < I_INE) { W = args.in[9] + (size_t)pr * 1024 * 1952; K = 1024; N = 1952; wo = WL_IN; }
                else if ((r -= I_INE) < I_OUT) { W = args.in[10] + (size_t)pr * 1024 * 1024; K = 1024; N = 1024; wo = WL_OUT; }
                else if ((r -= I_OUT) < I_FF1) { W = args.in[7] + (size_t)L * 1024 * 4096; K = 1024; N = 4096; wo = WL_FF1; }
                else if ((r -= I_FF1) < I_FF2) { W = args.in[8] + (size_t)L * 4096 * 1024; K = 4096; N = 1024; wo = WL_FF2; }
                else if ((r -= I_FF2) < I_UQ) { W = args.in[12] + (size_t)pr * 256 * 768; K = 256; N = 768; wo = WL_UQ; ks = args.in[11] + pr * 256; sc = MLA_SC * LOG2E; }
                else if ((r -= I_UQ) < I_UKV) { W = args.in[14] + (size_t)pr * 128 * 1024; K = 128; N = 1024; wo = WL_UKV; ks = args.in[13] + pr * 128; }
                else { r -= I_UKV; zero = true; W = nullptr; K = 0; N = 0; wo = WL_IN; }
            } else {
                if (r < I_INO) { W = args.in[17] + (size_t)pr * 1024 * 2304; K = 1024; N = 2304; wo = WL_IN; }
                else if ((r -= I_INO) < I_OUT) { W = args.in[18] + (size_t)pr * 1024 * 1024; K = 1024; N = 1024; wo = WL_OUT; }
                else if ((r -= I_OUT) < I_FF1) { W = args.in[7] + (size_t)L * 1024 * 4096; K = 1024; N = 4096; wo = WL_FF1; }
                else { r -= I_FF1; W = args.in[8] + (size_t)L * 4096 * 1024; K = 4096; N = 1024; wo = WL_FF2; }
            }
            if (zero) { bf16* z = (bf16*)(wl + WL_IN) + (size_t)(1952 + r) * 1024; u32x4 zz = {0u, 0u, 0u, 0u}; *(u32x4*)(z + F.lane * 8) = zz; *(u32x4*)(z + 512 + F.lane * 8) = zz; }
            else transpose_item(W, K, N, (bf16*)(wl + wo), scr, r, F.lane, ks, sc);
        }
    }
}

__device__ __forceinline__ void unpack8(const u32x4 v, float* x) {
#pragma unroll
    for (int i = 0; i < 4; ++i) { x[2 * i] = __uint_as_float(v[i] << 16); x[2 * i + 1] = __uint_as_float(v[i] & 0xffff0000u); }
}
__device__ __forceinline__ u32x4 pack8(const float* x) { u32x4 w; w.x = pk2(x[0], x[1]); w.y = pk2(x[2], x[3]); w.z = pk2(x[4], x[5]); w.w = pk2(x[6], x[7]); return w; }
struct RowPassP { const void* hin_lat; const void* hin_ctx; bf16* hb_lat; bf16* hb_ctx; float* out32; const bf16* Fsrc; bf16* Adst; const float* g_post; const float* g_pre;
                  const float* mod_post; const float* mod_pre; int gate_chunk, shift_chunk, scale_chunk; int has_f, write_h, write_a, skip_ctx, final32; };
template <bool HIN32, bool HAS_F, bool WRITE_H, bool WRITE_A, bool FINAL32>
__device__ __forceinline__ void phase_rowpass(const Ctx& F, const RowPassP p) {
    const int nrows = p.skip_ctx ? NB * SEQ : MROWS;
    const int rpb_ = (nrows + F.G - 1) / F.G; const int cbeg = F.vcu * rpb_, cend = min(cbeg + rpb_, nrows);
    const int c0 = F.lane * 8;
    float gpo[16], gpr[16];
#pragma unroll
    for (int jj = 0; jj < 2; ++jj)
#pragma unroll
        for (int q = 0; q < 2; ++q) { const f32x4 a = *(const f32x4*)(p.g_post + jj * 512 + c0 + q * 4), b = *(const f32x4*)(p.g_pre + jj * 512 + c0 + q * 4);
#pragma unroll
            for (int e = 0; e < 4; ++e) { gpo[jj * 8 + q * 4 + e] = a[e]; gpr[jj * 8 + q * 4 + e] = b[e]; } }
    int cur = cbeg;
    while (cur < cend) {
        int b, j0, send;
        if (p.skip_ctx) { b = cur / SEQ; j0 = cur - b * SEQ + CTXL; send = min(cend, (b + 1) * SEQ); }
        else { b = cur / RPB; j0 = cur - b * RPB; send = min(cend, (j0 < CTXL) ? b * RPB + CTXL : (b + 1) * RPB); }
        const bool isc = j0 < CTXL; const int mrow = isc ? 32 : b; const int n = send - cur;
        const size_t hbase = isc ? (size_t)(b * CTXL + j0) * DM : (size_t)(b * SEQ + j0 - CTXL) * DM;
        const size_t rbase = (size_t)(b * RPB + j0) * DM;
        float gt[16], sh[16], sc[16];
        { const float* gp = p.mod_post + (size_t)mrow * 6144 + p.gate_chunk * 1024; const float* sp = p.mod_pre + (size_t)mrow * 6144 + p.shift_chunk * 1024; const float* cp = p.mod_pre + (size_t)mrow * 6144 + p.scale_chunk * 1024;
#pragma unroll
          for (int jj = 0; jj < 2; ++jj)
#pragma unroll
              for (int q = 0; q < 2; ++q) { const f32x4 a = *(const f32x4*)(gp + jj * 512 + c0 + q * 4), s1 = *(const f32x4*)(sp + jj * 512 + c0 + q * 4), s2 = *(const f32x4*)(cp + jj * 512 + c0 + q * 4);
#pragma unroll
                  for (int e = 0; e < 4; ++e) { gt[jj * 8 + q * 4 + e] = a[e]; sh[jj * 8 + q * 4 + e] = s1[e]; sc[jj * 8 + q * 4 + e] = 1.f + s2[e]; } } }
        const float* hin32 = (const float*)(isc ? p.hin_ctx : p.hin_lat) + hbase; const bf16* hinb = (const bf16*)(isc ? p.hin_ctx : p.hin_lat) + hbase;
        bf16* houtb = (isc ? p.hb_ctx : p.hb_lat) + hbase; float* hout32 = p.out32 + hbase;
        const bf16* fsrc = p.Fsrc + rbase; bf16* adst = p.Adst + rbase;
        f32x4 hn[HIN32 ? 4 : 1]; u32x4 hbn[HIN32 ? 1 : 2]; u32x4 fn[2];
#define RP_LOAD(i_) do { const size_t o_ = (size_t)(i_) * DM; \
            if constexpr (HIN32) { _Pragma("unroll") for (int jj_ = 0; jj_ < 2; ++jj_) { hn[jj_ * 2] = *(const f32x4*)(hin32 + o_ + jj_ * 512 + c0); hn[jj_ * 2 + 1] = *(const f32x4*)(hin32 + o_ + jj_ * 512 + c0 + 4); } } \
            else { _Pragma("unroll") for (int jj_ = 0; jj_ < 2; ++jj_) hbn[jj_] = __builtin_nontemporal_load((const u32x4*)(hinb + o_ + jj_ * 512 + c0)); } \
            if constexpr (HAS_F) { _Pragma("unroll") for (int jj_ = 0; jj_ < 2; ++jj_) fn[jj_] = *(const u32x4*)(fsrc + o_ + jj_ * 512 + c0); } } while (0)
        int i = F.wave;
        if (i < n) RP_LOAD(i);
        for (; i < n; i += NWAVES) {
            float h[16]; u32x4 fc[2];
#pragma unroll
            for (int jj = 0; jj < 2; ++jj) {
                if constexpr (HIN32) {
#pragma unroll
                    for (int e = 0; e < 4; ++e) { h[jj * 8 + e] = hn[jj * 2][e]; h[jj * 8 + 4 + e] = hn[jj * 2 + 1][e]; } }
                else unpack8(hbn[jj], h + jj * 8);
                if constexpr (HAS_F) fc[jj] = fn[jj]; }
            { const int inx = (i + NWAVES < n) ? i + NWAVES : i; RP_LOAD(inx); }
            const size_t ro = (size_t)i * DM;
            if constexpr (HAS_F) {
                float f[16]; float ss = 0.f;
                unpack8(fc[0], f); unpack8(fc[1], f + 8);
#pragma unroll
                for (int e = 0; e < 16; ++e) ss += f[e] * f[e];
                ss = wave_sum(ss); const float rs = rsqrtf(ss * (1.f / DM) + EPSN);
#pragma unroll
                for (int e = 0; e < 16; ++e) h[e] += gt[e] * (f[e] * rs * gpo[e]);
            }
            if constexpr (FINAL32) {
#pragma unroll
                for (int jj = 0; jj < 2; ++jj) { f32x4 a, c;
#pragma unroll
                    for (int e = 0; e < 4; ++e) { a[e] = h[jj * 8 + e]; c[e] = h[jj * 8 + 4 + e]; }
                    *(f32x4*)(hout32 + ro + jj * 512 + c0) = a; *(f32x4*)(hout32 + ro + jj * 512 + c0 + 4) = c; }
            }
            if constexpr (WRITE_H) {
#pragma unroll
                for (int jj = 0; jj < 2; ++jj) { const u32x4 w = pack8(h + jj * 8); __builtin_nontemporal_store(w, (u32x4*)(houtb + ro + jj * 512 + c0)); unpack8(w, h + jj * 8); }
            }
            if constexpr (WRITE_A) {
                float ss = 0.f;
#pragma unroll
                for (int e = 0; e < 16; ++e) ss += h[e] * h[e];
                ss = wave_sum(ss); const float rs = rsqrtf(ss * (1.f / DM) + EPSN);
#pragma unroll
                for (int jj = 0; jj < 2; ++jj) { float o[8];
#pragma unroll
                    for (int e = 0; e < 8; ++e) o[e] = (h[jj * 8 + e] * rs * gpr[jj * 8 + e]) * sc[jj * 8 + e] + sh[jj * 8 + e];
                    *(u32x4*)(adst + ro + jj * 512 + c0) = pack8(o); }
            }
        }
#undef RP_LOAD
        cur = send;
    }
}

__device__ __forceinline__ void rope_cs(int j, int i, int nfreq, float& cs, float& sn) {
    if (j < CTXL) { cs = 1.f; sn = 0.f; return; }
    const int t = j - CTXL; const int fi = (i < nfreq) ? i : i - nfreq; const float pos = (i < nfreq) ? (float)(t >> 6) : (float)(t & 63);
    const float ang = pos * exp2f(-(float)fi * (LOG2_THETA / (float)nfreq));
    cs = __cosf(ang); sn = __sinf(ang);
}
__device__ __forceinline__ void rope8(float* x, int lane, bool isx2, float pos, const float* finv, bool doit, float scale) {
    float y[8];
#pragma unroll
    for (int e = 0; e < 8; ++e) y[e] = __shfl_xor(x[e], 4);
    (void)lane;
#pragma unroll
    for (int e = 0; e < 8; ++e) {
        float cs = 1.f, sn = 0.f;
        if (doit) { const float ang = pos * finv[e]; cs = __cosf(ang); sn = __sinf(ang); }
        x[e] = (isx2 ? (x[e] * cs + y[e] * sn) : (x[e] * cs - y[e] * sn)) * scale;
    }
}
__device__ __forceinline__ void phase_prep_even(const Ctx& F) {
    bf16* P = (bf16*)(F.ws + WS_P); bf16* CQN = (bf16*)(F.ws + WS_AF); bf16* CKVN = (bf16*)(F.ws + WS_AF + 36 * MiB);
    const int gw = F.vcu * NWAVES + F.wave, NGW = F.G * NWAVES; const int lane = F.lane; const int chunk = (MROWS + NGW - 1) / NGW;
    const int r0 = gw * chunk, r1 = min(r0 + chunk, MROWS);
    if (r0 >= r1) return;
    const int ca = lane < 52 ? lane : 51;
    const int cv = lane & 7; const bool isx2 = (cv & 4) != 0; const bool colang = (cv & 2) != 0;
    float finv[8], finvk[8];
#pragma unroll
    for (int e = 0; e < 8; ++e) { finv[e] = exp2f(-(float)(8 * (cv & 1) + e) * (LOG2_THETA / 16.f)); finvk[e] = exp2f(-(float)e * (LOG2_THETA / 8.f)); }
    u32x4 na, nb, nc;
    { const bf16* pr = P + (size_t)r0 * PE; na = *(const u32x4*)(pr + 8 * ca); nb = *(const u32x4*)(pr + E_DQ + 8 * lane); nc = *(const u32x4*)(pr + E_DK + 8 * lane); }
    for (int r = r0; r < r1; ++r) {
        const u32x4 va = na, vb = nb, vc = nc;
        if (r + 1 < r1) { const bf16* pn = P + (size_t)(r + 1) * PE; na = *(const u32x4*)(pn + 8 * ca); nb = *(const u32x4*)(pn + E_DQ + 8 * lane); nc = *(const u32x4*)(pn + E_DK + 8 * lane); }
        const int j = r % RPB; const bool lat = j >= CTXL; const int t = j - CTXL;
        const float posh = colang ? (float)(t & 63) : (float)(t >> 6);
        bf16* pr = P + (size_t)r * PE;
        {
            float x[8]; unpack8(va, x);
            float ss = 0.f;
#pragma unroll
            for (int e = 0; e < 8; ++e) ss += x[e] * x[e];
            ss = sum16(ss);
            const float ss32 = ss + __shfl_xor(ss, 16);
            const float rs = (lane < 32) ? rsqrtf(ss32 * (1.f / 256.f) + EPSN) : rsqrtf(ss * (1.f / 128.f) + EPSN);
            float y[8];
#pragma unroll
            for (int e = 0; e < 8; ++e) y[e] = __shfl_xor(x[e], 2);
            if (lane < 32) { float o[8];
#pragma unroll
                for (int e = 0; e < 8; ++e) o[e] = x[e] * rs;
                *(u32x4*)(CQN + (size_t)r * 256 + 8 * lane) = pack8(o); }
            else if (lane < 48) { float o[8];
#pragma unroll
                for (int e = 0; e < 8; ++e) o[e] = x[e] * rs;
                *(u32x4*)(CKVN + (size_t)r * 128 + 8 * (lane - 32)) = pack8(o); }
            else if (lane < 52 && lat) { const float pos = (lane & 1) ? (float)(t & 63) : (float)(t >> 6); const bool x2 = (lane & 2) != 0; float o[8];
#pragma unroll
                for (int e = 0; e < 8; ++e) { const float ang = pos * finvk[e]; const float cs = __cosf(ang), sn = __sinf(ang); o[e] = x2 ? (x[e] * cs + y[e] * sn) : (x[e] * cs - y[e] * sn); }
                *(u32x4*)(pr + 8 * lane) = pack8(o); }
        }
        { float x[8]; unpack8(vb, x); rope8(x, lane, isx2, posh, finv, lat, HD_SC * LOG2E); *(u32x4*)(pr + E_DQ + 8 * lane) = pack8(x); }
        if (lat) { float x[8]; unpack8(vc, x); rope8(x, lane, isx2, posh, finv, true, 1.f); *(u32x4*)(pr + E_DK + 8 * lane) = pack8(x); }
    }
}
__device__ __forceinline__ void phase_prep_odd(const Ctx& F, const float* qkn  ) {
    bf16* P = (bf16*)(F.ws + WS_P);
    const int gw = F.vcu * NWAVES + F.wave, NGW = F.G * NWAVES; const int lane = F.lane; const int chunk = (MROWS + NGW - 1) / NGW;
    const int r0 = gw * chunk, r1 = min(r0 + chunk, MROWS);
    if (r0 >= r1) return;
    const int cv = lane & 7; const bool isx2 = (cv & 4) != 0; const bool colang = (cv & 2) != 0;
    float finv[8], gq[8], gk[8];
#pragma unroll
    for (int e = 0; e < 8; ++e) { finv[e] = exp2f(-(float)(8 * (cv & 1) + e) * (LOG2_THETA / 16.f)); gq[e] = qkn[8 * cv + e]; gk[e] = qkn[64 + 8 * cv + e]; }
    u32x4 na, nb, nc;
    { const bf16* pr = P + (size_t)r0 * PO; na = *(const u32x4*)(pr + 8 * lane); nb = *(const u32x4*)(pr + O_GK + 8 * (lane & 15)); nc = *(const u32x4*)(pr + O_NQ + 8 * lane); }
    for (int r = r0; r < r1; ++r) {
        const u32x4 va = na, vb = nb, vc = nc;
        if (r + 1 < r1) { const bf16* pn = P + (size_t)(r + 1) * PO; na = *(const u32x4*)(pn + 8 * lane); nb = *(const u32x4*)(pn + O_GK + 8 * (lane & 15)); nc = *(const u32x4*)(pn + O_NQ + 8 * lane); }
        const int j = r % RPB; const bool lat = j >= CTXL; const int t = j - CTXL;
        const float posh = colang ? (float)(t & 63) : (float)(t >> 6);
        bf16* pr = P + (size_t)r * PO;
        { float x[8]; unpack8(va, x); float ss = 0.f;
#pragma unroll
          for (int e = 0; e < 8; ++e) ss += x[e] * x[e];
          ss = sum8(ss);
          const float rs = rsqrtf(ss * (1.f / 64.f) + EPSN);
#pragma unroll
          for (int e = 0; e < 8; ++e) x[e] *= rs * gq[e];
          rope8(x, lane, isx2, posh, finv, lat, HD_SC * LOG2E); *(u32x4*)(pr + 8 * lane) = pack8(x); }
        { float x[8]; unpack8(vb, x); float ss = 0.f;
#pragma unroll
          for (int e = 0; e < 8; ++e) ss += x[e] * x[e];
          ss = sum8(ss);
          const float rs = rsqrtf(ss * (1.f / 64.f) + EPSN);
#pragma unroll
          for (int e = 0; e < 8; ++e) x[e] *= rs * gk[e];
          rope8(x, lane, isx2, posh, finv, lat, 1.f); if (lane < 16) *(u32x4*)(pr + O_GK + 8 * lane) = pack8(x); }
        { float x[8]; unpack8(vc, x);
#pragma unroll
          for (int e = 0; e < 8; ++e) x[e] *= (HD_SC * LOG2E);
          *(u32x4*)(pr + O_NQ + 8 * lane) = pack8(x); }
    }
}

struct AttnP {
    const bf16* q; int qpitch; const bf16* ka; int kapitch; const bf16* kb; int kbpitch; const bf16* v; int vpitch; bf16* o; int opitch;
    int nA, tB0, nB;
    int rope_t0;
    int mode;
    float lam, post; const float* subln;
    int na_row0;
};
__device__ __forceinline__ int crow(int r, int hi) { return (r & 3) + 8 * (r >> 2) + 4 * hi; }

struct AttnP2 { const bf16* qA; const bf16* qB; int qpitch; const bf16* ka; int kapitch; const bf16* v; int vpitch; bf16* oA; bf16* oB; int opitch; int ntile; };
__device__ __forceinline__ void attn_unit_gqa2(const AttnP2& a, LAS unsigned char* lds, int tid) {
    constexpr int DQK = 64, DV = 64, KP = DQK * 2 + 16, KBYTES = 64 * KP, VBYTES = 64 * DV * 2, BUF = KBYTES + VBYTES, KCH = DQK / 8, VCH = DV / 8, ND = DQK / 16, NDB = DV / 32;
    const int lane = tid & 63, wave = __builtin_amdgcn_readfirstlane(tid >> 6), r32 = lane & 31, hi = lane >> 5;
    bf16x8 qfA[ND], qfB[ND];
    { const size_t ro = (size_t)(wave * 32 + r32) * a.qpitch + hi * 8;
#pragma unroll
      for (int d0 = 0; d0 < ND; ++d0) { qfA[d0] = *(const bf16x8*)(a.qA + ro + d0 * 16); qfB[d0] = *(const bf16x8*)(a.qB + ro + d0 * 16); } }
    constexpr int KS = KP / 16, NIK = KS, NIV = VCH, NI = NIK + NIV, MAXI = (NI + 7) / 8;
    const bf16* gsrc[MAXI]; unsigned gstep[MAXI];
#pragma unroll
    for (int j = 0; j < MAXI; ++j) {
        const int ii = wave + 8 * j; const int s = ii * 64 + lane;
        if (ii < NIK) { const int row = s / KS; int ch = s - row * KS; if (ch >= KCH) ch = 0; gsrc[j] = a.ka + (size_t)row * a.kapitch + ch * 8; gstep[j] = 64u * (unsigned)a.kapitch; }
        else { const int s2 = (s - 64 * KS) & (64 * VCH - 1); const int st = s2 >> 5, rowin = (s2 & 31) >> 2, chin = s2 & 3; const int row = (st / NDB) * 8 + rowin, ch = (st % NDB) * 4 + chin;
            gsrc[j] = a.v + (size_t)row * a.vpitch + ch * 8; gstep[j] = 64u * (unsigned)a.vpitch; }
    }
    const int mycnt = (NI - 1 - wave) / 8 + 1;
    const int ntile = a.ntile;
#define ATT_ISSUE(tt_, slot_) do { _Pragma("unroll") for (int j_ = 0; j_ < MAXI; ++j_) if (wave + 8 * j_ < NI) \
        __builtin_amdgcn_global_load_lds((const unsigned*)(gsrc[j_] + (size_t)(tt_) * gstep[j_]), (LAS unsigned*)(lds + (slot_) * BUF + (wave + 8 * j_) * 1024), 16, 0, 0); } while (0)
#define ATT_WAITBAR(keep_) do { if (keep_) { if (mycnt == MAXI) asm volatile("s_waitcnt vmcnt(%0) lgkmcnt(0)\n\ts_barrier" :: "n"(MAXI) : "memory"); else asm volatile("s_waitcnt vmcnt(%0) lgkmcnt(0)\n\ts_barrier" :: "n"(MAXI - 1) : "memory"); } \
        else asm volatile("s_waitcnt vmcnt(0) lgkmcnt(0)\n\ts_barrier" ::: "memory"); } while (0)
    ATT_ISSUE(0, 0);
    if (ntile > 1) ATT_ISSUE(1, 1);
    ATT_WAITBAR(ntile > 1);
    constexpr float THR = 8.f;
    float mrunA = 0.f, lrunA = 0.f, mrunB = 0.f, lrunB = 0.f;
    f32x16 oA[NDB], oB[NDB];
#pragma unroll
    for (int d = 0; d < NDB; ++d) { oA[d] = f32x16{}; oB[d] = f32x16{}; }
    const int koff = r32 * KP + hi * 16;
    const int voff = KBYTES + (4 * hi + ((lane & 15) >> 2)) * 64 + ((lane >> 4) & 1) * 32 + (lane & 3) * 8;
    int slot0 = 0, slot2 = 2;
    for (int it = 0; it < ntile; ++it) {
        if (it + 2 < ntile) ATT_ISSUE(it + 2, slot2);
        LAS unsigned char* kb_ = lds + slot0 * BUF;
        bf16x8 kf0[ND], kf1[ND];
#pragma unroll
        for (int d0 = 0; d0 < ND; ++d0) { kf0[d0] = *(const LAS bf16x8*)(kb_ + koff + d0 * 32); kf1[d0] = *(const LAS bf16x8*)(kb_ + koff + 32 * KP + d0 * 32); }
        bf16x8 pwA[4], pwB[4];
#define GQ_HEAD(QF_, MRUN_, LRUN_, O_, PW_) do { \
            f32x16 p0 = f32x16{}, p1 = f32x16{}; \
            _Pragma("unroll") for (int d0 = 0; d0 < ND; ++d0) { p0 = __builtin_amdgcn_mfma_f32_32x32x16_bf16(kf0[d0], QF_[d0], p0, 0, 0, 0); p1 = __builtin_amdgcn_mfma_f32_32x32x16_bf16(kf1[d0], QF_[d0], p1, 0, 0, 0); } \
            float mxa = fmaxf(fmaxf(p0[0], p0[1]), p1[0]), mxb = fmaxf(fmaxf(p0[2], p0[3]), p1[1]); \
            mxa = fmaxf(fmaxf(mxa, p1[2]), p1[3]); \
            _Pragma("unroll") for (int r = 4; r < 16; r += 4) { mxa = fmaxf(fmaxf(mxa, p0[r]), p0[r + 1]); mxb = fmaxf(fmaxf(mxb, p0[r + 2]), p0[r + 3]); mxa = fmaxf(fmaxf(mxa, p1[r]), p1[r + 1]); mxb = fmaxf(fmaxf(mxb, p1[r + 2]), p1[r + 3]); } \
            float mx = fmaxf(mxa, mxb); \
            { const auto rr = __builtin_amdgcn_permlane32_swap(__float_as_uint(mx), __float_as_uint(mx), false, false); mx = fmaxf(__uint_as_float(rr[0]), __uint_as_float(rr[1])); } \
            mx -= MRUN_; \
            if (it == 0 || __any(mx > THR)) { const float dl = (it == 0) ? mx : fmaxf(mx, 0.f); MRUN_ += dl; const float alpha = __builtin_amdgcn_exp2f(-dl); LRUN_ *= alpha; \
                _Pragma("unroll") for (int d = 0; d < NDB; ++d) _Pragma("unroll") for (int r = 0; r < 16; ++r) O_[d][r] *= alpha; } \
            float rs0 = 0.f, rs1 = 0.f; \
            _Pragma("unroll") for (int r = 0; r < 16; ++r) { p0[r] = __builtin_amdgcn_exp2f(p0[r] - MRUN_); p1[r] = __builtin_amdgcn_exp2f(p1[r] - MRUN_); rs0 += p0[r]; rs1 += p1[r]; } \
            LRUN_ += rs0 + rs1; \
            _Pragma("unroll") for (int ks = 0; ks < 4; ++ks) { u32x4 w; const int b = 8 * (ks & 1); \
                if (ks < 2) { w.x = pk2(p0[b], p0[b + 1]); w.y = pk2(p0[b + 2], p0[b + 3]); w.z = pk2(p0[b + 4], p0[b + 5]); w.w = pk2(p0[b + 6], p0[b + 7]); } \
                else { w.x = pk2(p1[b], p1[b + 1]); w.y = pk2(p1[b + 2], p1[b + 3]); w.z = pk2(p1[b + 4], p1[b + 5]); w.w = pk2(p1[b + 6], p1[b + 7]); } \
                PW_[ks] = __builtin_bit_cast(bf16x8, w); } } while (0)
        GQ_HEAD(qfA, mrunA, lrunA, oA, pwA);
        GQ_HEAD(qfB, mrunB, lrunB, oB, pwB);
#undef GQ_HEAD
        {
            const unsigned vaddr = (unsigned)(size_t)kb_ + (unsigned)voff;
            s16x4 vlo[2][NDB], vhi[2][NDB];
#define ATT_VRD(set_, ks_) do { _Pragma("unroll") for (int d_ = 0; d_ < NDB; ++d_) { \
                asm volatile("ds_read_b64_tr_b16 %0, %1 offset:%2" : "=&v"(vlo[set_][d_]) : "v"(vaddr), "n"(((2 * (ks_)) * NDB + d_) * 512)); \
                asm volatile("ds_read_b64_tr_b16 %0, %1 offset:%2" : "=&v"(vhi[set_][d_]) : "v"(vaddr), "n"(((2 * (ks_) + 1) * NDB + d_) * 512)); } } while (0)
            ATT_VRD(0, 0);
#pragma unroll
            for (int ks = 0; ks < 4; ++ks) {
                const int cs = ks & 1;
                if (ks < 3) { if (ks == 0) ATT_VRD(1, 1); else if (ks == 1) ATT_VRD(0, 2); else ATT_VRD(1, 3); }
                if (ks < 3) asm volatile("s_waitcnt lgkmcnt(4)" : "+v"(vlo[cs][0]), "+v"(vhi[cs][0]), "+v"(vlo[cs][1]), "+v"(vhi[cs][1]));
                else asm volatile("s_waitcnt lgkmcnt(0)" : "+v"(vlo[cs][0]), "+v"(vhi[cs][0]), "+v"(vlo[cs][1]), "+v"(vhi[cs][1]));
#pragma unroll
                for (int d = 0; d < NDB; ++d) {
                    const bf16x8 vf = {vlo[cs][d][0], vlo[cs][d][1], vlo[cs][d][2], vlo[cs][d][3], vhi[cs][d][0], vhi[cs][d][1], vhi[cs][d][2], vhi[cs][d][3]};
                    oA[d] = __builtin_amdgcn_mfma_f32_32x32x16_bf16(vf, pwA[ks], oA[d], 0, 0, 0);
                    oB[d] = __builtin_amdgcn_mfma_f32_32x32x16_bf16(vf, pwB[ks], oB[d], 0, 0, 0);
                }
            }
#undef ATT_VRD
        }
        ATT_WAITBAR(it + 2 < ntile);
        slot0 = (slot0 == 2) ? 0 : slot0 + 1; slot2 = (slot2 == 2) ? 0 : slot2 + 1;
    }
#undef ATT_ISSUE
#undef ATT_WAITBAR
    lrunA += __shfl_xor(lrunA, 32); lrunB += __shfl_xor(lrunB, 32);
    const float invA = 1.f / lrunA, invB = 1.f / lrunB;
    const size_t oo = (size_t)(wave * 32 + r32) * a.opitch + 4 * hi;
#pragma unroll
    for (int d = 0; d < NDB; ++d)
#pragma unroll
        for (int g = 0; g < 4; ++g) { u32x2 w; w.x = pk2(oA[d][4 * g] * invA, oA[d][4 * g + 1] * invA); w.y = pk2(oA[d][4 * g + 2] * invA, oA[d][4 * g + 3] * invA); *(u32x2*)(a.oA + oo + 32 * d + 8 * g) = w;
            u32x2 w2; w2.x = pk2(oB[d][4 * g] * invB, oB[d][4 * g + 1] * invB); w2.y = pk2(oB[d][4 * g + 2] * invB, oB[d][4 * g + 3] * invB); *(u32x2*)(a.oB + oo + 32 * d + 8 * g) = w2; }
}

template <int DQK, int DV, bool NA>
__device__ __forceinline__ void attn_unit(const AttnP& a, LAS unsigned char* lds, const LAS float* biasT, int tid) {
    constexpr int KP = DQK * 2 + 16, KBYTES = 64 * KP, VBYTES = 64 * DV * 2, BUF = KBYTES + VBYTES;
    constexpr int KCH = DQK / 8, VCH = DV / 8, ND = DQK / 16, NDB = DV / 32;
    const int lane = tid & 63, wave = __builtin_amdgcn_readfirstlane(tid >> 6), r32 = lane & 31, hi = lane >> 5;
    bf16x8 qf[ND];
    { const bf16* qrow = a.q + (size_t)(wave * 32 + r32) * a.qpitch + hi * 8;
#pragma unroll
      for (int d0 = 0; d0 < ND; ++d0) qf[d0] = *(const bf16x8*)(qrow + d0 * 16); }
    if constexpr (DQK == 96) {
        if (a.rope_t0 >= 0) {
            const int t = a.rope_t0 + wave * 32 + r32; const float pos = hi ? (float)(t & 63) : (float)(t >> 6);
#pragma unroll
            for (int e = 0; e < 8; ++e) { const float ang = pos * exp2f(-(float)e * (LOG2_THETA / 8.f)); const float cs = __cosf(ang), sn = __sinf(ang);
                const float x1 = bf2f((unsigned short)qf[4][e]), x2 = bf2f((unsigned short)qf[5][e]);
                qf[4][e] = (short)f2bf(x1 * cs - x2 * sn); qf[5][e] = (short)f2bf(x2 * cs + x1 * sn); }
        }
    }
    constexpr int KS = KP / 16, NIK = KS, NIV = VCH, NI = NIK + NIV, MAXI = (NI + 7) / 8;
    const bf16* gsrc[MAXI]; unsigned gstep[MAXI];
#pragma unroll
    for (int j = 0; j < MAXI; ++j) {
        const int ii = wave + 8 * j; const int s = ii * 64 + lane;
        if (ii < NIK) { const int row = s / KS; int ch = s - row * KS; if (ch >= KCH) ch = 0;
            if (DQK == 96 && ch >= 8) { gsrc[j] = a.kb + (size_t)row * a.kbpitch + (ch - 8) * 8; gstep[j] = 64u * (unsigned)a.kbpitch; }
            else { gsrc[j] = a.ka + (size_t)row * a.kapitch + ch * 8; gstep[j] = 64u * (unsigned)a.kapitch; } }
        else { const int s2 = (s - 64 * KS) & (64 * VCH - 1); const int st = s2 >> 5, rowin = (s2 & 31) >> 2, chin = s2 & 3; const int row = (st / NDB) * 8 + rowin, ch = (st % NDB) * 4 + chin;
            gsrc[j] = a.v + (size_t)row * a.vpitch + ch * 8; gstep[j] = 64u * (unsigned)a.vpitch; }
    }
    const int mycnt = (NI - 1 - wave) / 8 + 1;
    const int ntile = a.nA + a.nB;
#define ATT_TILE(i_) ((i_) < a.nA ? (i_) : a.tB0 + ((i_) - a.nA))
#define ATT_ISSUE(tt_, slot_) do { _Pragma("unroll") for (int j_ = 0; j_ < MAXI; ++j_) if (wave + 8 * j_ < NI) \
        __builtin_amdgcn_global_load_lds((const unsigned*)(gsrc[j_] + (size_t)(tt_) * gstep[j_]), (LAS unsigned*)(lds + (slot_) * BUF + (wave + 8 * j_) * 1024), 16, 0, 0); } while (0)
#define ATT_WAITBAR(keep_) do { if (keep_) { if (mycnt == MAXI) asm volatile("s_waitcnt vmcnt(%0) lgkmcnt(0)\n\ts_barrier" :: "n"(MAXI) : "memory"); else asm volatile("s_waitcnt vmcnt(%0) lgkmcnt(0)\n\ts_barrier" :: "n"(MAXI - 1) : "memory"); } \
        else asm volatile("s_waitcnt vmcnt(0) lgkmcnt(0)\n\ts_barrier" ::: "memory"); } while (0)
    ATT_ISSUE(ATT_TILE(0), 0);
    if (ntile > 1) ATT_ISSUE(ATT_TILE(1), 1);
    ATT_WAITBAR(ntile > 1);
    constexpr float THR = 8.f;
    constexpr bool NEGM = (DV == 64) && !NA;
    float mrun = 0.f, lrun = 0.f;
    f32x16 negm = f32x16{};
    f32x16 o[NDB];
#pragma unroll
    for (int d = 0; d < NDB; ++d) o[d] = f32x16{};
    const int koff = r32 * KP + hi * 16;
    const int voff = KBYTES + (4 * hi + ((lane & 15) >> 2)) * 64 + ((lane >> 4) & 1) * 32 + (lane & 3) * 8;
    int na_rq = 0, na_r0 = 0, na_c = 0, na_ws = 0;
    if constexpr (NA) { na_rq = a.na_row0 + (wave >> 1); na_r0 = min(max(na_rq - 4, 0), 24); na_c = 32 * (wave & 1) + r32; na_ws = min(max(na_c - 8, 0), 48); }
    float mv[NA ? 20 : 1]; const LAS float* tb0 = nullptr; const int napar = wave & 1;
    if constexpr (NA) {
        tb0 = biasT + (64 + 15 - na_c + 4 * hi);
        if (napar == 0) {
#pragma unroll
            for (int r = 0; r < 16; ++r) { const int kc0 = crow(r, hi); mv[r] = (kc0 >= na_ws && kc0 < na_ws + 16) ? 0.f : -INFINITY; }
#pragma unroll
            for (int r = 0; r < 4; ++r) { const int kc1 = 32 + crow(r, hi); mv[16 + r] = (kc1 >= na_ws && kc1 < na_ws + 16) ? 0.f : -INFINITY; }
        } else {
#pragma unroll
            for (int r = 0; r < 16; ++r) { const int kc1 = 32 + crow(r, hi); mv[r] = (kc1 >= na_ws && kc1 < na_ws + 16) ? 0.f : -INFINITY; }
#pragma unroll
            for (int r = 0; r < 4; ++r) { const int kc0 = crow(12 + r, hi); mv[16 + r] = (kc0 >= na_ws && kc0 < na_ws + 16) ? 0.f : -INFINITY; }
        }
    }
    int slot0 = 0, slot2 = 2;
    for (int it = 0; it < ntile; ++it) {
        const int tt = ATT_TILE(it);
        if (it + 2 < ntile) { const int tn = ATT_TILE(it + 2); ATT_ISSUE(tn, slot2); }
        bool active = true; int rowoff = 0; bool local = false;
        if constexpr (NA) { if (tt >= 4) { const int kr = tt - 4; local = true; active = (kr >= na_r0) && (kr < na_r0 + 8); rowoff = (kr - na_rq + 7) * 32; } }
        if (active) {
            LAS unsigned char* kb_ = lds + slot0 * BUF;
            f32x16 p0, p1;
            if constexpr (NEGM) { p0 = negm; p1 = negm; } else { p0 = f32x16{}; p1 = f32x16{}; }
            {
                bf16x8 kf0[ND], kf1[ND];
#pragma unroll
                for (int d0 = 0; d0 < ND; ++d0) { kf0[d0] = *(const LAS bf16x8*)(kb_ + koff + d0 * 32); kf1[d0] = *(const LAS bf16x8*)(kb_ + koff + 32 * KP + d0 * 32); }
                __builtin_amdgcn_sched_barrier(0);
#pragma unroll
                for (int d0 = 0; d0 < ND; ++d0) {
                    p0 = __builtin_amdgcn_mfma_f32_32x32x16_bf16(kf0[d0], qf[d0], p0, 0, 0, 0);
                    p1 = __builtin_amdgcn_mfma_f32_32x32x16_bf16(kf1[d0], qf[d0], p1, 0, 0, 0);
                }
            }
            if constexpr (NA) {
                if (local) {
                    const LAS float* tb = tb0 + rowoff;
                    if (napar == 0) {
#pragma unroll
                        for (int r = 0; r < 16; ++r) p0[r] = (p0[r] + tb[(r & 3) + 8 * (r >> 2)]) + mv[r];
#pragma unroll
                        for (int r = 0; r < 4; ++r) p1[r] = (p1[r] + tb[32 + (r & 3)]) + mv[16 + r];
#pragma unroll
                        for (int r = 4; r < 16; ++r) p1[r] = -INFINITY;
                    } else {
#pragma unroll
                        for (int r = 0; r < 12; ++r) p0[r] = -INFINITY;
#pragma unroll
                        for (int r = 12; r < 16; ++r) p0[r] = (p0[r] + tb[(r & 3) + 24]) + mv[16 + r - 12];
#pragma unroll
                        for (int r = 0; r < 16; ++r) p1[r] = (p1[r] + tb[32 + (r & 3) + 8 * (r >> 2)]) + mv[r];
                    }
                }
            }
            float mxa = fmaxf(fmaxf(p0[0], p0[1]), p1[0]), mxb = fmaxf(fmaxf(p0[2], p0[3]), p1[1]);
            mxa = fmaxf(fmaxf(mxa, p1[2]), p1[3]);
#pragma unroll
            for (int r = 4; r < 16; r += 4) { mxa = fmaxf(fmaxf(mxa, p0[r]), p0[r + 1]); mxb = fmaxf(fmaxf(mxb, p0[r + 2]), p0[r + 3]); mxa = fmaxf(fmaxf(mxa, p1[r]), p1[r + 1]); mxb = fmaxf(fmaxf(mxb, p1[r + 2]), p1[r + 3]); }
            float mx = fmaxf(mxa, mxb);
            { const auto rr = __builtin_amdgcn_permlane32_swap(__float_as_uint(mx), __float_as_uint(mx), false, false); mx = fmaxf(__uint_as_float(rr[0]), __uint_as_float(rr[1])); }
            if constexpr (!NEGM) mx -= mrun;
            if (it == 0 || __any(mx > THR)) {
                const float dl = (it == 0) ? mx : fmaxf(mx, 0.f);
                mrun += dl;
                const float alpha = __builtin_amdgcn_exp2f(-dl);
                lrun *= alpha;
#pragma unroll
                for (int d = 0; d < NDB; ++d)
#pragma unroll
                    for (int r = 0; r < 16; ++r) o[d][r] *= alpha;
                if constexpr (NEGM) {
#pragma unroll
                    for (int r = 0; r < 16; ++r) { p0[r] -= dl; p1[r] -= dl; negm[r] = -mrun; }
                }
            }
            float rs0 = 0.f, rs1 = 0.f, rs2 = 0.f, rs3 = 0.f;
#pragma unroll
            for (int r = 0; r < 16; r += 2) {
                if constexpr (NEGM) { p0[r] = __builtin_amdgcn_exp2f(p0[r]); p0[r + 1] = __builtin_amdgcn_exp2f(p0[r + 1]); p1[r] = __builtin_amdgcn_exp2f(p1[r]); p1[r + 1] = __builtin_amdgcn_exp2f(p1[r + 1]); }
                else { p0[r] = __builtin_amdgcn_exp2f(p0[r] - mrun); p0[r + 1] = __builtin_amdgcn_exp2f(p0[r + 1] - mrun); p1[r] = __builtin_amdgcn_exp2f(p1[r] - mrun); p1[r + 1] = __builtin_amdgcn_exp2f(p1[r + 1] - mrun); }
                rs0 += p0[r]; rs1 += p0[r + 1]; rs2 += p1[r]; rs3 += p1[r + 1];
            }
            lrun += (rs0 + rs1) + (rs2 + rs3);
            bf16x8 pw[4];
#pragma unroll
            for (int ks = 0; ks < 4; ++ks) { u32x4 w;
                if (ks < 2) { const int b = 8 * (ks & 1); w.x = pk2(p0[b], p0[b + 1]); w.y = pk2(p0[b + 2], p0[b + 3]); w.z = pk2(p0[b + 4], p0[b + 5]); w.w = pk2(p0[b + 6], p0[b + 7]); }
                else { const int b = 8 * (ks & 1); w.x = pk2(p1[b], p1[b + 1]); w.y = pk2(p1[b + 2], p1[b + 3]); w.z = pk2(p1[b + 4], p1[b + 5]); w.w = pk2(p1[b + 6], p1[b + 7]); }
                pw[ks] = __builtin_bit_cast(bf16x8, w); }
            {
                const unsigned vaddr = (unsigned)(size_t)kb_ + (unsigned)voff;
                s16x4 vlo[2][NDB], vhi[2][NDB];
#define ATT_VRD(set_, ks_) do { _Pragma("unroll") for (int d_ = 0; d_ < NDB; ++d_) { \
                    asm volatile("ds_read_b64_tr_b16 %0, %1 offset:%2" : "=&v"(vlo[set_][d_]) : "v"(vaddr), "n"(((2 * (ks_)) * NDB + d_) * 512)); \
                    asm volatile("ds_read_b64_tr_b16 %0, %1 offset:%2" : "=&v"(vhi[set_][d_]) : "v"(vaddr), "n"(((2 * (ks_) + 1) * NDB + d_) * 512)); } } while (0)
                ATT_VRD(0, 0);
#pragma unroll
                for (int ks = 0; ks < 4; ++ks) {
                    const int cs = ks & 1;
                    if (ks < 3) { if (ks == 0) ATT_VRD(1, 1); else if (ks == 1) ATT_VRD(0, 2); else ATT_VRD(1, 3); }
                    if (ks < 3) { if constexpr (NDB == 2) asm volatile("s_waitcnt lgkmcnt(4)" : "+v"(vlo[cs][0]), "+v"(vhi[cs][0]), "+v"(vlo[cs][1]), "+v"(vhi[cs][1]));
                                  else asm volatile("s_waitcnt lgkmcnt(8)" : "+v"(vlo[cs][0]), "+v"(vhi[cs][0]), "+v"(vlo[cs][1]), "+v"(vhi[cs][1]), "+v"(vlo[cs][NDB - 2]), "+v"(vhi[cs][NDB - 2]), "+v"(vlo[cs][NDB - 1]), "+v"(vhi[cs][NDB - 1])); }
                    else { if constexpr (NDB == 2) asm volatile("s_waitcnt lgkmcnt(0)" : "+v"(vlo[cs][0]), "+v"(vhi[cs][0]), "+v"(vlo[cs][1]), "+v"(vhi[cs][1]));
                           else asm volatile("s_waitcnt lgkmcnt(0)" : "+v"(vlo[cs][0]), "+v"(vhi[cs][0]), "+v"(vlo[cs][1]), "+v"(vhi[cs][1]), "+v"(vlo[cs][NDB - 2]), "+v"(vhi[cs][NDB - 2]), "+v"(vlo[cs][NDB - 1]), "+v"(vhi[cs][NDB - 1])); }
#pragma unroll
                    for (int d = 0; d < NDB; ++d) {
                        const bf16x8 vf = {vlo[cs][d][0], vlo[cs][d][1], vlo[cs][d][2], vlo[cs][d][3], vhi[cs][d][0], vhi[cs][d][1], vhi[cs][d][2], vhi[cs][d][3]};
                        o[d] = __builtin_amdgcn_mfma_f32_32x32x16_bf16(vf, pw[ks], o[d], 0, 0, 0);
                    }
                }
#undef ATT_VRD
            }
        }
        ATT_WAITBAR(it + 2 < ntile);
        slot0 = (slot0 == 2) ? 0 : slot0 + 1; slot2 = (slot2 == 2) ? 0 : slot2 + 1;
    }
#undef ATT_TILE
#undef ATT_ISSUE
#undef ATT_WAITBAR
    lrun += __shfl_xor(lrun, 32);
    const float inv = 1.f / lrun;
    bf16* orow = a.o + (size_t)(wave * 32 + r32) * a.opitch + 4 * hi;
    if (a.mode == 2) {
        float ss = 0.f;
#pragma unroll
        for (int d = 0; d < NDB; ++d)
#pragma unroll
            for (int g = 0; g < 4; ++g) { const u32x2 w = *(const u32x2*)(orow + 32 * d + 8 * g);
                const float o1[4] = {bf2f(w.x & 0xffff), bf2f(w.x >> 16), bf2f(w.y & 0xffff), bf2f(w.y >> 16)};
#pragma unroll
                for (int e = 0; e < 4; ++e) { const float dl = o1[e] - a.lam * (o[d][4 * g + e] * inv); o[d][4 * g + e] = dl; ss += dl * dl; } }
        ss += __shfl_xor(ss, 32);
        const float rs = rsqrtf(ss * (1.f / (float)DV) + EPSN) * a.post;
#pragma unroll
        for (int d = 0; d < NDB; ++d)
#pragma unroll
            for (int g = 0; g < 4; ++g) { const f32x4 sl = *(const f32x4*)(a.subln + 32 * d + 8 * g + 4 * hi);
                u32x2 w; w.x = pk2(o[d][4 * g] * rs * sl[0], o[d][4 * g + 1] * rs * sl[1]); w.y = pk2(o[d][4 * g + 2] * rs * sl[2], o[d][4 * g + 3] * rs * sl[3]);
                *(u32x2*)(orow + 32 * d + 8 * g) = w; }
    } else {
#pragma unroll
        for (int d = 0; d < NDB; ++d)
#pragma unroll
            for (int g = 0; g < 4; ++g) { u32x2 w; w.x = pk2(o[d][4 * g] * inv, o[d][4 * g + 1] * inv); w.y = pk2(o[d][4 * g + 2] * inv, o[d][4 * g + 3] * inv);
                *(u32x2*)(orow + 32 * d + 8 * g) = w; }
    }
}

__device__ __forceinline__ void phase_attn_even(const Ctx& F, const Args& args, int L, bool want_ctx) {
    const bf16* P = (const bf16*)(F.ws + WS_P); const bf16* QM = (const bf16*)(F.ws + WS_QM); const bf16* KVM = (const bf16*)(F.ws + WS_KVM); bf16* O = (bf16*)(F.ws + WS_O);
    const int pr = L >> 1;
    const float lam_init = (L == 0) ? 0.2f : 0.47071302f;
    float lam;
    { const float* lp = args.in[15] + pr * 256; const float sa = wave_sum(lp[F.lane] * lp[64 + F.lane]), sb = wave_sum(lp[128 + F.lane] * lp[192 + F.lane]); lam = __expf(sa) - __expf(sb) + lam_init; }
    const float* subln = args.in[16] + pr * 128;
    const int n0 = 1024, n1 = 2048, n2 = want_ctx ? 128 : 0, n3 = want_ctx ? 256 : 0, ntot = n0 + n1 + n2 + n3;
    for (int u = F.vcu; u < ntot; u += F.G) {
        AttnP a; a.kb = nullptr; a.kbpitch = 0; a.tB0 = 0; a.nB = 0; a.rope_t0 = -1; a.mode = 0; a.lam = lam; a.post = 1.f - lam_init; a.subln = subln; a.na_row0 = 0;
        int cls, uu = u;
        if (uu < n0) cls = 0; else if ((uu -= n0) < n1) cls = 1; else if ((uu -= n1) < n2) cls = 2; else { uu -= n2; cls = 3; }
        if (cls == 0 || cls == 2) {
            int b, h, row0;
            if (cls == 0) { const int bh = uu >> 3, qb = uu & 7; b = bh >> 2; h = bh & 3; row0 = b * RPB + CTXL + 256 * qb; a.nA = 36; }
            else { b = uu >> 2; h = uu & 3; row0 = b * RPB; a.nA = 4; }
            const size_t base = (size_t)b * RPB;
            a.qpitch = PE; a.kapitch = PE; a.vpitch = PE; a.opitch = DM;
            a.v = P + base * PE + E_DV + h * 128; a.o = O + (size_t)row0 * DM + 512 + h * 128;
            for (int m = 0; m < 2; ++m) {
                a.q = P + (size_t)row0 * PE + E_DQ + h * 128 + m * 64; a.ka = P + base * PE + E_DK + h * 128 + m * 64; a.mode = 1 + m;
                attn_unit<64, 128, false>(a, F.lds, nullptr, F.tid);
            }
        } else {
            int b, h, row0;
            if (cls == 1) { const int bh = uu >> 3, qb = uu & 7; b = bh >> 3; h = bh & 7; row0 = b * RPB + CTXL + 256 * qb; a.nA = 36; a.rope_t0 = 256 * qb; }
            else { b = uu >> 3; h = uu & 7; row0 = b * RPB; a.nA = 4; }
            const size_t base = (size_t)b * RPB;
            a.q = QM + (size_t)row0 * 768 + h * 96; a.qpitch = 768; a.ka = KVM + base * 1024 + h * 128; a.kapitch = 1024; a.kb = P + base * PE + E_KR; a.kbpitch = PE;
            a.v = KVM + base * 1024 + h * 128 + 64; a.vpitch = 1024; a.o = O + (size_t)row0 * DM + h * 64; a.opitch = DM;
            attn_unit<96, 64, false>(a, F.lds, nullptr, F.tid);
        }
    }
}
__device__ __forceinline__ void phase_attn_odd(const Ctx& F, const Args& args, int L, bool want_ctx) {
    const bf16* P = (const bf16*)(F.ws + WS_P); bf16* O = (bf16*)(F.ws + WS_O);
    const int pr = L >> 1;
    const float* rpb = args.in[20] + (size_t)pr * 8 * 15 * 31;
    LAS float* biasT = (LAS float*)(F.lds + 98304);
    const int n0 = 1024, n1 = 2048, n2 = want_ctx ? 256 : 0, n3 = want_ctx ? 256 : 0, ntot = n0 + n1 + n2 + n3;
    for (int u = F.vcu; u < ntot; u += F.G) {
        if (u < n0) {
            const int qb = u & 7, bhp = u >> 3, pair = bhp & 1, hkv = (bhp >> 1) & 1, b = bhp >> 2; const int hA = 4 * hkv + 2 * pair;
            const int row0 = b * RPB + CTXL + 256 * qb; const size_t base = (size_t)b * RPB;
            AttnP2 a2; a2.qA = P + (size_t)row0 * PO + hA * 64; a2.qB = a2.qA + 64; a2.qpitch = PO; a2.ka = P + base * PO + O_GK + hkv * 64; a2.kapitch = PO; a2.v = P + base * PO + O_GV + hkv * 64; a2.vpitch = PO;
            a2.oA = O + (size_t)row0 * DM + hA * 64; a2.oB = a2.oA + 64; a2.opitch = DM; a2.ntile = 36;
            attn_unit_gqa2(a2, F.lds, F.tid);
            continue;
        }
        AttnP a; a.kb = nullptr; a.kbpitch = 0; a.tB0 = 0; a.nB = 0; a.rope_t0 = -1; a.mode = 0; a.lam = 0.f; a.post = 1.f; a.subln = nullptr; a.na_row0 = 0;
        a.qpitch = PO; a.kapitch = PO; a.vpitch = PO; a.opitch = DM;
        int cls, uu = u - n0;
        if (uu < n1) cls = 1; else if ((uu -= n1) < n2) cls = 2; else { uu -= n2; cls = 3; }
        int b, h, row0, qb = 0;
        if (cls < 2) { const int bh = uu >> 3; qb = uu & 7; b = bh >> 3; h = bh & 7; row0 = b * RPB + CTXL + 256 * qb; }
        else { b = uu >> 3; h = uu & 7; row0 = b * RPB; }
        const size_t base = (size_t)b * RPB;
        if (cls == 0 || cls == 2) {
            a.q = P + (size_t)row0 * PO + h * 64; a.ka = P + base * PO + O_GK + (h >> 2) * 64; a.v = P + base * PO + O_GV + (h >> 2) * 64; a.o = O + (size_t)row0 * DM + h * 64;
            a.nA = (cls == 0) ? 36 : 4;
            attn_unit<64, 64, false>(a, F.lds, nullptr, F.tid);
        } else {
            a.q = P + (size_t)row0 * PO + O_NQ + h * 64; a.ka = P + base * PO + O_NK + h * 64; a.v = P + base * PO + O_NV + h * 64; a.o = O + (size_t)row0 * DM + 512 + h * 64;
            a.nA = 4;
            if (cls == 1) {
                const int rlo = 4 * qb, rmin = min(max(rlo - 4, 0), 24), rmax = min(max(rlo + 3 - 4, 0), 24) + 7;
                a.tB0 = 4 + rmin; a.nB = rmax - rmin + 1; a.na_row0 = rlo;
                int tl_ = F.tid; asm volatile("" : "+v"(tl_));
                for (int e = tl_; e < 704; e += NTHR) { const int j = e - 64, rr = j >> 5, cc = j & 31; biasT[e] = (j >= 0 && j < 15 * 32 && cc < 31) ? rpb[(h * 15 + rr) * 31 + cc] * LOG2E : 0.f; }
                attn_unit<64, 64, true>(a, F.lds, biasT, tl_);
            } else {
                attn_unit<64, 64, false>(a, F.lds, nullptr, F.tid);
            }
        }
    }
}

constexpr int N_PHASES = 2 + 9 * DEPTH;
#ifndef REP_A0
#define REP_A0 1
#endif
#ifndef REP_SYNC
#define REP_SYNC 1
#endif
#ifndef REP_PRO
#define REP_PRO 1
#endif
#ifndef REP_ATTN
#define REP_ATTN 1
#endif
#ifndef REP_GEMM
#define REP_GEMM 1
#endif
#ifndef EN_PRO
#define EN_PRO 1
#endif
#ifndef EN_ROW
#define EN_ROW 1
#endif
#ifndef EN_PREP
#define EN_PREP 1
#endif
#ifndef EN_AE
#define EN_AE 1
#endif
#ifndef EN_AO
#define EN_AO 1
#endif
#ifndef EN_GEMM
#define EN_GEMM 1
#endif
__global__ void __launch_bounds__(NTHR, 2) fwd_kernel(Args args) {
    extern __shared__ __attribute__((aligned(16))) unsigned char lds_raw[];
    cg::grid_group grid = cg::this_grid();
    Ctx F;
    F.lds = (LAS unsigned char*)lds_raw;
    F.G = gridDim.x; { const int bx = blockIdx.x; F.vcu = (F.G % 8 == 0) ? (bx % 8) * (F.G / 8) + bx / 8 : bx; }
    F.out = args.out; F.ws = args.ws;
    const int lo = args.ph_lo, hi = args.ph_hi;
    volatile LAS unsigned* barst = (volatile LAS unsigned*)(F.lds + LDS_BARST);
    if (threadIdx.x == 0) { barst[0] = 0u; barst[1] = 0u; }
    __syncthreads();
    unsigned* barw = (unsigned*)(F.ws + WS_BAR);
    XcdBarrier xbar; xbar.bar = barw; xbar.x = 0; xbar.st = barst;
    int nsync = 0;
    for (int ph = lo; ph < hi; ++ph) {
        { int t_ = threadIdx.x; asm volatile("" : "+v"(t_)); F.tid = t_; F.lane = t_ & 63; F.wave = __builtin_amdgcn_readfirstlane(t_ >> 6); }
        float* MOD = (float*)(F.ws + WS_MOD); bf16* AF = (bf16*)(F.ws + WS_AF);
        const float* normg = args.in[6];
        const int L = (ph < 2) ? 0 : (ph - 2) / 9, k = (ph < 2) ? -1 : (ph - 2) % 9;
        const bool even = (L & 1) == 0, want_ctx = L < DEPTH - 1;
        unsigned char* wl = F.ws + WS_WT + (size_t)L * WL_STRIDE;
        if (ph == lo && hi - lo > 1 && blockIdx.x == 0) { for (int w_ = threadIdx.x; w_ < XCD_BAR_WORDS; w_ += NTHR) barw[w_] = 0u; }
        if (ph == 0) { for (int rep_ = 0; rep_ < REP_PRO; ++rep_) { if (EN_PRO) phase_prologue_a(F, args); __syncthreads(); } }
        else if (ph == 1 || k == 5 || k == 8) {
            const float* modL = MOD + (size_t)L * 33 * 6144;
            RowPassP p;
            bf16* HB = (bf16*)(F.ws + WS_HB); bf16* HCB = (bf16*)(F.ws + WS_HCB);
            p.Adst = AF; p.Fsrc = AF; p.hb_lat = HB; p.hb_ctx = HCB; p.out32 = F.out; p.final32 = 0; p.hin_lat = HB; p.hin_ctx = HCB;
            bool hin32 = false;
            if (ph == 1) { p.hin_lat = args.in[0]; p.hin_ctx = args.in[2]; hin32 = true; p.g_post = normg; p.g_pre = normg; p.mod_post = MOD; p.mod_pre = MOD;
                p.gate_chunk = 0; p.shift_chunk = 0; p.scale_chunk = 1; p.has_f = 0; p.write_h = 0; p.write_a = 1; p.skip_ctx = 0; }
            else if (k == 5) { if (L == 0) { p.hin_lat = args.in[0]; p.hin_ctx = args.in[2]; hin32 = true; } p.Fsrc = (const bf16*)(F.ws + WS_F1); p.g_post = normg + (L * 4 + 1) * DM; p.g_pre = normg + (L * 4 + 2) * DM;
                p.mod_post = modL; p.mod_pre = modL; p.gate_chunk = 2; p.shift_chunk = 3; p.scale_chunk = 4; p.has_f = 1; p.write_h = 1; p.write_a = 1; p.skip_ctx = want_ctx ? 0 : 1; }
            else { const int Ln = (L + 1 < DEPTH) ? L + 1 : L;
                p.g_post = normg + (L * 4 + 3) * DM; p.g_pre = normg + (Ln * 4 + 0) * DM; p.mod_post = modL; p.mod_pre = MOD + (size_t)Ln * 33 * 6144;
                p.gate_chunk = 5; p.shift_chunk = 0; p.scale_chunk = 1; p.has_f = 1; p.write_h = 1; p.write_a = want_ctx ? 1 : 0; p.skip_ctx = want_ctx ? 0 : 1; p.final32 = want_ctx ? 0 : 1; }
            if (EN_ROW) {
                if (ph == 1) { for (int rep_ = 0; rep_ < REP_A0; ++rep_) { phase_rowpass<true, false, false, true, false>(F, p); __syncthreads(); } }
                else if (hin32) phase_rowpass<true, true, true, true, false>(F, p);
                else if (p.final32) phase_rowpass<false, true, false, false, true>(F, p);
                else phase_rowpass<false, true, true, true, false>(F, p);
            }
        }
        else if (k == 1) { if (EN_PREP) { if (even) phase_prep_even(F); else phase_prep_odd(F, args.in[19] + (L >> 1) * 128); } }
        else if (k == 3) { for (int rep_ = 0; rep_ < REP_ATTN; ++rep_) { if (even) { if (EN_AE) phase_attn_even(F, args, L, want_ctx); } else { if (EN_AO) phase_attn_odd(F, args, L, want_ctx); } } }
        else {
            const int ng = (k == 2) ? (even ? 2 : 0) : 1;
            for (int gi_ = 0; gi_ < ng * REP_GEMM; ++gi_) { const int gi = gi_ % ng;
                pg8::Gemm g; pg8::EpiStore E; E.act = 0;
                g.M = MROWS;
                if (k == 0) { g.A = AF; g.Bt = (const bf16*)(wl + WL_IN); g.N = even ? PE : PO; g.K = DM; g.lda = DM; E.O = (bf16*)(F.ws + WS_P); E.ldc = g.N; }
                else if (k == 2) {
                    if (gi == 0) { g.A = AF; g.Bt = (const bf16*)(wl + WL_UQ); g.N = 768; g.K = 256; g.lda = 256; E.O = (bf16*)(F.ws + WS_QM); E.ldc = 768; }
                    else { g.A = (const bf16*)(F.ws + WS_AF + 36 * MiB); g.Bt = (const bf16*)(wl + WL_UKV); g.N = 1024; g.K = 128; g.lda = 128; E.O = (bf16*)(F.ws + WS_KVM); E.ldc = 1024; } }
                else if (k == 4) { g.A = (const bf16*)(F.ws + WS_O); g.Bt = (const bf16*)(wl + WL_OUT); g.N = DM; g.K = DM; g.lda = DM; E.O = (bf16*)(F.ws + WS_F1); E.ldc = DM; }
                else if (k == 6) { g.A = AF; g.Bt = (const bf16*)(wl + WL_FF1); g.N = DFF; g.K = DM; g.lda = DM; E.O = (bf16*)(F.ws + WS_H); E.ldc = DFF; E.act = 1; }
                else { g.A = (const bf16*)(F.ws + WS_H); g.Bt = (const bf16*)(wl + WL_FF2); g.N = DM; g.K = DFF; g.lda = DFF; E.O = AF; E.ldc = DM; }
                const int skipc = (L == DEPTH - 1 && k >= 4) ? 1 : 0;
                pg8::StaticOrder S; S.init(MROWS, g.N, F.G, (int)blockIdx.x, skipc);
                if (EN_GEMM) pg8::gemm_phase<pg8::EpiStore, pg8::StaticOrder, true, true>(F.lds, g, S, E);
            }
        }
        if (ph + 1 < hi) {
            for (int s_ = 0; s_ < REP_SYNC; ++s_) {
                if (nsync == 0) { grid.sync(); xbar = xcd_barrier_post(barw, barst); }
                else xcd_barrier(xbar);
                ++nsync;
            }
        }
    }
}

#ifndef SINGLE_LAUNCH
#define SINGLE_LAUNCH 1
#endif
extern "C" void kernel_launch(void* const* d_in, const int* in_sizes, int n_in, void* d_out, int out_size, void* d_ws, size_t ws_size, hipStream_t stream) {
    static int grid = 0;
    if (grid == 0) {
        if (n_in != 21 || out_size != NB * SEQ * DM || ws_size < WS_END) { fprintf(stderr, "kernel_launch: unexpected problem (n_in %d, out %d, ws %zu)\n", n_in, out_size, ws_size); grid = -1; return; }
        int dev = 0, cus = 0, per_cu = 0;
        hipGetDevice(&dev); hipDeviceGetAttribute(&cus, hipDeviceAttributeMultiprocessorCount, dev);
        hipFuncSetAttribute((const void*)fwd_kernel, hipFuncAttributeMaxDynamicSharedMemorySize, LDS_BYTES);
        hipOccupancyMaxActiveBlocksPerMultiprocessor(&per_cu, (const void*)fwd_kernel, NTHR, LDS_BYTES);
        if (per_cu < 1) per_cu = 1;
        grid = cus;
        (void)hipGetLastError();
    }
    if (grid < 0) return;
    Args a{};
    for (int i = 0; i < 21; ++i) a.in[i] = (const float*)d_in[i];
    a.out = (float*)d_out; a.ws = (unsigned char*)d_ws;
#if SINGLE_LAUNCH
    a.ph_lo = 0; a.ph_hi = N_PHASES;
    void* kargs[] = {&a};
    hipError_t e = hipLaunchCooperativeKernel((const void*)fwd_kernel, dim3(grid), dim3(NTHR), kargs, LDS_BYTES, stream);
    if (e != hipSuccess) fprintf(stderr, "cooperative launch failed: %s (grid %d)\n", hipGetErrorString(e), grid);
#else
    for (int ph = 0; ph < N_PHASES; ++ph) {
        if (ph >= 2) { const int L = (ph - 2) / 9, k = (ph - 2) % 9; if (k == 2 && (L & 1)) continue; }
        a.ph_lo = ph; a.ph_hi = ph + 1;
        hipLaunchKernelGGL(fwd_kernel, dim3(grid), dim3(NTHR), LDS_BYTES, stream, a);
    }
#endif
}
```

```cpp
#include <hip/hip_runtime.h>
#include <hip/hip_cooperative_groups.h>
#include <cstdio>
#include <cstdint>
namespace cg = cooperative_groups;
namespace pg8 {
#define PG8_LAS __attribute__((address_space(3)))
typedef unsigned short bf16_t;
typedef short bf16x8 __attribute__((ext_vector_type(8)));
typedef float f32x4 __attribute__((ext_vector_type(4)));
typedef unsigned u32x4 __attribute__((ext_vector_type(4)));
constexpr int BM = 256, BK = 64, HALF = 128, HTB = HALF * BK * 2  , STAGE_BYTES = 8 * HTB, NXCD = 8, WGM = 8;

__host__ __device__ __forceinline__ int lds_byte(int r, int c) { const int st = (r >> 4) * 2 + (c >> 5), rr = r & 15, cc = c & 31, ob = rr * 64 + cc * 2; return st * 1024 + (ob ^ (((ob >> 9) & 1) << 5)); }
__host__ __device__ __forceinline__ void stage_rc(int b, int& R, int& C) { const int st = b / 1024, sb = b % 1024, swz = sb ^ (((sb >> 9) & 1) << 5); R = (st >> 1) * 16 + swz / 64; C = (st & 1) * 32 + (swz % 64) / 2; }
__host__ __device__ __forceinline__ int perm32(int rho) { const int n = rho >> 4, i = rho & 15; return 8 * (i >> 2) + 4 * n + (i & 3); }

struct Unit { int pm, pn; };
struct Gemm { const bf16_t* A; const bf16_t* Bt; int M, N, K, lda; };

struct StaticOrder {
    int rev;
    int nM, nN, nwg, G, c, skipc;
    __host__ __device__ void init(int M, int N, int G_, int c_, int skipc_ = 0) { nM = M / BM; if (skipc_) nM = nM / 9 * 8; nN = N / BM; nwg = nM * nN; G = G_; c = c_; skipc = skipc_; rev = 0; }
    __host__ __device__ bool next(int i, Unit& u) const {
        const long L = (long)i * G + c; if (L >= nwg) return false;
        int wgid = (int)L; { const int q = nwg / NXCD, r = nwg % NXCD, xcd = wgid % NXCD, off = wgid / NXCD; wgid = (xcd < r ? xcd * (q + 1) : r * (q + 1) + (xcd - r) * q) + off; }
        const int nig = WGM * nN, gid = wgid / nig, fm = gid * WGM, gsz = (nM - fm) < WGM ? (nM - fm) : WGM;
        u.pm = fm + ((wgid % nig) % gsz); u.pn = (wgid % nig) / gsz; if (rev) u.pm = nM - 1 - u.pm; if (skipc) u.pm = u.pm + u.pm / 8 + 1; return true;
    }
    __device__ __forceinline__ void a_ready(const Unit&) const {}
    __device__ __forceinline__ void done(const Unit&) const {}
};

__device__ __forceinline__ unsigned cvt_pk_bf16(float lo, float hi) { unsigned r; asm volatile("v_cvt_pk_bf16_f32 %0, %1, %2" : "=v"(r) : "v"(lo), "v"(hi)); return r; }
template <class Epi, class Sched, bool ALIGN_EPI = false, bool SP2 = false>
__device__ __forceinline__ void gemm_phase(PG8_LAS unsigned char* lds, const Gemm g, const Sched& S, const Epi& E) {
    int tid_ = threadIdx.x; asm volatile("" : "+v"(tid_));
    const int tid = tid_, wid = __builtin_amdgcn_readfirstlane(tid >> 6), lane = tid & 63, wr = wid >> 2, wc = wid & 3, fr = lane & 15, fq = lane >> 4;
    const int K = g.K, nt = K / BK;
    unsigned voffA[2], voffB[2];
#pragma unroll
    for (int i = 0; i < 2; ++i) { int R, C; stage_rc(tid * 16 + i * 8192, R, C); const int Rb = Epi::PERM ? ((R & ~31) + perm32(R & 31)) : R;
        voffA[i] = (unsigned)(R * g.lda + C) * 2u; voffB[i] = (unsigned)(Rb * K + C) * 2u; }
    const size_t kstep = (size_t)(BK * 2);
    const size_t hstep = (size_t)HALF * K * 2, hstepA = (size_t)HALF * g.lda * 2;
    const size_t tstep = 2 * hstep, tstepA = 2 * hstepA;
    const unsigned ldsw = (unsigned)wid * 1024u;
    const int aoff = lds_byte(wr * 64 + fr, fq * 8), boff = lds_byte(wc * 32 + fr, fq * 8);
#define PG8_SA(b, h) (((b) * 2 + (h)) * HTB)
#define PG8_SB(b, h) ((4 + (b) * 2 + (h)) * HTB)
#define PG8_STAGE(bufoff, gbase, voff) do { _Pragma("unroll") for (int _i = 0; _i < 2; ++_i) \
        __builtin_amdgcn_global_load_lds((const unsigned*)((const char*)(gbase) + (voff)[_i]), (PG8_LAS unsigned*)(lds + (bufoff) + ldsw + _i * 8192), 16, 0, 0); } while (0)
#define PG8_LDA(dst, b, h) do { _Pragma("unroll") for (int m = 0; m < 4; ++m) _Pragma("unroll") for (int k = 0; k < 2; ++k) dst[m][k] = *(const PG8_LAS bf16x8*)(lds + PG8_SA(b, h) + aoff + m * 2048 + k * 1024); } while (0)
#define PG8_LDB(dst, b, h) do { _Pragma("unroll") for (int n = 0; n < 2; ++n) _Pragma("unroll") for (int k = 0; k < 2; ++k) dst[n][k] = *(const PG8_LAS bf16x8*)(lds + PG8_SB(b, h) + boff + n * 2048 + k * 1024); } while (0)
#define PG8_MMA(ai, bj, At, Bt) do { __builtin_amdgcn_s_setprio(1); _Pragma("unroll") for (int m = 0; m < 4; ++m) _Pragma("unroll") for (int n = 0; n < 2; ++n) _Pragma("unroll") for (int k = 0; k < 2; ++k) \
        acc[ai][bj][m][n] = __builtin_amdgcn_mfma_f32_16x16x32_bf16(Bt[n][k], At[m][k], acc[ai][bj][m][n], 0, 0, 0); __builtin_amdgcn_s_setprio(0); } while (0)
#define PG8_WAIT_V(n) asm volatile("s_waitcnt vmcnt(" #n ")" ::: "memory")
#define PG8_WAIT_L(n) asm volatile("s_waitcnt lgkmcnt(" #n ")" ::: "memory")
#define PG8_BAR __builtin_amdgcn_s_barrier()
#define PG8_SCHED __builtin_amdgcn_sched_barrier(0)
    Unit cur, nxt; int ui = 0;
    if (!S.next(0, cur)) return;
    f32x4 acc[2][2][4][2];
#pragma unroll
    for (int a = 0; a < 2; ++a)
#pragma unroll
        for (int b = 0; b < 2; ++b)
#pragma unroll
            for (int m = 0; m < 4; ++m)
#pragma unroll
                for (int n = 0; n < 2; ++n) acc[a][b][m][n] = (f32x4){0.f, 0.f, 0.f, 0.f};
    bf16x8 At[4][2], B0[2][2], B1[2][2];
    const char* cA = (const char*)g.A + (size_t)cur.pm * tstepA; const char* cB = (const char*)g.Bt + (size_t)cur.pn * tstep;
    S.a_ready(cur);
    if constexpr (SP2) {
        PG8_STAGE(PG8_SB(0, 0), cB, voffB); PG8_STAGE(PG8_SB(0, 1), cB + hstep, voffB); PG8_STAGE(PG8_SA(0, 0), cA, voffA); PG8_STAGE(PG8_SA(0, 1), cA + hstepA, voffA);
        if (wr == 1) PG8_BAR;
        PG8_WAIT_V(2); PG8_BAR;
        PG8_STAGE(PG8_SB(1, 0), cB + kstep, voffB); PG8_STAGE(PG8_SA(1, 0), cA + kstep, voffA); PG8_STAGE(PG8_SB(1, 1), cB + hstep + kstep, voffB);
        PG8_WAIT_V(6); PG8_BAR;
    } else {
        PG8_STAGE(PG8_SB(0, 0), cB, voffB); PG8_STAGE(PG8_SA(0, 0), cA, voffA); PG8_STAGE(PG8_SB(0, 1), cB + hstep, voffB); PG8_STAGE(PG8_SA(0, 1), cA + hstepA, voffA);
        if (wr == 1) PG8_BAR;
        PG8_WAIT_V(4); PG8_BAR;
        PG8_STAGE(PG8_SB(1, 0), cB + kstep, voffB); PG8_STAGE(PG8_SA(1, 0), cA + kstep, voffA); PG8_STAGE(PG8_SB(1, 1), cB + hstep + kstep, voffB);
        PG8_WAIT_V(6); PG8_BAR;
    }
    for (;;) {
        const bool has_next = S.next(ui + 1, nxt);
        const char* nA = has_next ? (const char*)g.A + (size_t)nxt.pm * tstepA : cA; const char* nB = has_next ? (const char*)g.Bt + (size_t)nxt.pn * tstep : cB;
        for (int t = 0; t < nt; t += 2) {
            const bool last = (t == nt - 2);
            const char* a1 = cA + (size_t)(t + 1) * kstep;
            const char* a2 = last ? nA : cA + (size_t)(t + 2) * kstep; const char* b2 = last ? nB : cB + (size_t)(t + 2) * kstep;
            const char* a3 = a2 + kstep; const char* b3 = b2 + kstep;
            if (last && has_next) S.a_ready(nxt);
            if constexpr (SP2) {
            PG8_LDB(B0, 0, 0); PG8_LDB(B1, 0, 1); PG8_SCHED; PG8_LDA(At, 0, 0); PG8_STAGE(PG8_SA(1, 1), a1 + hstepA, voffA);
            PG8_WAIT_V(8); PG8_WAIT_L(0); PG8_BAR; PG8_MMA(0, 0, At, B0); PG8_MMA(0, 1, At, B1); PG8_BAR; PG8_SCHED;
            PG8_LDA(At, 0, 1); PG8_STAGE(PG8_SB(0, 0), b2, voffB); PG8_STAGE(PG8_SB(0, 1), b2 + hstep, voffB); PG8_STAGE(PG8_SA(0, 0), a2, voffA);
            PG8_WAIT_V(8); PG8_WAIT_L(0); PG8_BAR; PG8_MMA(1, 0, At, B0); PG8_MMA(1, 1, At, B1); PG8_BAR; PG8_SCHED;
            PG8_LDB(B0, 1, 0); PG8_LDB(B1, 1, 1); PG8_SCHED; PG8_LDA(At, 1, 0); PG8_STAGE(PG8_SA(0, 1), a2 + hstepA, voffA);
            PG8_WAIT_V(8); PG8_WAIT_L(0); PG8_BAR; PG8_MMA(0, 0, At, B0); PG8_MMA(0, 1, At, B1); PG8_BAR; PG8_SCHED;
            PG8_LDA(At, 1, 1); PG8_STAGE(PG8_SB(1, 0), b3, voffB); PG8_STAGE(PG8_SB(1, 1), b3 + hstep, voffB); PG8_STAGE(PG8_SA(1, 0), a3, voffA);
            PG8_WAIT_V(8); PG8_WAIT_L(0); PG8_BAR; PG8_MMA(1, 0, At, B0); PG8_MMA(1, 1, At, B1); PG8_BAR; PG8_SCHED;
            } else {
            PG8_LDB(B0, 0, 0); PG8_SCHED; PG8_LDA(At, 0, 0); PG8_STAGE(PG8_SA(1, 1), a1 + hstepA, voffA);
            PG8_WAIT_L(8); PG8_BAR; PG8_WAIT_L(0); PG8_MMA(0, 0, At, B0); PG8_BAR; PG8_SCHED;
            PG8_LDB(B1, 0, 1); PG8_STAGE(PG8_SB(0, 0), b2, voffB);
            PG8_BAR; PG8_WAIT_L(0); PG8_MMA(0, 1, At, B1); PG8_BAR;
            PG8_LDA(At, 0, 1); PG8_STAGE(PG8_SA(0, 0), a2, voffA);
            PG8_BAR; PG8_WAIT_L(0); PG8_MMA(1, 0, At, B0); PG8_BAR; PG8_SCHED;
            PG8_STAGE(PG8_SB(0, 1), b2 + hstep, voffB);
            PG8_WAIT_V(6); PG8_BAR; PG8_MMA(1, 1, At, B1); PG8_BAR;
            PG8_LDB(B0, 1, 0); PG8_SCHED; PG8_LDA(At, 1, 0); PG8_STAGE(PG8_SA(0, 1), a2 + hstepA, voffA);
            PG8_WAIT_L(8); PG8_BAR; PG8_WAIT_L(0); PG8_MMA(0, 0, At, B0); PG8_BAR; PG8_SCHED;
            PG8_LDB(B1, 1, 1); PG8_STAGE(PG8_SB(1, 0), b3, voffB);
            PG8_BAR; PG8_WAIT_L(0); PG8_MMA(0, 1, At, B1); PG8_BAR;
            PG8_LDA(At, 1, 1); PG8_STAGE(PG8_SA(1, 0), a3, voffA);
            PG8_BAR; PG8_WAIT_L(0); PG8_MMA(1, 0, At, B0); PG8_BAR; PG8_SCHED;
            PG8_STAGE(PG8_SB(1, 1), b3 + hstep, voffB);
            PG8_WAIT_V(6); PG8_BAR; PG8_MMA(1, 1, At, B1); PG8_BAR;
            }
        }
        if constexpr (ALIGN_EPI) { if (wr == 0) PG8_BAR; }
        if constexpr (!Epi::AFTER_DRAIN) { E(acc, cur, wr, wc, fr, fq); S.done(cur); }
        if (!has_next) break;
#pragma unroll
        for (int a = 0; a < 2; ++a)
#pragma unroll
            for (int b = 0; b < 2; ++b)
#pragma unroll
                for (int m = 0; m < 4; ++m)
#pragma unroll
                    for (int n = 0; n < 2; ++n) acc[a][b][m][n] = (f32x4){0.f, 0.f, 0.f, 0.f};
        cur = nxt; cA = nA; cB = nB; ++ui;
        if constexpr (ALIGN_EPI) { if (wr == 1) PG8_BAR; }
    }
    PG8_WAIT_V(0);
    if constexpr (!ALIGN_EPI) { if (wr == 0) PG8_BAR; }
    PG8_BAR;
    if constexpr (Epi::AFTER_DRAIN) { E.fused(acc, cur, wr, wc, fr, fq, lds, wid, lane); S.done(cur); }
#undef PG8_SA
#undef PG8_SB
#undef PG8_STAGE
#undef PG8_LDA
#undef PG8_LDB
#undef PG8_MMA
#undef PG8_WAIT_V
#undef PG8_WAIT_L
#undef PG8_BAR
#undef PG8_SCHED
}
}
namespace pg8 {
struct EpiStore {
    static constexpr bool PERM = true, AFTER_DRAIN = false;
    bf16_t* O; int ldc; int act;
    __device__ __forceinline__ void operator()(const f32x4 (&acc)[2][2][4][2], const Unit& u, int wr, int wc, int fr, int fq) const {
        const int row0 = u.pm * BM + wr * 64 + fr; const int col0 = u.pn * BM + wc * 32 + 8 * fq;
#pragma unroll
        for (int ai = 0; ai < 2; ++ai)
#pragma unroll
            for (int m = 0; m < 4; ++m) { bf16_t* rowp = O + (size_t)(row0 + ai * HALF + m * 16) * ldc + col0;
#pragma unroll
                for (int bj = 0; bj < 2; ++bj) { f32x4 v0 = acc[ai][bj][m][0], v1 = acc[ai][bj][m][1];
                    if (act == 1) {
#pragma unroll
                        for (int e = 0; e < 4; ++e) { float a = fmaxf(v0[e], 0.f), b = fmaxf(v1[e], 0.f); v0[e] = a * a; v1[e] = b * b; } }
                    u32x4 w; w.x = cvt_pk_bf16(v0[0], v0[1]); w.y = cvt_pk_bf16(v0[2], v0[3]); w.z = cvt_pk_bf16(v1[0], v1[1]); w.w = cvt_pk_bf16(v1[2], v1[3]);
                    *(u32x4*)(rowp + bj * HALF) = w; } }
    }
};
}
#define LAS __attribute__((address_space(3)))
#define GAS __attribute__((address_space(1)))
typedef unsigned v4u __attribute__((ext_vector_type(4)));
typedef GAS unsigned gu32;
typedef GAS unsigned long long gu64;
#define RLX_AGENT __ATOMIC_RELAXED, __HIP_MEMORY_SCOPE_AGENT
#define LDS_WAIT() asm volatile("s_waitcnt lgkmcnt(0)" ::: "memory")
#define VM_WAIT() asm volatile("s_waitcnt vmcnt(0)" ::: "memory")
__device__ __forceinline__ unsigned long long rt() { return __builtin_amdgcn_s_memrealtime(); }
#define XB_TMO      128
#define XB_XCNT(j)  (256  + 64 * (j))
#define XB_XSUB(j)  (1280 + 64 * (j))
#define XB_XGEN(j)  (2304 + 64 * (j))
#define XB_TOP      3328
#define XB_TOPGEN   3392
#define XCD_BAR_WORDS 3456
#define XB_SPIN_CAP (1u << 22)

__device__ __forceinline__ unsigned xb_ld(unsigned* p)              { return __hip_atomic_load(p, __ATOMIC_RELAXED, __HIP_MEMORY_SCOPE_AGENT); }
__device__ __forceinline__ unsigned xb_add(unsigned* p, unsigned v) { return __hip_atomic_fetch_add(p, v, __ATOMIC_RELAXED, __HIP_MEMORY_SCOPE_AGENT); }
__device__ __forceinline__ unsigned xb_xcc_id() { return (unsigned)__builtin_amdgcn_s_getreg((3 << 11) | 20) & 0xFu; }
#define XB_SPIN(cond, bar) do { unsigned _sp = 0; while (cond) { __builtin_amdgcn_s_sleep(1); \
    if ((++_sp & 255u) == 0u) { if (xb_ld(&(bar)[XB_TMO])) break; if (_sp > XB_SPIN_CAP) { atomicAdd(&(bar)[XB_TMO], 1u); break; } } } } while (0)

struct XcdBarrier {
    unsigned* bar; unsigned x;
    volatile LAS unsigned* st;
};

__device__ __forceinline__ XcdBarrier xcd_barrier_post(unsigned* bar, volatile LAS unsigned* st) {
    XcdBarrier b; b.bar = bar; b.x = xb_xcc_id(); b.st = st;
    if (threadIdx.x == 0) (void)xb_add(&bar[XB_XCNT(b.x)], 1u);
    return b;
}
__device__ __forceinline__ void xcd_barrier_complete(unsigned* bar, unsigned x, unsigned& nloc, unsigned& nx) {
    const unsigned G = gridDim.x * gridDim.y * gridDim.z;
    unsigned sum, cnt, mine, sp = 0u;
    for (;;) {
        sum = 0u; cnt = 0u; mine = 0u;
#pragma unroll
        for (unsigned j = 0; j < 16; ++j) { const unsigned c = xb_ld(&bar[XB_XCNT(j)]); sum += c; cnt += (c > 0u) ? 1u : 0u; mine = (j == x) ? c : mine; }
        if (sum == G) break;
        __builtin_amdgcn_s_sleep(1);
        if ((++sp & 255u) == 0u) { if (xb_ld(&bar[XB_TMO])) break; if (sp > XB_SPIN_CAP) { atomicAdd(&bar[XB_TMO], 1u); break; } }
    }
    nloc = mine > 0u ? mine : 1u; nx = cnt > 0u ? cnt : 1u;
}

__device__ __forceinline__ void xcd_barrier(const XcdBarrier& b) {
    asm volatile("s_waitcnt vmcnt(0)" ::: "memory");
    __syncthreads();
    if (threadIdx.x == 0) {
        unsigned* bar = b.bar;
        __builtin_amdgcn_s_waitcnt(0);
        unsigned nloc = b.st[0], nx = b.st[1];
        if (nloc == 0u) { xcd_barrier_complete(bar, b.x, nloc, nx); b.st[0] = nloc; b.st[1] = nx; }
        const unsigned old = xb_add(&bar[XB_XSUB(b.x)], 1u);
        const unsigned gen = old / nloc;
        if (old + 1u == (gen + 1u) * nloc) {
            __builtin_amdgcn_fence(__ATOMIC_RELEASE, "agent");
            asm volatile("s_waitcnt vmcnt(0)" ::: "memory");
            const unsigned og = xb_add(&bar[XB_TOP], 1u);
            const unsigned tg = og / nx;
            if (og + 1u == (tg + 1u) * nx) xb_add(&bar[XB_TOPGEN], 1u);
            else XB_SPIN(xb_ld(&bar[XB_TOPGEN]) == tg, bar);
            __builtin_amdgcn_fence(__ATOMIC_ACQUIRE, "agent");
            xb_add(&bar[XB_XGEN(b.x)], 1u);
            asm volatile("s_waitcnt vmcnt(0)" ::: "memory");
        } else {
            XB_SPIN(xb_ld(&bar[XB_XGEN(b.x)]) == gen, bar);
            __builtin_amdgcn_fence(__ATOMIC_ACQUIRE, "agent");
            asm volatile("s_waitcnt vmcnt(0)" ::: "memory");
        }
    }
    __syncthreads();
}

typedef unsigned short bf16;
typedef short bf16x8 __attribute__((ext_vector_type(8)));
typedef short s16x4 __attribute__((ext_vector_type(4)));
typedef float f32x4 __attribute__((ext_vector_type(4)));
typedef float f32x16 __attribute__((ext_vector_type(16)));
typedef unsigned u32x4 __attribute__((ext_vector_type(4)));
typedef unsigned u32x2 __attribute__((ext_vector_type(2)));

constexpr int DM = 1024, NB = 32, SEQ = 2048, CTXL = 256, RPB = SEQ + CTXL, MROWS = NB * RPB;
constexpr int DFF = 4096, DEPTH = 4, NWAVES = 8, NTHR = 512;
constexpr int PE = 2048, PO = 2304;
constexpr int E_CKV = 256, E_KR = 384, E_DQ = 416, E_DK = 928, E_DV = 1440;
constexpr int O_GK = 512, O_GV = 640, O_NQ = 768, O_NK = 1280, O_NV = 1792;
constexpr float EPSN = 1e-6f, LOG2E = 1.4426950408889634f, LOG2_THETA = 13.287712379549449f;
constexpr float MLA_SC = 0.10206207261596575f  , HD_SC = 0.125f;

constexpr size_t MiB = 1u << 20;
constexpr size_t WS_MOD = 0;
constexpr size_t WS_HB = 852 * MiB;
constexpr size_t WS_HCB = 980 * MiB;
constexpr size_t WS_WT = 36 * MiB;
constexpr size_t WS_AF = 132 * MiB;
constexpr size_t WS_P = 276 * MiB;
constexpr size_t WS_QM = 600 * MiB;
constexpr size_t WS_KVM = 708 * MiB;
constexpr size_t WS_O = WS_AF;
constexpr size_t WS_F1 = WS_P;
constexpr size_t WS_END = 996 * MiB;
constexpr size_t WS_H = WS_P;
constexpr size_t WL_STRIDE = 24 * MiB, WL_IN = 0, WL_OUT = 5 * MiB, WL_FF1 = 7 * MiB, WL_FF2 = 15 * MiB, WL_UQ = 23 * MiB, WL_UKV = 23 * MiB + 512 * 1024;
static_assert(WS_H + (size_t)MROWS * DFF * 2 <= WS_HB, "H overlay");
constexpr int LDS_BYTES = 147456, LDS_BARST = 147200;
constexpr size_t WS_BAR = 3 * MiB + 512 * 1024;

struct Args { const float* in[21]; float* out; unsigned char* ws; int ph_lo, ph_hi; };

__device__ __forceinline__ float bf2f(unsigned short b) { return __uint_as_float((unsigned)b << 16); }
typedef float f32x2_t __attribute__((ext_vector_type(2))); typedef __bf16 bf16x2_t __attribute__((ext_vector_type(2)));
__device__ __forceinline__ unsigned pk2(float lo, float hi) { f32x2_t v = {lo, hi}; bf16x2_t b = __builtin_convertvector(v, bf16x2_t); return __builtin_bit_cast(unsigned, b); }
__device__ __forceinline__ unsigned short f2bf(float f) { return (unsigned short)(pk2(f, 0.f) & 0xffffu); }
__device__ __forceinline__ float dpp_add(float v, int ctrl_qp1, int) { return v; }
template <int CTRL> __device__ __forceinline__ float dpp_mov(float v) { return __int_as_float(__builtin_amdgcn_update_dpp(0, __float_as_int(v), CTRL, 0xF, 0xF, true)); }
__device__ __forceinline__ float sum8(float v) {
    v += dpp_mov<0xB1>(v);
    v += dpp_mov<0x4E>(v);
    v += dpp_mov<0x141>(v);
    return v;
}
__device__ __forceinline__ float sum16(float v) { v = sum8(v); v += dpp_mov<0x140>(v); return v; }
__device__ __forceinline__ float wave_sum(float v) { v = sum16(v); v += __shfl_xor(v, 16); v += __shfl_xor(v, 32); return v; }
__device__ __forceinline__ float half_sum(float v) {
#pragma unroll
    for (int o = 1; o < 32; o <<= 1) v += __shfl_xor(v, o);
    return v;
}

__device__ __forceinline__ void transpose_item(const float* W, int K, int N, bf16* WT, LAS float* scr, int item, int lane, const float* kscale, float sc) {
    const int nblk = N / 32, kb = item / nblk, nb = item % nblk, k0 = 64 * kb, n0 = 32 * nb;
#pragma unroll
    for (int i = 0; i < 8; ++i) { const int kk = 8 * i + (lane >> 3); const f32x4 w = *(const f32x4*)(W + (size_t)(k0 + kk) * N + n0 + 4 * (lane & 7));
        const float s_ = kscale ? kscale[k0 + kk] * sc : sc;
#pragma unroll
        for (int j = 0; j < 4; ++j) scr[kk * 33 + 4 * (lane & 7) + j] = w[j] * s_; }
    asm volatile("s_waitcnt lgkmcnt(0)" ::: "memory");
    const int c = lane & 7;
#pragma unroll
    for (int j = 0; j < 4; ++j) { const int n = (lane >> 3) + 8 * j; const LAS float* s = scr + (8 * c) * 33 + n;
        u32x4 o; o.x = pk2(s[0 * 33], s[1 * 33]); o.y = pk2(s[2 * 33], s[3 * 33]); o.z = pk2(s[4 * 33], s[5 * 33]); o.w = pk2(s[6 * 33], s[7 * 33]);
        *(u32x4*)(WT + (size_t)(n0 + n) * K + k0 + 8 * c) = o; }
    asm volatile("s_waitcnt lgkmcnt(0)" ::: "memory");
}

struct Ctx {
    LAS unsigned char* lds; int tid, lane, wave, vcu, G;
    float* out; unsigned char* ws;
};

__device__ __forceinline__ void phase_prologue_a(const Ctx& F, const Args& args) {
    {
        LAS float* S = (LAS float*)F.lds;
        LAS float* R = (LAS float*)(F.lds + 33 * 512 * 4);
        const float* c = args.in[1]; const float* cc = args.in[3]; const float* wada = args.in[4]; const float* bada = args.in[5];
        float* MOD = (float*)(F.ws + WS_MOD);
        const int cg_ = F.lane & 31, kh = F.lane >> 5;
        for (int it = F.vcu; it < 4 * 192; it += F.G) {
            const int l = it / 192, n0 = (it % 192) * 32;
            float acc[33];
#pragma unroll
            for (int r = 0; r < 33; ++r) acc[r] = 0.f;
            for (int half = 0; half < 2; ++half) {
                __syncthreads();
                for (int e = F.tid; e < 33 * 512; e += NTHR) { const int r = e >> 9, k = (e & 511) + half * 512; const float v = (r < 32) ? c[r * 1024 + k] : cc[k]; S[e] = v / (1.f + __expf(-v)); }
                __syncthreads();
                const int kb = F.wave * 64 + kh * 32;
                const float* wp = wada + ((size_t)l * 1024 + half * 512 + kb) * 6144 + n0 + cg_;
#pragma unroll 1
                for (int kk = 0; kk < 32; kk += 8) {
                    const float w0 = wp[(size_t)(kk + 0) * 6144], w1 = wp[(size_t)(kk + 1) * 6144], w2 = wp[(size_t)(kk + 2) * 6144], w3 = wp[(size_t)(kk + 3) * 6144];
                    const float w4 = wp[(size_t)(kk + 4) * 6144], w5 = wp[(size_t)(kk + 5) * 6144], w6 = wp[(size_t)(kk + 6) * 6144], w7 = wp[(size_t)(kk + 7) * 6144];
#pragma unroll
                    for (int r = 0; r < 33; ++r) { const f32x4 s = *(const LAS f32x4*)(S + r * 512 + kb + kk), t = *(const LAS f32x4*)(S + r * 512 + kb + kk + 4);
                        acc[r] += (s[0] * w0 + s[1] * w1 + s[2] * w2 + s[3] * w3) + (t[0] * w4 + t[1] * w5 + t[2] * w6 + t[3] * w7); }
                }
            }
#pragma unroll
            for (int r = 0; r < 33; ++r) { acc[r] += __shfl_xor(acc[r], 32); if (kh == 0) R[(F.wave * 33 + r) * 32 + cg_] = acc[r]; }
            __syncthreads();
            for (int e = F.tid; e < 33 * 32; e += NTHR) { float s = 0.f;
#pragma unroll
                for (int w = 0; w < 8; ++w) s += R[w * 33 * 32 + e];
                const int r = e >> 5, n = n0 + (e & 31); MOD[((size_t)l * 33 + r) * 6144 + n] = s + bada[l * 6144 + n]; }
        }
        __syncthreads();
    }
    {
        LAS float* scr = (LAS float*)(F.lds + F.wave * 16384);
        const int gw = F.vcu * NWAVES + F.wave, NGW = F.G * NWAVES;
        constexpr int I_INE = 16 * 61, I_INO = 16 * 72, I_OUT = 16 * 32, I_FF1 = 16 * 128, I_FF2 = 64 * 32, I_UQ = 4 * 24, I_UKV = 2 * 32, I_Z = 96;
        constexpr int PER_E = I_INE + I_OUT + I_FF1 + I_FF2 + I_UQ + I_UKV + I_Z, PER_O = I_INO + I_OUT + I_FF1 + I_FF2;
        constexpr int NIT = 2 * (PER_E + PER_O);
        for (int it = gw; it < NIT; it += NGW) {
            int pr = it / (PER_E + PER_O), r = it % (PER_E + PER_O);
            const bool odd = r >= PER_E; if (odd) r -= PER_E;
            const int L = 2 * pr + (odd ? 1 : 0);
            unsigned char* wl = F.ws + WS_WT + (size_t)L * WL_STRIDE;
            const float* W; int K, N; size_t wo; const float* ks = nullptr; float sc = 1.f; bool zero = false;
            if (!odd) {
                if (r < I_INE) { W = args.in[9] + (size_t)pr * 1024 * 1952; K = 1024; N = 1952; wo = WL_IN; }
                else if ((r -= I_INE) < I_OUT) { W = args.in[10] + (size_t)pr * 1024 * 1024; K = 1024; N = 1024; wo = WL_OUT; }
                else if ((r -= I_OUT) < I_FF1) { W = args.in[7] + (size_t)L * 1024 * 4096; K = 1024; N = 4096; wo = WL_FF1; }
                else if ((r -= I_FF1) < I_FF2) { W = args.in[8] + (size_t)L * 4096 * 1024; K = 4096; N = 1024; wo = WL_FF2; }
                else if ((r -= I_FF2) < I_UQ) { W = args.in[12] + (size_t)pr * 256 * 768; K = 256; N = 768; wo = WL_UQ; ks = args.in[11] + pr * 256; sc = MLA_SC * LOG2E; }
                else if ((r -= I_UQ) < I_UKV) { W = args.in[14] + (size_t)pr * 128 * 1024; K = 128; N = 1024; wo = WL_UKV; ks = args.in[13] + pr * 128; }
                else { r -= I_UKV; zero = true; W = nullptr; K = 0; N = 0; wo = WL_IN; }
            } else {
                if (r < I_INO) { W = args.in[17] + (size_t)pr * 1024 * 2304; K = 1024; N = 2304; wo = WL_IN; }
                else if ((r -= I_INO) < I_OUT) { W = args.in[18] + (size_t)pr * 1024 * 1024; K = 1024; N = 1024; wo = WL_OUT; }
                else if ((r -= I_OUT) < I_FF1) { W = args.in[7] + (size_t)L * 1024 * 4096; K = 1024; N = 4096; wo = WL_FF1; }
                else { r -= I_FF1; W = args.in[8] + (size_t)L * 4096 * 1024; K = 4096; N = 1024; wo = WL_FF2; }
            }
            if (zero) { bf16* z = (bf16*)(wl + WL_IN) + (size_t)(1952 + r) * 1024; u32x4 zz = {0u, 0u, 0u, 0u}; *(u32x4*)(z + F.lane * 8) = zz; *(u32x4*)(z + 512 + F.lane * 8) = zz; }
            else transpose_item(W, K, N, (bf16*)(wl + wo), scr, r, F.lane, ks, sc);
        }
    }
}

__device__ __forceinline__ void unpack8(const u32x4 v, float* x) {
#pragma unroll
    for (int i = 0; i < 4; ++i) { x[2 * i] = __uint_as_float(v[i] << 16); x[2 * i + 1] = __uint_as_float(v[i] & 0xffff0000u); }
}
__device__ __forceinline__ u32x4 pack8(const float* x) { u32x4 w; w.x = pk2(x[0], x[1]); w.y = pk2(x[2], x[3]); w.z = pk2(x[4], x[5]); w.w = pk2(x[6], x[7]); return w; }
struct RowPassP { const void* hin_lat; const void* hin_ctx; bf16* hb_lat; bf16* hb_ctx; float* out32; const bf16* Fsrc; bf16* Adst; const float* g_post; const float* g_pre;
                  const float* mod_post; const float* mod_pre; int gate_chunk, shift_chunk, scale_chunk; int has_f, write_h, write_a, skip_ctx, final32; };
template <bool HIN32, bool HAS_F, bool WRITE_H, bool WRITE_A, bool FINAL32>
__device__ __forceinline__ void phase_rowpass(const Ctx& F, const RowPassP p) {
    const int nrows = p.skip_ctx ? NB * SEQ : MROWS;
    const int rpb_ = (nrows + F.G - 1) / F.G; const int cbeg = F.vcu * rpb_, cend = min(cbeg + rpb_, nrows);
    const int c0 = F.lane * 8;
    float gpo[16], gpr[16];
#pragma unroll
    for (int jj = 0; jj < 2; ++jj)
#pragma unroll
        for (int q = 0; q < 2; ++q) { const f32x4 a = *(const f32x4*)(p.g_post + jj * 512 + c0 + q * 4), b = *(const f32x4*)(p.g_pre + jj * 512 + c0 + q * 4);
#pragma unroll
            for (int e = 0; e < 4; ++e) { gpo[jj * 8 + q * 4 + e] = a[e]; gpr[jj * 8 + q * 4 + e] = b[e]; } }
    int cur = cbeg;
    while (cur < cend) {
        int b, j0, send;
        if (p.skip_ctx) { b = cur / SEQ; j0 = cur - b * SEQ + CTXL; send = min(cend, (b + 1) * SEQ); }
        else { b = cur / RPB; j0 = cur - b * RPB; send = min(cend, (j0 < CTXL) ? b * RPB + CTXL : (b + 1) * RPB); }
        const bool isc = j0 < CTXL; const int mrow = isc ? 32 : b; const int n = send - cur;
        const size_t hbase = isc ? (size_t)(b * CTXL + j0) * DM : (size_t)(b * SEQ + j0 - CTXL) * DM;
        const size_t rbase = (size_t)(b * RPB + j0) * DM;
        float gt[16], sh[16], sc[16];
        { const float* gp = p.mod_post + (size_t)mrow * 6144 + p.gate_chunk * 1024; const float* sp = p.mod_pre + (size_t)mrow * 6144 + p.shift_chunk * 1024; const float* cp = p.mod_pre + (size_t)mrow * 6144 + p.scale_chunk * 1024;
#pragma unroll
          for (int jj = 0; jj < 2; ++jj)
#pragma unroll
              for (int q = 0; q < 2; ++q) { const f32x4 a = *(const f32x4*)(gp + jj * 512 + c0 + q * 4), s1 = *(const f32x4*)(sp + jj * 512 + c0 + q * 4), s2 = *(const f32x4*)(cp + jj * 512 + c0 + q * 4);
#pragma unroll
                  for (int e = 0; e < 4; ++e) { gt[jj * 8 + q * 4 + e] = a[e]; sh[jj * 8 + q * 4 + e] = s1[e]; sc[jj * 8 + q * 4 + e] = 1.f + s2[e]; } } }
        const float* hin32 = (const float*)(isc ? p.hin_ctx : p.hin_lat) + hbase; const bf16* hinb = (const bf16*)(isc ? p.hin_ctx : p.hin_lat) + hbase;
        bf16* houtb = (isc ? p.hb_ctx : p.hb_lat) + hbase; float* hout32 = p.out32 + hbase;
        const bf16* fsrc = p.Fsrc + rbase; bf16* adst = p.Adst + rbase;
        f32x4 hn[HIN32 ? 4 : 1]; u32x4 hbn[HIN32 ? 1 : 2]; u32x4 fn[2];
#define RP_LOAD(i_) do { const size_t o_ = (size_t)(i_) * DM; \
            if constexpr (HIN32) { _Pragma("unroll") for (int jj_ = 0; jj_ < 2; ++jj_) { hn[jj_ * 2] = *(const f32x4*)(hin32 + o_ + jj_ * 512 + c0); hn[jj_ * 2 + 1] = *(const f32x4*)(hin32 + o_ + jj_ * 512 + c0 + 4); } } \
            else { _Pragma("unroll") for (int jj_ = 0; jj_ < 2; ++jj_) hbn[jj_] = __builtin_nontemporal_load((const u32x4*)(hinb + o_ + jj_ * 512 + c0)); } \
            if constexpr (HAS_F) { _Pragma("unroll") for (int jj_ = 0; jj_ < 2; ++jj_) fn[jj_] = *(const u32x4*)(fsrc + o_ + jj_ * 512 + c0); } } while (0)
        int i = F.wave;
        if (i < n) RP_LOAD(i);
        for (; i < n; i += NWAVES) {
            float h[16]; u32x4 fc[2];
#pragma unroll
            for (int jj = 0; jj < 2; ++jj) {
                if constexpr (HIN32) {
#pragma unroll
                    for (int e = 0; e < 4; ++e) { h[jj * 8 + e] = hn[jj * 2][e]; h[jj * 8 + 4 + e] = hn[jj * 2 + 1][e]; } }
                else unpack8(hbn[jj], h + jj * 8);
                if constexpr (HAS_F) fc[jj] = fn[jj]; }
            { const int inx = (i + NWAVES < n) ? i + NWAVES : i; RP_LOAD(inx); }
            const size_t ro = (size_t)i * DM;
            if constexpr (HAS_F) {
                float f[16]; float ss = 0.f;
                unpack8(fc[0], f); unpack8(fc[1], f + 8);
#pragma unroll
                for (int e = 0; e < 16; ++e) ss += f[e] * f[e];
                ss = wave_sum(ss); const float rs = rsqrtf(ss * (1.f / DM) + EPSN);
#pragma unroll
                for (int e = 0; e < 16; ++e) h[e] += gt[e] * (f[e] * rs * gpo[e]);
            }
            if constexpr (FINAL32) {
#pragma unroll
                for (int jj = 0; jj < 2; ++jj) { f32x4 a, c;
#pragma unroll
                    for (int e = 0; e < 4; ++e) { a[e] = h[jj * 8 + e]; c[e] = h[jj * 8 + 4 + e]; }
                    *(f32x4*)(hout32 + ro + jj * 512 + c0) = a; *(f32x4*)(hout32 + ro + jj * 512 + c0 + 4) = c; }
            }
            if constexpr (WRITE_H) {
#pragma unroll
                for (int jj = 0; jj < 2; ++jj) { const u32x4 w = pack8(h + jj * 8); __builtin_nontemporal_store(w, (u32x4*)(houtb + ro + jj * 512 + c0)); unpack8(w, h + jj * 8); }
            }
            if constexpr (WRITE_A) {
                float ss = 0.f;
#pragma unroll
                for (int e = 0; e < 16; ++e) ss += h[e] * h[e];
                ss = wave_sum(ss); const float rs = rsqrtf(ss * (1.f / DM) + EPSN);
#pragma unroll
                for (int jj = 0; jj < 2; ++jj) { float o[8];
#pragma unroll
                    for (int e = 0; e < 8; ++e) o[e] = (h[jj * 8 + e] * rs * gpr[jj * 8 + e]) * sc[jj * 8 + e] + sh[jj * 8 + e];
                    *(u32x4*)(adst + ro + jj * 512 + c0) = pack8(o); }
            }
        }
#undef RP_LOAD
        cur = send;
    }
}

__device__ __forceinline__ void rope_cs(int j, int i, int nfreq, float& cs, float& sn) {
    if (j < CTXL) { cs = 1.f; sn = 0.f; return; }
    const int t = j - CTXL; const int fi = (i < nfreq) ? i : i - nfreq; const float pos = (i < nfreq) ? (float)(t >> 6) : (float)(t & 63);
    const float ang = pos * exp2f(-(float)fi * (LOG2_THETA / (float)nfreq));
    cs = __cosf(ang); sn = __sinf(ang);
}
__device__ __forceinline__ void rope8(float* x, int lane, bool isx2, float pos, const float* finv, bool doit, float scale) {
    float y[8];
#pragma unroll
    for (int e = 0; e < 8; ++e) y[e] = __shfl_xor(x[e], 4);
    (void)lane;
#pragma unroll
    for (int e = 0; e < 8; ++e) {
        float cs = 1.f, sn = 0.f;
        if (doit) { const float ang = pos * finv[e]; cs = __cosf(ang); sn = __sinf(ang); }
        x[e] = (isx2 ? (x[e] * cs + y[e] * sn) : (x[e] * cs - y[e] * sn)) * scale;
    }
}
__device__ __forceinline__ void phase_prep_even(const Ctx& F) {
    bf16* P = (bf16*)(F.ws + WS_P); bf16* CQN = (bf16*)(F.ws + WS_AF); bf16* CKVN = (bf16*)(F.ws + WS_AF + 36 * MiB);
    const int gw = F.vcu * NWAVES + F.wave, NGW = F.G * NWAVES; const int lane = F.lane; const int chunk = (MROWS + NGW - 1) / NGW;
    const int r0 = gw * chunk, r1 = min(r0 + chunk, MROWS);
    if (r0 >= r1) return;
    const int ca = lane < 52 ? lane : 51;
    const int cv = lane & 7; const bool isx2 = (cv & 4) != 0; const bool colang = (cv & 2) != 0;
    float finv[8], finvk[8];
#pragma unroll
    for (int e = 0; e < 8; ++e) { finv[e] = exp2f(-(float)(8 * (cv & 1) + e) * (LOG2_THETA / 16.f)); finvk[e] = exp2f(-(float)e * (LOG2_THETA / 8.f)); }
    u32x4 na, nb, nc;
    { const bf16* pr = P + (size_t)r0 * PE; na = *(const u32x4*)(pr + 8 * ca); nb = *(const u32x4*)(pr + E_DQ + 8 * lane); nc = *(const u32x4*)(pr + E_DK + 8 * lane); }
    for (int r = r0; r < r1; ++r) {
        const u32x4 va = na, vb = nb, vc = nc;
        if (r + 1 < r1) { const bf16* pn = P + (size_t)(r + 1) * PE; na = *(const u32x4*)(pn + 8 * ca); nb = *(const u32x4*)(pn + E_DQ + 8 * lane); nc = *(const u32x4*)(pn + E_DK + 8 * lane); }
        const int j = r % RPB; const bool lat = j >= CTXL; const int t = j - CTXL;
        const float posh = colang ? (float)(t & 63) : (float)(t >> 6);
        bf16* pr = P + (size_t)r * PE;
        {
            float x[8]; unpack8(va, x);
            float ss = 0.f;
#pragma unroll
            for (int e = 0; e < 8; ++e) ss += x[e] * x[e];
            ss = sum16(ss);
            const float ss32 = ss + __shfl_xor(ss, 16);
            const float rs = (lane < 32) ? rsqrtf(ss32 * (1.f / 256.f) + EPSN) : rsqrtf(ss * (1.f / 128.f) + EPSN);
            float y[8];
#pragma unroll
            for (int e = 0; e < 8; ++e) y[e] = __shfl_xor(x[e], 2);
            if (lane < 32) { float o[8];
#pragma unroll
                for (int e = 0; e < 8; ++e) o[e] = x[e] * rs;
                *(u32x4*)(CQN + (size_t)r * 256 + 8 * lane) = pack8(o); }
            else if (lane < 48) { float o[8];
#pragma unroll
                for (int e = 0; e < 8; ++e) o[e] = x[e] * rs;
                *(u32x4*)(CKVN + (size_t)r * 128 + 8 * (lane - 32)) = pack8(o); }
            else if (lane < 52 && lat) { const float pos = (lane & 1) ? (float)(t & 63) : (float)(t >> 6); const bool x2 = (lane & 2) != 0; float o[8];
#pragma unroll
                for (int e = 0; e < 8; ++e) { const float ang = pos * finvk[e]; const float cs = __cosf(ang), sn = __sinf(ang); o[e] = x2 ? (x[e] * cs + y[e] * sn) : (x[e] * cs - y[e] * sn); }
                *(u32x4*)(pr + 8 * lane) = pack8(o); }
        }
        { float x[8]; unpack8(vb, x); rope8(x, lane, isx2, posh, finv, lat, HD_SC * LOG2E); *(u32x4*)(pr + E_DQ + 8 * lane) = pack8(x); }
        if (lat) { float x[8]; unpack8(vc, x); rope8(x, lane, isx2, posh, finv, true, 1.f); *(u32x4*)(pr + E_DK + 8 * lane) = pack8(x); }
    }
}
__device__ __forceinline__ void phase_prep_odd(const Ctx& F, const float* qkn  ) {
    bf16* P = (bf16*)(F.ws + WS_P);
    const int gw = F.vcu * NWAVES + F.wave, NGW = F.G * NWAVES; const int lane = F.lane; const int chunk = (MROWS + NGW - 1) / NGW;
    const int r0 = gw * chunk, r1 = min(r0 + chunk, MROWS);
    if (r0 >= r1) return;
    const int cv = lane & 7; const bool isx2 = (cv & 4) != 0; const bool colang = (cv & 2) != 0;
    float finv[8], gq[8], gk[8];
#pragma unroll
    for (int e = 0; e < 8; ++e) { finv[e] = exp2f(-(float)(8 * (cv & 1) + e) * (LOG2_THETA / 16.f)); gq[e] = qkn[8 * cv + e]; gk[e] = qkn[64 + 8 * cv + e]; }
    u32x4 na, nb, nc;
    { const bf16* pr = P + (size_t)r0 * PO; na = *(const u32x4*)(pr + 8 * lane); nb = *(const u32x4*)(pr + O_GK + 8 * (lane & 15)); nc = *(const u32x4*)(pr + O_NQ + 8 * lane); }
    for (int r = r0; r < r1; ++r) {
        const u32x4 va = na, vb = nb, vc = nc;
        if (r + 1 < r1) { const bf16* pn = P + (size_t)(r + 1) * PO; na = *(const u32x4*)(pn + 8 * lane); nb = *(const u32x4*)(pn + O_GK + 8 * (lane & 15)); nc = *(const u32x4*)(pn + O_NQ + 8 * lane); }
        const int j = r % RPB; const bool lat = j >= CTXL; const int t = j - CTXL;
        const float posh = colang ? (float)(t & 63) : (float)(t >> 6);
        bf16* pr = P + (size_t)r * PO;
        { float x[8]; unpack8(va, x); float ss = 0.f;
#pragma unroll
          for (int e = 0; e < 8; ++e) ss += x[e] * x[e];
          ss = sum8(ss);
          const float rs = rsqrtf(ss * (1.f / 64.f) + EPSN);
#pragma unroll
          for (int e = 0; e < 8; ++e) x[e] *= rs * gq[e];
          rope8(x, lane, isx2, posh, finv, lat, HD_SC * LOG2E); *(u32x4*)(pr + 8 * lane) = pack8(x); }
        { float x[8]; unpack8(vb, x); float ss = 0.f;
#pragma unroll
          for (int e = 0; e < 8; ++e) ss += x[e] * x[e];
          ss = sum8(ss);
          const float rs = rsqrtf(ss * (1.f / 64.f) + EPSN);
#pragma unroll
          for (int e = 0; e < 8; ++e) x[e] *= rs * gk[e];
          rope8(x, lane, isx2, posh, finv, lat, 1.f); if (lane < 16) *(u32x4*)(pr + O_GK + 8 * lane) = pack8(x); }
        { float x[8]; unpack8(vc, x);
#pragma unroll
          for (int e = 0; e < 8; ++e) x[e] *= (HD_SC * LOG2E);
          *(u32x4*)(pr + O_NQ + 8 * lane) = pack8(x); }
    }
}

struct AttnP {
    const bf16* q; int qpitch; const bf16* ka; int kapitch; const bf16* kb; int kbpitch; const bf16* v; int vpitch; bf16* o; int opitch;
    int nA, tB0, nB;
    int rope_t0;
    int mode;
    float lam, post; const float* subln;
    int na_row0;
};
__device__ __forceinline__ int crow(int r, int hi) { return (r & 3) + 8 * (r >> 2) + 4 * hi; }

struct AttnP2 { const bf16* qA; const bf16* qB; int qpitch; const bf16* ka; int kapitch; const bf16* v; int vpitch; bf16* oA; bf16* oB; int opitch; int ntile; };
__device__ __forceinline__ void attn_unit_gqa2(const AttnP2& a, LAS unsigned char* lds, int tid) {
    constexpr int DQK = 64, DV = 64, KP = DQK * 2 + 16, KBYTES = 64 * KP, VBYTES = 64 * DV * 2, BUF = KBYTES + VBYTES, KCH = DQK / 8, VCH = DV / 8, ND = DQK / 16, NDB = DV / 32;
    const int lane = tid & 63, wave = __builtin_amdgcn_readfirstlane(tid >> 6), r32 = lane & 31, hi = lane >> 5;
    bf16x8 qfA[ND], qfB[ND];
    { const size_t ro = (size_t)(wave * 32 + r32) * a.qpitch + hi * 8;
#pragma unroll
      for (int d0 = 0; d0 < ND; ++d0) { qfA[d0] = *(const bf16x8*)(a.qA + ro + d0 * 16); qfB[d0] = *(const bf16x8*)(a.qB + ro + d0 * 16); } }
    constexpr int KS = KP / 16, NIK = KS, NIV = VCH, NI = NIK + NIV, MAXI = (NI + 7) / 8;
    const bf16* gsrc[MAXI]; unsigned gstep[MAXI];
#pragma unroll
    for (int j = 0; j < MAXI; ++j) {
        const int ii = wave + 8 * j; const int s = ii * 64 + lane;
        if (ii < NIK) { const int row = s / KS; int ch = s - row * KS; if (ch >= KCH) ch = 0; gsrc[j] = a.ka + (size_t)row * a.kapitch + ch * 8; gstep[j] = 64u * (unsigned)a.kapitch; }
        else { const int s2 = (s - 64 * KS) & (64 * VCH - 1); const int st = s2 >> 5, rowin = (s2 & 31) >> 2, chin = s2 & 3; const int row = (st / NDB) * 8 + rowin, ch = (st % NDB) * 4 + chin;
            gsrc[j] = a.v + (size_t)row * a.vpitch + ch * 8; gstep[j] = 64u * (unsigned)a.vpitch; }
    }
    const int mycnt = (NI - 1 - wave) / 8 + 1;
    const int ntile = a.ntile;
#define ATT_ISSUE(tt_, slot_) do { _Pragma("unroll") for (int j_ = 0; j_ < MAXI; ++j_) if (wave + 8 * j_ < NI) \
        __builtin_amdgcn_global_load_lds((const unsigned*)(gsrc[j_] + (size_t)(tt_) * gstep[j_]), (LAS unsigned*)(lds + (slot_) * BUF + (wave + 8 * j_) * 1024), 16, 0, 0); } while (0)
#define ATT_WAITBAR(keep_) do { if (keep_) { if (mycnt == MAXI) asm volatile("s_waitcnt vmcnt(%0) lgkmcnt(0)\n\ts_barrier" :: "n"(MAXI) : "memory"); else asm volatile("s_waitcnt vmcnt(%0) lgkmcnt(0)\n\ts_barrier" :: "n"(MAXI - 1) : "memory"); } \
        else asm volatile("s_waitcnt vmcnt(0) lgkmcnt(0)\n\ts_barrier" ::: "memory"); } while (0)
    ATT_ISSUE(0, 0);
    if (ntile > 1) ATT_ISSUE(1, 1);
    ATT_WAITBAR(ntile > 1);
    constexpr float THR = 8.f;
    float mrunA = 0.f, lrunA = 0.f, mrunB = 0.f, lrunB = 0.f;
    f32x16 oA[NDB], oB[NDB];
#pragma unroll
    for (int d = 0; d < NDB; ++d) { oA[d] = f32x16{}; oB[d] = f32x16{}; }
    const int koff = r32 * KP + hi * 16;
    const int voff = KBYTES + (4 * hi + ((lane & 15) >> 2)) * 64 + ((lane >> 4) & 1) * 32 + (lane & 3) * 8;
    int slot0 = 0, slot2 = 2;
    for (int it = 0; it < ntile; ++it) {
        if (it + 2 < ntile) ATT_ISSUE(it + 2, slot2);
        LAS unsigned char* kb_ = lds + slot0 * BUF;
        bf16x8 kf0[ND], kf1[ND];
#pragma unroll
        for (int d0 = 0; d0 < ND; ++d0) { kf0[d0] = *(const LAS bf16x8*)(kb_ + koff + d0 * 32); kf1[d0] = *(const LAS bf16x8*)(kb_ + koff + 32 * KP + d0 * 32); }
        bf16x8 pwA[4], pwB[4];
#define GQ_HEAD(QF_, MRUN_, LRUN_, O_, PW_) do { \
            f32x16 p0 = f32x16{}, p1 = f32x16{}; \
            _Pragma("unroll") for (int d0 = 0; d0 < ND; ++d0) { p0 = __builtin_amdgcn_mfma_f32_32x32x16_bf16(kf0[d0], QF_[d0], p0, 0, 0, 0); p1 = __builtin_amdgcn_mfma_f32_32x32x16_bf16(kf1[d0], QF_[d0], p1, 0, 0, 0); } \
            float mxa = fmaxf(fmaxf(p0[0], p0[1]), p1[0]), mxb = fmaxf(fmaxf(p0[2], p0[3]), p1[1]); \
            mxa = fmaxf(fmaxf(mxa, p1[2]), p1[3]); \
            _Pragma("unroll") for (int r = 4; r < 16; r += 4) { mxa = fmaxf(fmaxf(mxa, p0[r]), p0[r + 1]); mxb = fmaxf(fmaxf(mxb, p0[r + 2]), p0[r + 3]); mxa = fmaxf(fmaxf(mxa, p1[r]), p1[r + 1]); mxb = fmaxf(fmaxf(mxb, p1[r + 2]), p1[r + 3]); } \
            float mx = fmaxf(mxa, mxb); \
            { const auto rr = __builtin_amdgcn_permlane32_swap(__float_as_uint(mx), __float_as_uint(mx), false, false); mx = fmaxf(__uint_as_float(rr[0]), __uint_as_float(rr[1])); } \
            mx -= MRUN_; \
            if (it == 0 || __any(mx > THR)) { const float dl = (it == 0) ? mx : fmaxf(mx, 0.f); MRUN_ += dl; const float alpha = __builtin_amdgcn_exp2f(-dl); LRUN_ *= alpha; \
                _Pragma("unroll") for (int d = 0; d < NDB; ++d) _Pragma("unroll") for (int r = 0; r < 16; ++r) O_[d][r] *= alpha; } \
            float rs0 = 0.f, rs1 = 0.f; \
            _Pragma("unroll") for (int r = 0; r < 16; ++r) { p0[r] = __builtin_amdgcn_exp2f(p0[r] - MRUN_); p1[r] = __builtin_amdgcn_exp2f(p1[r] - MRUN_); rs0 += p0[r]; rs1 += p1[r]; } \
            LRUN_ += rs0 + rs1; \
            _Pragma("unroll") for (int ks = 0; ks < 4; ++ks) { u32x4 w; const int b = 8 * (ks & 1); \
                if (ks < 2) { w.x = pk2(p0[b], p0[b + 1]); w.y = pk2(p0[b + 2], p0[b + 3]); w.z = pk2(p0[b + 4], p0[b + 5]); w.w = pk2(p0[b + 6], p0[b + 7]); } \
                else { w.x = pk2(p1[b], p1[b + 1]); w.y = pk2(p1[b + 2], p1[b + 3]); w.z = pk2(p1[b + 4], p1[b + 5]); w.w = pk2(p1[b + 6], p1[b + 7]); } \
                PW_[ks] = __builtin_bit_cast(bf16x8, w); } } while (0)
        GQ_HEAD(qfA, mrunA, lrunA, oA, pwA);
        GQ_HEAD(qfB, mrunB, lrunB, oB, pwB);
#undef GQ_HEAD
        {
            const unsigned vaddr = (unsigned)(size_t)kb_ + (unsigned)voff;
            s16x4 vlo[2][NDB], vhi[2][NDB];
#define ATT_VRD(set_, ks_) do { _Pragma("unroll") for (int d_ = 0; d_ < NDB; ++d_) { \
                asm volatile("ds_read_b64_tr_b16 %0, %1 offset:%2" : "=&v"(vlo[set_][d_]) : "v"(vaddr), "n"(((2 * (ks_)) * NDB + d_) * 512)); \
                asm volatile("ds_read_b64_tr_b16 %0, %1 offset:%2" : "=&v"(vhi[set_][d_]) : "v"(vaddr), "n"(((2 * (ks_) + 1) * NDB + d_) * 512)); } } while (0)
            ATT_VRD(0, 0);
#pragma unroll
            for (int ks = 0; ks < 4; ++ks) {
                const int cs = ks & 1;
                if (ks < 3) { if (ks == 0) ATT_VRD(1, 1); else if (ks == 1) ATT_VRD(0, 2); else ATT_VRD(1, 3); }
                if (ks < 3) asm volatile("s_waitcnt lgkmcnt(4)" : "+v"(vlo[cs][0]), "+v"(vhi[cs][0]), "+v"(vlo[cs][1]), "+v"(vhi[cs][1]));
                else asm volatile("s_waitcnt lgkmcnt(0)" : "+v"(vlo[cs][0]), "+v"(vhi[cs][0]), "+v"(vlo[cs][1]), "+v"(vhi[cs][1]));
#pragma unroll
                for (int d = 0; d < NDB; ++d) {
                    const bf16x8 vf = {vlo[cs][d][0], vlo[cs][d][1], vlo[cs][d][2], vlo[cs][d][3], vhi[cs][d][0], vhi[cs][d][1], vhi[cs][d][2], vhi[cs][d][3]};
                    oA[d] = __builtin_amdgcn_mfma_f32_32x32x16_bf16(vf, pwA[ks], oA[d], 0, 0, 0);
                    oB[d] = __builtin_amdgcn_mfma_f32_32x32x16_bf16(vf, pwB[ks], oB[d], 0, 0, 0);
                }
            }
#undef ATT_VRD
        }
        ATT_WAITBAR(it + 2 < ntile);
        slot0 = (slot0 == 2) ? 0 : slot0 + 1; slot2 = (slot2 == 2) ? 0 : slot2 + 1;
    }
#undef ATT_ISSUE
#undef ATT_WAITBAR
    lrunA += __shfl_xor(lrunA, 32); lrunB += __shfl_xor(lrunB, 32);
    const float invA = 1.f / lrunA, invB = 1.f / lrunB;
    const size_t oo = (size_t)(wave * 32 + r32) * a.opitch + 4 * hi;
#pragma unroll
    for (int d = 0; d < NDB; ++d)
#pragma unroll
        for (int g = 0; g < 4; ++g) { u32x2 w; w.x = pk2(oA[d][4 * g] * invA, oA[d][4 * g + 1] * invA); w.y = pk2(oA[d][4 * g + 2] * invA, oA[d][4 * g + 3] * invA); *(u32x2*)(a.oA + oo + 32 * d + 8 * g) = w;
            u32x2 w2; w2.x = pk2(oB[d][4 * g] * invB, oB[d][4 * g + 1] * invB); w2.y = pk2(oB[d][4 * g + 2] * invB, oB[d][4 * g + 3] * invB); *(u32x2*)(a.oB + oo + 32 * d + 8 * g) = w2; }
}

template <int DQK, int DV, bool NA>
__device__ __forceinline__ void attn_unit(const AttnP& a, LAS unsigned char* lds, const LAS float* biasT, int tid) {
    constexpr int KP = DQK * 2 + 16, KBYTES = 64 * KP, VBYTES = 64 * DV * 2, BUF = KBYTES + VBYTES;
    constexpr int KCH = DQK / 8, VCH = DV / 8, ND = DQK / 16, NDB = DV / 32;
    const int lane = tid & 63, wave = __builtin_amdgcn_readfirstlane(tid >> 6), r32 = lane & 31, hi = lane >> 5;
    bf16x8 qf[ND];
    { const bf16* qrow = a.q + (size_t)(wave * 32 + r32) * a.qpitch + hi * 8;
#pragma unroll
      for (int d0 = 0; d0 < ND; ++d0) qf[d0] = *(const bf16x8*)(qrow + d0 * 16); }
    if constexpr (DQK == 96) {
        if (a.rope_t0 >= 0) {
            const int t = a.rope_t0 + wave * 32 + r32; const float pos = hi ? (float)(t & 63) : (float)(t >> 6);
#pragma unroll
            for (int e = 0; e < 8; ++e) { const float ang = pos * exp2f(-(float)e * (LOG2_THETA / 8.f)); const float cs = __cosf(ang), sn = __sinf(ang);
                const float x1 = bf2f((unsigned short)qf[4][e]), x2 = bf2f((unsigned short)qf[5][e]);
                qf[4][e] = (short)f2bf(x1 * cs - x2 * sn); qf[5][e] = (short)f2bf(x2 * cs + x1 * sn); }
        }
    }
    constexpr int KS = KP / 16, NIK = KS, NIV = VCH, NI = NIK + NIV, MAXI = (NI + 7) / 8;
    const bf16* gsrc[MAXI]; unsigned gstep[MAXI];
#pragma unroll
    for (int j = 0; j < MAXI; ++j) {
        const int ii = wave + 8 * j; const int s = ii * 64 + lane;
        if (ii < NIK) { const int row = s / KS; int ch = s - row * KS; if (ch >= KCH) ch = 0;
            if (DQK == 96 && ch >= 8) { gsrc[j] = a.kb + (size_t)row * a.kbpitch + (ch - 8) * 8; gstep[j] = 64u * (unsigned)a.kbpitch; }
            else { gsrc[j] = a.ka + (size_t)row * a.kapitch + ch * 8; gstep[j] = 64u * (unsigned)a.kapitch; } }
        else { const int s2 = (s - 64 * KS) & (64 * VCH - 1); const int st = s2 >> 5, rowin = (s2 & 31) >> 2, chin = s2 & 3; const int row = (st / NDB) * 8 + rowin, ch = (st % NDB) * 4 + chin;
            gsrc[j] = a.v + (size_t)row * a.vpitch + ch * 8; gstep[j] = 64u * (unsigned)a.vpitch; }
    }
    const int mycnt = (NI - 1 - wave) / 8 + 1;
    const int ntile = a.nA + a.nB;
#define ATT_TILE(i_) ((i_) < a.nA ? (i_) : a.tB0 + ((i_) - a.nA))
#define ATT_ISSUE(tt_, slot_) do { _Pragma("unroll") for (int j_ = 0; j_ < MAXI; ++j_) if (wave + 8 * j_ < NI) \
        __builtin_amdgcn_global_load_lds((const unsigned*)(gsrc[j_] + (size_t)(tt_) * gstep[j_]), (LAS unsigned*)(lds + (slot_) * BUF + (wave + 8 * j_) * 1024), 16, 0, 0); } while (0)
#define ATT_WAITBAR(keep_) do { if (keep_) { if (mycnt == MAXI) asm volatile("s_waitcnt vmcnt(%0) lgkmcnt(0)\n\ts_barrier" :: "n"(MAXI) : "memory"); else asm volatile("s_waitcnt vmcnt(%0) lgkmcnt(0)\n\ts_barrier" :: "n"(MAXI - 1) : "memory"); } \
        else asm volatile("s_waitcnt vmcnt(0) lgkmcnt(0)\n\ts_barrier" ::: "memory"); } while (0)
    ATT_ISSUE(ATT_TILE(0), 0);
    if (ntile > 1) ATT_ISSUE(ATT_TILE(1), 1);
    ATT_WAITBAR(ntile > 1);
    constexpr float THR = 8.f;
    constexpr bool NEGM = (DV == 64) && !NA;
    float mrun = 0.f, lrun = 0.f;
    f32x16 negm = f32x16{};
    f32x16 o[NDB];
#pragma unroll
    for (int d = 0; d < NDB; ++d) o[d] = f32x16{};
    const int koff = r32 * KP + hi * 16;
    const int voff = KBYTES + (4 * hi + ((lane & 15) >> 2)) * 64 + ((lane >> 4) & 1) * 32 + (lane & 3) * 8;
    int na_rq = 0, na_r0 = 0, na_c = 0, na_ws = 0;
    if constexpr (NA) { na_rq = a.na_row0 + (wave >> 1); na_r0 = min(max(na_rq - 4, 0), 24); na_c = 32 * (wave & 1) + r32; na_ws = min(max(na_c - 8, 0), 48); }
    float mv[NA ? 20 : 1]; const LAS float* tb0 = nullptr; const int napar = wave & 1;
    if constexpr (NA) {
        tb0 = biasT + (64 + 15 - na_c + 4 * hi);
        if (napar == 0) {
#pragma unroll
            for (int r = 0; r < 16; ++r) { const int kc0 = crow(r, hi); mv[r] = (kc0 >= na_ws && kc0 < na_ws + 16) ? 0.f : -INFINITY; }
#pragma unroll
            for (int r = 0; r < 4; ++r) { const int kc1 = 32 + crow(r, hi); mv[16 + r] = (kc1 >= na_ws && kc1 < na_ws + 16) ? 0.f : -INFINITY; }
        } else {
#pragma unroll
            for (int r = 0; r < 16; ++r) { const int kc1 = 32 + crow(r, hi); mv[r] = (kc1 >= na_ws && kc1 < na_ws + 16) ? 0.f : -INFINITY; }
#pragma unroll
            for (int r = 0; r < 4; ++r) { const int kc0 = crow(12 + r, hi); mv[16 + r] = (kc0 >= na_ws && kc0 < na_ws + 16) ? 0.f : -INFINITY; }
        }
    }
    int slot0 = 0, slot2 = 2;
    for (int it = 0; it < ntile; ++it) {
        const int tt = ATT_TILE(it);
        if (it + 2 < ntile) { const int tn = ATT_TILE(it + 2); ATT_ISSUE(tn, slot2); }
        bool active = true; int rowoff = 0; bool local = false;
        if constexpr (NA) { if (tt >= 4) { const int kr = tt - 4; local = true; active = (kr >= na_r0) && (kr < na_r0 + 8); rowoff = (kr - na_rq + 7) * 32; } }
        if (active) {
            LAS unsigned char* kb_ = lds + slot0 * BUF;
            f32x16 p0, p1;
            if constexpr (NEGM) { p0 = negm; p1 = negm; } else { p0 = f32x16{}; p1 = f32x16{}; }
            {
                bf16x8 kf0[ND], kf1[ND];
#pragma unroll
                for (int d0 = 0; d0 < ND; ++d0) { kf0[d0] = *(const LAS bf16x8*)(kb_ + koff + d0 * 32); kf1[d0] = *(const LAS bf16x8*)(kb_ + koff + 32 * KP + d0 * 32); }
                __builtin_amdgcn_sched_barrier(0);
#pragma unroll
                for (int d0 = 0; d0 < ND; ++d0) {
                    p0 = __builtin_amdgcn_mfma_f32_32x32x16_bf16(kf0[d0], qf[d0], p0, 0, 0, 0);
                    p1 = __builtin_amdgcn_mfma_f32_32x32x16_bf16(kf1[d0], qf[d0], p1, 0, 0, 0);
                }
            }
            if constexpr (NA) {
                if (local) {
                    const LAS float* tb = tb0 + rowoff;
                    if (napar == 0) {
#pragma unroll
                        for (int r = 0; r < 16; ++r) p0[r] = (p0[r] + tb[(r & 3) + 8 * (r >> 2)]) + mv[r];
#pragma unroll
                        for (int r = 0; r < 4; ++r) p1[r] = (p1[r] + tb[32 + (r & 3)]) + mv[16 + r];
#pragma unroll
                        for (int r = 4; r < 16; ++r) p1[r] = -INFINITY;
                    } else {
#pragma unroll
                        for (int r = 0; r < 12; ++r) p0[r] = -INFINITY;
#pragma unroll
                        for (int r = 12; r < 16; ++r) p0[r] = (p0[r] + tb[(r & 3) + 24]) + mv[16 + r - 12];
#pragma unroll
                        for (int r = 0; r < 16; ++r) p1[r] = (p1[r] + tb[32 + (r & 3) + 8 * (r >> 2)]) + mv[r];
                    }
                }
            }
            float mxa = fmaxf(fmaxf(p0[0], p0[1]), p1[0]), mxb = fmaxf(fmaxf(p0[2], p0[3]), p1[1]);
            mxa = fmaxf(fmaxf(mxa, p1[2]), p1[3]);
#pragma unroll
            for (int r = 4; r < 16; r += 4) { mxa = fmaxf(fmaxf(mxa, p0[r]), p0[r + 1]); mxb = fmaxf(fmaxf(mxb, p0[r + 2]), p0[r + 3]); mxa = fmaxf(fmaxf(mxa, p1[r]), p1[r + 1]); mxb = fmaxf(fmaxf(mxb, p1[r + 2]), p1[r + 3]); }
            float mx = fmaxf(mxa, mxb);
            { const auto rr = __builtin_amdgcn_permlane32_swap(__float_as_uint(mx), __float_as_uint(mx), false, false); mx = fmaxf(__uint_as_float(rr[0]), __uint_as_float(rr[1])); }
            if constexpr (!NEGM) mx -= mrun;
            if (it == 0 || __any(mx > THR)) {
                const float dl = (it == 0) ? mx : fmaxf(mx, 0.f);
                mrun += dl;
                const float alpha = __builtin_amdgcn_exp2f(-dl);
                lrun *= alpha;
#pragma unroll
                for (int d = 0; d < NDB; ++d)
#pragma unroll
                    for (int r = 0; r < 16; ++r) o[d][r] *= alpha;
                if constexpr (NEGM) {
#pragma unroll
                    for (int r = 0; r < 16; ++r) { p0[r] -= dl; p1[r] -= dl; negm[r] = -mrun; }
                }
            }
            float rs0 = 0.f, rs1 = 0.f, rs2 = 0.f, rs3 = 0.f;
#pragma unroll
            for (int r = 0; r < 16; r += 2) {
                if constexpr (NEGM) { p0[r] = __builtin_amdgcn_exp2f(p0[r]); p0[r + 1] = __builtin_amdgcn_exp2f(p0[r + 1]); p1[r] = __builtin_amdgcn_exp2f(p1[r]); p1[r + 1] = __builtin_amdgcn_exp2f(p1[r + 1]); }
                else { p0[r] = __builtin_amdgcn_exp2f(p0[r] - mrun); p0[r + 1] = __builtin_amdgcn_exp2f(p0[r + 1] - mrun); p1[r] = __builtin_amdgcn_exp2f(p1[r] - mrun); p1[r + 1] = __builtin_amdgcn_exp2f(p1[r + 1] - mrun); }
                rs0 += p0[r]; rs1 += p0[r + 1]; rs2 += p1[r]; rs3 += p1[r + 1];
            }
            lrun += (rs0 + rs1) + (rs2 + rs3);
            bf16x8 pw[4];
#pragma unroll
            for (int ks = 0; ks < 4; ++ks) { u32x4 w;
                if (ks < 2) { const int b = 8 * (ks & 1); w.x = pk2(p0[b], p0[b + 1]); w.y = pk2(p0[b + 2], p0[b + 3]); w.z = pk2(p0[b + 4], p0[b + 5]); w.w = pk2(p0[b + 6], p0[b + 7]); }
                else { const int b = 8 * (ks & 1); w.x = pk2(p1[b], p1[b + 1]); w.y = pk2(p1[b + 2], p1[b + 3]); w.z = pk2(p1[b + 4], p1[b + 5]); w.w = pk2(p1[b + 6], p1[b + 7]); }
                pw[ks] = __builtin_bit_cast(bf16x8, w); }
            {
                const unsigned vaddr = (unsigned)(size_t)kb_ + (unsigned)voff;
                s16x4 vlo[2][NDB], vhi[2][NDB];
#define ATT_VRD(set_, ks_) do { _Pragma("unroll") for (int d_ = 0; d_ < NDB; ++d_) { \
                    asm volatile("ds_read_b64_tr_b16 %0, %1 offset:%2" : "=&v"(vlo[set_][d_]) : "v"(vaddr), "n"(((2 * (ks_)) * NDB + d_) * 512)); \
                    asm volatile("ds_read_b64_tr_b16 %0, %1 offset:%2" : "=&v"(vhi[set_][d_]) : "v"(vaddr), "n"(((2 * (ks_) + 1) * NDB + d_) * 512)); } } while (0)
                ATT_VRD(0, 0);
#pragma unroll
                for (int ks = 0; ks < 4; ++ks) {
                    const int cs = ks & 1;
                    if (ks < 3) { if (ks == 0) ATT_VRD(1, 1); else if (ks == 1) ATT_VRD(0, 2); else ATT_VRD(1, 3); }
                    if (ks < 3) { if constexpr (NDB == 2) asm volatile("s_waitcnt lgkmcnt(4)" : "+v"(vlo[cs][0]), "+v"(vhi[cs][0]), "+v"(vlo[cs][1]), "+v"(vhi[cs][1]));
                                  else asm volatile("s_waitcnt lgkmcnt(8)" : "+v"(vlo[cs][0]), "+v"(vhi[cs][0]), "+v"(vlo[cs][1]), "+v"(vhi[cs][1]), "+v"(vlo[cs][NDB - 2]), "+v"(vhi[cs][NDB - 2]), "+v"(vlo[cs][NDB - 1]), "+v"(vhi[cs][NDB - 1])); }
                    else { if constexpr (NDB == 2) asm volatile("s_waitcnt lgkmcnt(0)" : "+v"(vlo[cs][0]), "+v"(vhi[cs][0]), "+v"(vlo[cs][1]), "+v"(vhi[cs][1]));
                           else asm volatile("s_waitcnt lgkmcnt(0)" : "+v"(vlo[cs][0]), "+v"(vhi[cs][0]), "+v"(vlo[cs][1]), "+v"(vhi[cs][1]), "+v"(vlo[cs][NDB - 2]), "+v"(vhi[cs][NDB - 2]), "+v"(vlo[cs][NDB - 1]), "+v"(vhi[cs][NDB - 1])); }
#pragma unroll
                    for (int d = 0; d < NDB; ++d) {
                        const bf16x8 vf = {vlo[cs][d][0], vlo[cs][d][1], vlo[cs][d][2], vlo[cs][d][3], vhi[cs][d][0], vhi[cs][d][1], vhi[cs][d][2], vhi[cs][d][3]};
                        o[d] = __builtin_amdgcn_mfma_f32_32x32x16_bf16(vf, pw[ks], o[d], 0, 0, 0);
                    }
                }
#undef ATT_VRD
            }
        }
        ATT_WAITBAR(it + 2 < ntile);
        slot0 = (slot0 == 2) ? 0 : slot0 + 1; slot2 = (slot2 == 2) ? 0 : slot2 + 1;
    }
#undef ATT_TILE
#undef ATT_ISSUE
#undef ATT_WAITBAR
    lrun += __shfl_xor(lrun, 32);
    const float inv = 1.f / lrun;
    bf16* orow = a.o + (size_t)(wave * 32 + r32) * a.opitch + 4 * hi;
    if (a.mode == 2) {
        float ss = 0.f;
#pragma unroll
        for (int d = 0; d < NDB; ++d)
#pragma unroll
            for (int g = 0; g < 4; ++g) { const u32x2 w = *(const u32x2*)(orow + 32 * d + 8 * g);
                const float o1[4] = {bf2f(w.x & 0xffff), bf2f(w.x >> 16), bf2f(w.y & 0xffff), bf2f(w.y >> 16)};
#pragma unroll
                for (int e = 0; e < 4; ++e) { const float dl = o1[e] - a.lam * (o[d][4 * g + e] * inv); o[d][4 * g + e] = dl; ss += dl * dl; } }
        ss += __shfl_xor(ss, 32);
        const float rs = rsqrtf(ss * (1.f / (float)DV) + EPSN) * a.post;
#pragma unroll
        for (int d = 0; d < NDB; ++d)
#pragma unroll
            for (int g = 0; g < 4; ++g) { const f32x4 sl = *(const f32x4*)(a.subln + 32 * d + 8 * g + 4 * hi);
                u32x2 w; w.x = pk2(o[d][4 * g] * rs * sl[0], o[d][4 * g + 1] * rs * sl[1]); w.y = pk2(o[d][4 * g + 2] * rs * sl[2], o[d][4 * g + 3] * rs * sl[3]);
                *(u32x2*)(orow + 32 * d + 8 * g) = w; }
    } else {
#pragma unroll
        for (int d = 0; d < NDB; ++d)
#pragma unroll
            for (int g = 0; g < 4; ++g) { u32x2 w; w.x = pk2(o[d][4 * g] * inv, o[d][4 * g + 1] * inv); w.y = pk2(o[d][4 * g + 2] * inv, o[d][4 * g + 3] * inv);
                *(u32x2*)(orow + 32 * d + 8 * g) = w; }
    }
}

__device__ __forceinline__ void phase_attn_even(const Ctx& F, const Args& args, int L, bool want_ctx) {
    const bf16* P = (const bf16*)(F.ws + WS_P); const bf16* QM = (const bf16*)(F.ws + WS_QM); const bf16* KVM = (const bf16*)(F.ws + WS_KVM); bf16* O = (bf16*)(F.ws + WS_O);
    const int pr = L >> 1;
    const float lam_init = (L == 0) ? 0.2f : 0.47071302f;
    float lam;
    { const float* lp = args.in[15] + pr * 256; const float sa = wave_sum(lp[F.lane] * lp[64 + F.lane]), sb = wave_sum(lp[128 + F.lane] * lp[192 + F.lane]); lam = __expf(sa) - __expf(sb) + lam_init; }
    const float* subln = args.in[16] + pr * 128;
    const int n0 = 1024, n1 = 2048, n2 = want_ctx ? 128 : 0, n3 = want_ctx ? 256 : 0, ntot = n0 + n1 + n2 + n3;
    for (int u = F.vcu; u < ntot; u += F.G) {
        AttnP a; a.kb = nullptr; a.kbpitch = 0; a.tB0 = 0; a.nB = 0; a.rope_t0 = -1; a.mode = 0; a.lam = lam; a.post = 1.f - lam_init; a.subln = subln; a.na_row0 = 0;
        int cls, uu = u;
        if (uu < n0) cls = 0; else if ((uu -= n0) < n1) cls = 1; else if ((uu -= n1) < n2) cls = 2; else { uu -= n2; cls = 3; }
        if (cls == 0 || cls == 2) {
            int b, h, row0;
            if (cls == 0) { const int bh = uu >> 3, qb = uu & 7; b = bh >> 2; h = bh & 3; row0 = b * RPB + CTXL + 256 * qb; a.nA = 36; }
            else { b = uu >> 2; h = uu & 3; row0 = b * RPB; a.nA = 4; }
            const size_t base = (size_t)b * RPB;
            a.qpitch = PE; a.kapitch = PE; a.vpitch = PE; a.opitch = DM;
            a.v = P + base * PE + E_DV + h * 128; a.o = O + (size_t)row0 * DM + 512 + h * 128;
            for (int m = 0; m < 2; ++m) {
                a.q = P + (size_t)row0 * PE + E_DQ + h * 128 + m * 64; a.ka = P + base * PE + E_DK + h * 128 + m * 64; a.mode = 1 + m;
                attn_unit<64, 128, false>(a, F.lds, nullptr, F.tid);
            }
        } else {
            int b, h, row0;
            if (cls == 1) { const int bh = uu >> 3, qb = uu & 7; b = bh >> 3; h = bh & 7; row0 = b * RPB + CTXL + 256 * qb; a.nA = 36; a.rope_t0 = 256 * qb; }
            else { b = uu >> 3; h = uu & 7; row0 = b * RPB; a.nA = 4; }
            const size_t base = (size_t)b * RPB;
            a.q = QM + (size_t)row0 * 768 + h * 96; a.qpitch = 768; a.ka = KVM + base * 1024 + h * 128; a.kapitch = 1024; a.kb = P + base * PE + E_KR; a.kbpitch = PE;
            a.v = KVM + base * 1024 + h * 128 + 64; a.vpitch = 1024; a.o = O + (size_t)row0 * DM + h * 64; a.opitch = DM;
            attn_unit<96, 64, false>(a, F.lds, nullptr, F.tid);
        }
    }
}
__device__ __forceinline__ void phase_attn_odd(const Ctx& F, const Args& args, int L, bool want_ctx) {
    const bf16* P = (const bf16*)(F.ws + WS_P); bf16* O = (bf16*)(F.ws + WS_O);
    const int pr = L >> 1;
    const float* rpb = args.in[20] + (size_t)pr * 8 * 15 * 31;
    LAS float* biasT = (LAS float*)(F.lds + 98304);
    const int n0 = 1024, n1 = 2048, n2 = want_ctx ? 256 : 0, n3 = want_ctx ? 256 : 0, ntot = n0 + n1 + n2 + n3;
    for (int u = F.vcu; u < ntot; u += F.G) {
        if (u < n0) {
            const int qb = u & 7, bhp = u >> 3, pair = bhp & 1, hkv = (bhp >> 1) & 1, b = bhp >> 2; const int hA = 4 * hkv + 2 * pair;
            const int row0 = b * RPB + CTXL + 256 * qb; const size_t base = (size_t)b * RPB;
            AttnP2 a2; a2.qA = P + (size_t)row0 * PO + hA * 64; a2.qB = a2.qA + 64; a2.qpitch = PO; a2.ka = P + base * PO + O_GK + hkv * 64; a2.kapitch = PO; a2.v = P + base * PO + O_GV + hkv * 64; a2.vpitch = PO;
            a2.oA = O + (size_t)row0 * DM + hA * 64; a2.oB = a2.oA + 64; a2.opitch = DM; a2.ntile = 36;
            attn_unit_gqa2(a2, F.lds, F.tid);
            continue;
        }
        AttnP a; a.kb = nullptr; a.kbpitch = 0; a.tB0 = 0; a.nB = 0; a.rope_t0 = -1; a.mode = 0; a.lam = 0.f; a.post = 1.f; a.subln = nullptr; a.na_row0 = 0;
        a.qpitch = PO; a.kapitch = PO; a.vpitch = PO; a.opitch = DM;
        int cls, uu = u - n0;
        if (uu < n1) cls = 1; else if ((uu -= n1) < n2) cls = 2; else { uu -= n2; cls = 3; }
        int b, h, row0, qb = 0;
        if (cls < 2) { const int bh = uu >> 3; qb = uu & 7; b = bh >> 3; h = bh & 7; row0 = b * RPB + CTXL + 256 * qb; }
        else { b = uu >> 3; h = uu & 7; row0 = b * RPB; }
        const size_t base = (size_t)b * RPB;
        if (cls == 0 || cls == 2) {
            a.q = P + (size_t)row0 * PO + h * 64; a.ka = P + base * PO + O_GK + (h >> 2) * 64; a.v = P + base * PO + O_GV + (h >> 2) * 64; a.o = O + (size_t)row0 * DM + h * 64;
            a.nA = (cls == 0) ? 36 : 4;
            attn_unit<64, 64, false>(a, F.lds, nullptr, F.tid);
        } else {
            a.q = P + (size_t)row0 * PO + O_NQ + h * 64; a.ka = P + base * PO + O_NK + h * 64; a.v = P + base * PO + O_NV + h * 64; a.o = O + (size_t)row0 * DM + 512 + h * 64;
            a.nA = 4;
            if (cls == 1) {
                const int rlo = 4 * qb, rmin = min(max(rlo - 4, 0), 24), rmax = min(max(rlo + 3 - 4, 0), 24) + 7;
                a.tB0 = 4 + rmin; a.nB = rmax - rmin + 1; a.na_row0 = rlo;
                int tl_ = F.tid; asm volatile("" : "+v"(tl_));
                for (int e = tl_; e < 704; e += NTHR) { const int j = e - 64, rr = j >> 5, cc = j & 31; biasT[e] = (j >= 0 && j < 15 * 32 && cc < 31) ? rpb[(h * 15 + rr) * 31 + cc] * LOG2E : 0.f; }
                attn_unit<64, 64, true>(a, F.lds, biasT, tl_);
            } else {
                attn_unit<64, 64, false>(a, F.lds, nullptr, F.tid);
            }
        }
    }
}

constexpr int N_PHASES = 2 + 9 * DEPTH;
#ifndef REP_A0
#define REP_A0 1
#endif
#ifndef REP_SYNC
#define REP_SYNC 1
#endif
#ifndef REP_PRO
#define REP_PRO 1
#endif
#ifndef REP_ATTN
#define REP_ATTN 1
#endif
#ifndef REP_GEMM
#define REP_GEMM 1
#endif
#ifndef EN_PRO
#define EN_PRO 1
#endif
#ifndef EN_ROW
#define EN_ROW 1
#endif
#ifndef EN_PREP
#define EN_PREP 1
#endif
#ifndef EN_AE
#define EN_AE 1
#endif
#ifndef EN_AO
#define EN_AO 1
#endif
#ifndef EN_GEMM
#define EN_GEMM 1
#endif
__global__ void __launch_bounds__(NTHR, 2) fwd_kernel(Args args) {
    extern __shared__ __attribute__((aligned(16))) unsigned char lds_raw[];
    cg::grid_group grid = cg::this_grid();
    Ctx F;
    F.lds = (LAS unsigned char*)lds_raw;
    F.G = gridDim.x; { const int bx = blockIdx.x; F.vcu = (F.G % 8 == 0) ? (bx % 8) * (F.G / 8) + bx / 8 : bx; }
    F.out = args.out; F.ws = args.ws;
    const int lo = args.ph_lo, hi = args.ph_hi;
    volatile LAS unsigned* barst = (volatile LAS unsigned*)(F.lds + LDS_BARST);
    if (threadIdx.x == 0) { barst[0] = 0u; barst[1] = 0u; }
    __syncthreads();
    unsigned* barw = (unsigned*)(F.ws + WS_BAR);
    XcdBarrier xbar; xbar.bar = barw; xbar.x = 0; xbar.st = barst;
    int nsync = 0;
    for (int ph = lo; ph < hi; ++ph) {
        { int t_ = threadIdx.x; asm volatile("" : "+v"(t_)); F.tid = t_; F.lane = t_ & 63; F.wave = __builtin_amdgcn_readfirstlane(t_ >> 6); }
        float* MOD = (float*)(F.ws + WS_MOD); bf16* AF = (bf16*)(F.ws + WS_AF);
        const float* normg = args.in[6];
        const int L = (ph < 2) ? 0 : (ph - 2) / 9, k = (ph < 2) ? -1 : (ph - 2) % 9;
        const bool even = (L & 1) == 0, want_ctx = L < DEPTH - 1;
        unsigned char* wl = F.ws + WS_WT + (size_t)L * WL_STRIDE;
        if (ph == lo && hi - lo > 1 && blockIdx.x == 0) { for (int w_ = threadIdx.x; w_ < XCD_BAR_WORDS; w_ += NTHR) barw[w_] = 0u; }
        if (ph == 0) { for (int rep_ = 0; rep_ < REP_PRO; ++rep_) { if (EN_PRO) phase_prologue_a(F, args); __syncthreads(); } }
        else if (ph == 1 || k == 5 || k == 8) {
            const float* modL = MOD + (size_t)L * 33 * 6144;
            RowPassP p;
            bf16* HB = (bf16*)(F.ws + WS_HB); bf16* HCB = (bf16*)(F.ws + WS_HCB);
            p.Adst = AF; p.Fsrc = AF; p.hb_lat = HB; p.hb_ctx = HCB; p.out32 = F.out; p.final32 = 0; p.hin_lat = HB; p.hin_ctx = HCB;
            bool hin32 = false;
            if (ph == 1) { p.hin_lat = args.in[0]; p.hin_ctx = args.in[2]; hin32 = true; p.g_post = normg; p.g_pre = normg; p.mod_post = MOD; p.mod_pre = MOD;
                p.gate_chunk = 0; p.shift_chunk = 0; p.scale_chunk = 1; p.has_f = 0; p.write_h = 0; p.write_a = 1; p.skip_ctx = 0; }
            else if (k == 5) { if (L == 0) { p.hin_lat = args.in[0]; p.hin_ctx = args.in[2]; hin32 = true; } p.Fsrc = (const bf16*)(F.ws + WS_F1); p.g_post = normg + (L * 4 + 1) * DM; p.g_pre = normg + (L * 4 + 2) * DM;
                p.mod_post = modL; p.mod_pre = modL; p.gate_chunk = 2; p.shift_chunk = 3; p.scale_chunk = 4; p.has_f = 1; p.write_h = 1; p.write_a = 1; p.skip_ctx = want_ctx ? 0 : 1; }
            else { const int Ln = (L + 1 < DEPTH) ? L + 1 : L;
                p.g_post = normg + (L * 4 + 3) * DM; p.g_pre = normg + (Ln * 4 + 0) * DM; p.mod_post = modL; p.mod_pre = MOD + (size_t)Ln * 33 * 6144;
                p.gate_chunk = 5; p.shift_chunk = 0; p.scale_chunk = 1; p.has_f = 1; p.write_h = 1; p.write_a = want_ctx ? 1 : 0; p.skip_ctx = want_ctx ? 0 : 1; p.final32 = want_ctx ? 0 : 1; }
            if (EN_ROW) {
                if (ph == 1) { for (int rep_ = 0; rep_ < REP_A0; ++rep_) { phase_rowpass<true, false, false, true, false>(F, p); __syncthreads(); } }
                else if (hin32) phase_rowpass<true, true, true, true, false>(F, p);
                else if (p.final32) phase_rowpass<false, true, false, false, true>(F, p);
                else phase_rowpass<false, true, true, true, false>(F, p);
            }
        }
        else if (k == 1) { if (EN_PREP) { if (even) phase_prep_even(F); else phase_prep_odd(F, args.in[19] + (L >> 1) * 128); } }
        else if (k == 3) { for (int rep_ = 0; rep_ < REP_ATTN; ++rep_) { if (even) { if (EN_AE) phase_attn_even(F, args, L, want_ctx); } else { if (EN_AO) phase_attn_odd(F, args, L, want_ctx); } } }
        else {
            const int ng = (k == 2) ? (even ? 2 : 0) : 1;
            for (int gi_ = 0; gi_ < ng * REP_GEMM; ++gi_) { const int gi = gi_ % ng;
                pg8::Gemm g; pg8::EpiStore E; E.act = 0;
                g.M = MROWS;
                if (k == 0) { g.A = AF; g.Bt = (const bf16*)(wl + WL_IN); g.N = even ? PE : PO; g.K = DM; g.lda = DM; E.O = (bf16*)(F.ws + WS_P); E.ldc = g.N; }
                else if (k == 2) {
                    if (gi == 0) { g.A = AF; g.Bt = (const bf16*)(wl + WL_UQ); g.N = 768; g.K = 256; g.lda = 256; E.O = (bf16*)(F.ws + WS_QM); E.ldc = 768; }
                    else { g.A = (const bf16*)(F.ws + WS_AF + 36 * MiB); g.Bt = (const bf16*)(wl + WL_UKV); g.N = 1024; g.K = 128; g.lda = 128; E.O = (bf16*)(F.ws + WS_KVM); E.ldc = 1024; } }
                else if (k == 4) { g.A = (const bf16*)(F.ws + WS_O); g.Bt = (const bf16*)(wl + WL_OUT); g.N = DM; g.K = DM; g.lda = DM; E.O = (bf16*)(F.ws + WS_F1); E.ldc = DM; }
                else if (k == 6) { g.A = AF; g.Bt = (const bf16*)(wl + WL_FF1); g.N = DFF; g.K = DM; g.lda = DM; E.O = (bf16*)(F.ws + WS_H); E.ldc = DFF; E.act = 1; }
                else { g.A = (const bf16*)(F.ws + WS_H); g.Bt = (const bf16*)(wl + WL_FF2); g.N = DM; g.K = DFF; g.lda = DFF; E.O = AF; E.ldc = DM; }
                const int skipc = (L == DEPTH - 1 && k >= 4) ? 1 : 0;
                pg8::StaticOrder S; S.init(MROWS, g.N, F.G, (int)blockIdx.x, skipc); S.rev = (k == 7) ? 1 : 0;
                if (EN_GEMM) pg8::gemm_phase<pg8::EpiStore, pg8::StaticOrder, true, true>(F.lds, g, S, E);
            }
        }
        if (ph + 1 < hi) {
            for (int s_ = 0; s_ < REP_SYNC; ++s_) {
                if (nsync == 0) { grid.sync(); xbar = xcd_barrier_post(barw, barst); }
                else xcd_barrier(xbar);
                ++nsync;
            }
        }
    }
}

#ifndef SINGLE_LAUNCH
#define SINGLE_LAUNCH 1
#endif
extern "C" void kernel_launch(void* const* d_in, const int* in_sizes, int n_in, void* d_out, int out_size, void* d_ws, size_t ws_size, hipStream_t stream) {
    static int grid = 0;
    if (grid == 0) {
        if (n_in != 21 || out_size != NB * SEQ * DM || ws_size < WS_END) { fprintf(stderr, "kernel_launch: unexpected problem (n_in %d, out %d, ws %zu)\n", n_in, out_size, ws_size); grid = -1; return; }
        int dev = 0, cus = 0, per_cu = 0;
        hipGetDevice(&dev); hipDeviceGetAttribute(&cus, hipDeviceAttributeMultiprocessorCount, dev);
        hipFuncSetAttribute((const void*)fwd_kernel, hipFuncAttributeMaxDynamicSharedMemorySize, LDS_BYTES);
        hipOccupancyMaxActiveBlocksPerMultiprocessor(&per_cu, (const void*)fwd_kernel, NTHR, LDS_BYTES);
        if (per_cu < 1) per_cu = 1;
        grid = cus;
        (void)hipGetLastError();
    }
    if (grid < 0) return;
    Args a{};
    for (int i = 0; i < 21; ++i) a.in[i] = (const float*)d_in[i];
    a.out = (float*)d_out; a.ws = (unsigned char*)d_ws;
#if SINGLE_LAUNCH
    a.ph_lo = 0; a.ph_hi = N_PHASES;
    void* kargs[] = {&a};
    hipError_t e = hipLaunchCooperativeKernel((const void*)fwd_kernel, dim3(grid), dim3(NTHR), kargs, LDS_BYTES, stream);
    if (e != hipSuccess) fprintf(stderr, "cooperative launch failed: %s (grid %d)\n", hipGetErrorString(e), grid);
#else
    for (int ph = 0; ph < N_PHASES; ++ph) {
        if (ph >= 2) { const int L = (ph - 2) / 9, k = (ph - 2) % 9; if (k == 2 && (L & 1)) continue; }
        a.ph_lo = ph; a.ph_hi = ph + 1;
        hipLaunchKernelGGL(fwd_kernel, dim3(grid), dim3(NTHR), LDS_BYTES, stream, a);
    }
#endif
}
```

```cpp
#include <hip/hip_runtime.h>
#include <hip/hip_cooperative_groups.h>
#include <cstdio>
#include <cstdint>
namespace cg = cooperative_groups;
namespace pg8 {
#define PG8_LAS __attribute__((address_space(3)))
typedef unsigned short bf16_t;
typedef short bf16x8 __attribute__((ext_vector_type(8)));
typedef float f32x4 __attribute__((ext_vector_type(4)));
typedef unsigned u32x4 __attribute__((ext_vector_type(4)));
constexpr int BM = 256, BK = 64, HALF = 128, HTB = HALF * BK * 2  , STAGE_BYTES = 8 * HTB, NXCD = 8, WGM = 8;

__host__ __device__ __forceinline__ int lds_byte(int r, int c) { const int st = (r >> 4) * 2 + (c >> 5), rr = r & 15, cc = c & 31, ob = rr * 64 + cc * 2; return st * 1024 + (ob ^ (((ob >> 9) & 1) << 5)); }
__host__ __device__ __forceinline__ void stage_rc(int b, int& R, int& C) { const int st = b / 1024, sb = b % 1024, swz = sb ^ (((sb >> 9) & 1) << 5); R = (st >> 1) * 16 + swz / 64; C = (st & 1) * 32 + (swz % 64) / 2; }
__host__ __device__ __forceinline__ int perm32(int rho) { const int n = rho >> 4, i = rho & 15; return 8 * (i >> 2) + 4 * n + (i & 3); }

struct Unit { int pm, pn; };
struct Gemm { const bf16_t* A; const bf16_t* Bt; int M, N, K, lda; };

struct StaticOrder {
    int rev;
    int nM, nN, nwg, G, c, skipc;
    __host__ __device__ void init(int M, int N, int G_, int c_, int skipc_ = 0) { nM = M / BM; if (skipc_) nM = nM / 9 * 8; nN = N / BM; nwg = nM * nN; G = G_; c = c_; skipc = skipc_; rev = 0; }
    __host__ __device__ bool next(int i, Unit& u) const {
        const long L = (long)i * G + c; if (L >= nwg) return false;
        int wgid = (int)L; { const int q = nwg / NXCD, r = nwg % NXCD, xcd = wgid % NXCD, off = wgid / NXCD; wgid = (xcd < r ? xcd * (q + 1) : r * (q + 1) + (xcd - r) * q) + off; }
        const int nig = WGM * nN, gid = wgid / nig, fm = gid * WGM, gsz = (nM - fm) < WGM ? (nM - fm) : WGM;
        u.pm = fm + ((wgid % nig) % gsz); u.pn = (wgid % nig) / gsz; if (rev) u.pm = nM - 1 - u.pm; if (skipc) u.pm = u.pm + u.pm / 8 + 1; return true;
    }
    __device__ __forceinline__ void a_ready(const Unit&) const {}
    __device__ __forceinline__ void done(const Unit&) const {}
};

__device__ __forceinline__ unsigned cvt_pk_bf16(float lo, float hi) { unsigned r; asm volatile("v_cvt_pk_bf16_f32 %0, %1, %2" : "=v"(r) : "v"(lo), "v"(hi)); return r; }
template <class Epi, class Sched, bool ALIGN_EPI = false, bool SP2 = false>
__device__ __forceinline__ void gemm_phase(PG8_LAS unsigned char* lds, const Gemm g, const Sched& S, const Epi& E) {
    int tid_ = threadIdx.x; asm volatile("" : "+v"(tid_));
    const int tid = tid_, wid = __builtin_amdgcn_readfirstlane(tid >> 6), lane = tid & 63, wr = wid >> 2, wc = wid & 3, fr = lane & 15, fq = lane >> 4;
    const int K = g.K, nt = K / BK;
    unsigned voffA[2], voffB[2];
#pragma unroll
    for (int i = 0; i < 2; ++i) { int R, C; stage_rc(tid * 16 + i * 8192, R, C); const int Rb = Epi::PERM ? ((R & ~31) + perm32(R & 31)) : R;
        voffA[i] = (unsigned)(R * g.lda + C) * 2u; voffB[i] = (unsigned)(Rb * K + C) * 2u; }
    const size_t kstep = (size_t)(BK * 2);
    const size_t hstep = (size_t)HALF * K * 2, hstepA = (size_t)HALF * g.lda * 2;
    const size_t tstep = 2 * hstep, tstepA = 2 * hstepA;
    const unsigned ldsw = (unsigned)wid * 1024u;
    const int aoff = lds_byte(wr * 64 + fr, fq * 8), boff = lds_byte(wc * 32 + fr, fq * 8);
#define PG8_SA(b, h) (((b) * 2 + (h)) * HTB)
#define PG8_SB(b, h) ((4 + (b) * 2 + (h)) * HTB)
#define PG8_STAGE(bufoff, gbase, voff) do { _Pragma("unroll") for (int _i = 0; _i < 2; ++_i) \
        __builtin_amdgcn_global_load_lds((const unsigned*)((const char*)(gbase) + (voff)[_i]), (PG8_LAS unsigned*)(lds + (bufoff) + ldsw + _i * 8192), 16, 0, 0); } while (0)
#define PG8_LDA(dst, b, h) do { _Pragma("unroll") for (int m = 0; m < 4; ++m) _Pragma("unroll") for (int k = 0; k < 2; ++k) dst[m][k] = *(const PG8_LAS bf16x8*)(lds + PG8_SA(b, h) + aoff + m * 2048 + k * 1024); } while (0)
#define PG8_LDB(dst, b, h) do { _Pragma("unroll") for (int n = 0; n < 2; ++n) _Pragma("unroll") for (int k = 0; k < 2; ++k) dst[n][k] = *(const PG8_LAS bf16x8*)(lds + PG8_SB(b, h) + boff + n * 2048 + k * 1024); } while (0)
#define PG8_MMA(ai, bj, At, Bt) do { __builtin_amdgcn_s_setprio(1); _Pragma("unroll") for (int m = 0; m < 4; ++m) _Pragma("unroll") for (int n = 0; n < 2; ++n) _Pragma("unroll") for (int k = 0; k < 2; ++k) \
        acc[ai][bj][m][n] = __builtin_amdgcn_mfma_f32_16x16x32_bf16(Bt[n][k], At[m][k], acc[ai][bj][m][n], 0, 0, 0); __builtin_amdgcn_s_setprio(0); } while (0)
#define PG8_WAIT_V(n) asm volatile("s_waitcnt vmcnt(" #n ")" ::: "memory")
#define PG8_WAIT_L(n) asm volatile("s_waitcnt lgkmcnt(" #n ")" ::: "memory")
#define PG8_BAR __builtin_amdgcn_s_barrier()
#define PG8_SCHED __builtin_amdgcn_sched_barrier(0)
    Unit cur, nxt; int ui = 0;
    if (!S.next(0, cur)) return;
    f32x4 acc[2][2][4][2];
#pragma unroll
    for (int a = 0; a < 2; ++a)
#pragma unroll
        for (int b = 0; b < 2; ++b)
#pragma unroll
            for (int m = 0; m < 4; ++m)
#pragma unroll
                for (int n = 0; n < 2; ++n) acc[a][b][m][n] = (f32x4){0.f, 0.f, 0.f, 0.f};
    bf16x8 At[4][2], B0[2][2], B1[2][2];
    const char* cA = (const char*)g.A + (size_t)cur.pm * tstepA; const char* cB = (const char*)g.Bt + (size_t)cur.pn * tstep;
    S.a_ready(cur);
    if constexpr (SP2) {
        PG8_STAGE(PG8_SB(0, 0), cB, voffB); PG8_STAGE(PG8_SB(0, 1), cB + hstep, voffB); PG8_STAGE(PG8_SA(0, 0), cA, voffA); PG8_STAGE(PG8_SA(0, 1), cA + hstepA, voffA);
        if (wr == 1) PG8_BAR;
        PG8_WAIT_V(2); PG8_BAR;
        PG8_STAGE(PG8_SB(1, 0), cB + kstep, voffB); PG8_STAGE(PG8_SA(1, 0), cA + kstep, voffA); PG8_STAGE(PG8_SB(1, 1), cB + hstep + kstep, voffB);
        PG8_WAIT_V(6); PG8_BAR;
    } else {
        PG8_STAGE(PG8_SB(0, 0), cB, voffB); PG8_STAGE(PG8_SA(0, 0), cA, voffA); PG8_STAGE(PG8_SB(0, 1), cB + hstep, voffB); PG8_STAGE(PG8_SA(0, 1), cA + hstepA, voffA);
        if (wr == 1) PG8_BAR;
        PG8_WAIT_V(4); PG8_BAR;
        PG8_STAGE(PG8_SB(1, 0), cB + kstep, voffB); PG8_STAGE(PG8_SA(1, 0), cA + kstep, voffA); PG8_STAGE(PG8_SB(1, 1), cB + hstep + kstep, voffB);
        PG8_WAIT_V(6); PG8_BAR;
    }
    for (;;) {
        const bool has_next = S.next(ui + 1, nxt);
        const char* nA = has_next ? (const char*)g.A + (size_t)nxt.pm * tstepA : cA; const char* nB = has_next ? (const char*)g.Bt + (size_t)nxt.pn * tstep : cB;
        for (int t = 0; t < nt; t += 2) {
            const bool last = (t == nt - 2);
            const char* a1 = cA + (size_t)(t + 1) * kstep;
            const char* a2 = last ? nA : cA + (size_t)(t + 2) * kstep; const char* b2 = last ? nB : cB + (size_t)(t + 2) * kstep;
            const char* a3 = a2 + kstep; const char* b3 = b2 + kstep;
            if (last && has_next) S.a_ready(nxt);
            if constexpr (SP2) {
            PG8_LDB(B0, 0, 0); PG8_LDB(B1, 0, 1); PG8_SCHED; PG8_LDA(At, 0, 0); PG8_STAGE(PG8_SA(1, 1), a1 + hstepA, voffA);
            PG8_WAIT_V(8); PG8_WAIT_L(0); PG8_BAR; PG8_MMA(0, 0, At, B0); PG8_MMA(0, 1, At, B1); PG8_BAR; PG8_SCHED;
            PG8_LDA(At, 0, 1); PG8_STAGE(PG8_SB(0, 0), b2, voffB); PG8_STAGE(PG8_SB(0, 1), b2 + hstep, voffB); PG8_STAGE(PG8_SA(0, 0), a2, voffA);
            PG8_WAIT_V(8); PG8_WAIT_L(0); PG8_BAR; PG8_MMA(1, 0, At, B0); PG8_MMA(1, 1, At, B1); PG8_BAR; PG8_SCHED;
            PG8_LDB(B0, 1, 0); PG8_LDB(B1, 1, 1); PG8_SCHED; PG8_LDA(At, 1, 0); PG8_STAGE(PG8_SA(0, 1), a2 + hstepA, voffA);
            PG8_WAIT_V(8); PG8_WAIT_L(0); PG8_BAR; PG8_MMA(0, 0, At, B0); PG8_MMA(0, 1, At, B1); PG8_BAR; PG8_SCHED;
            PG8_LDA(At, 1, 1); PG8_STAGE(PG8_SB(1, 0), b3, voffB); PG8_STAGE(PG8_SB(1, 1), b3 + hstep, voffB); PG8_STAGE(PG8_SA(1, 0), a3, voffA);
            PG8_WAIT_V(8); PG8_WAIT_L(0); PG8_BAR; PG8_MMA(1, 0, At, B0); PG8_MMA(1, 1, At, B1); PG8_BAR; PG8_SCHED;
            } else {
            PG8_LDB(B0, 0, 0); PG8_SCHED; PG8_LDA(At, 0, 0); PG8_STAGE(PG8_SA(1, 1), a1 + hstepA, voffA);
            PG8_WAIT_L(8); PG8_BAR; PG8_WAIT_L(0); PG8_MMA(0, 0, At, B0); PG8_BAR; PG8_SCHED;
            PG8_LDB(B1, 0, 1); PG8_STAGE(PG8_SB(0, 0), b2, voffB);
            PG8_BAR; PG8_WAIT_L(0); PG8_MMA(0, 1, At, B1); PG8_BAR;
            PG8_LDA(At, 0, 1); PG8_STAGE(PG8_SA(0, 0), a2, voffA);
            PG8_BAR; PG8_WAIT_L(0); PG8_MMA(1, 0, At, B0); PG8_BAR; PG8_SCHED;
            PG8_STAGE(PG8_SB(0, 1), b2 + hstep, voffB);
            PG8_WAIT_V(6); PG8_BAR; PG8_MMA(1, 1, At, B1); PG8_BAR;
            PG8_LDB(B0, 1, 0); PG8_SCHED; PG8_LDA(At, 1, 0); PG8_STAGE(PG8_SA(0, 1), a2 + hstepA, voffA);
            PG8_WAIT_L(8); PG8_BAR; PG8_WAIT_L(0); PG8_MMA(0, 0, At, B0); PG8_BAR; PG8_SCHED;
            PG8_LDB(B1, 1, 1); PG8_STAGE(PG8_SB(1, 0), b3, voffB);
            PG8_BAR; PG8_WAIT_L(0); PG8_MMA(0, 1, At, B1); PG8_BAR;
            PG8_LDA(At, 1, 1); PG8_STAGE(PG8_SA(1, 0), a3, voffA);
            PG8_BAR; PG8_WAIT_L(0); PG8_MMA(1, 0, At, B0); PG8_BAR; PG8_SCHED;
            PG8_STAGE(PG8_SB(1, 1), b3 + hstep, voffB);
            PG8_WAIT_V(6); PG8_BAR; PG8_MMA(1, 1, At, B1); PG8_BAR;
            }
        }
        if constexpr (ALIGN_EPI) { if (wr == 0) PG8_BAR; }
        if constexpr (!Epi::AFTER_DRAIN) { E(acc, cur, wr, wc, fr, fq); S.done(cur); }
        if (!has_next) break;
#pragma unroll
        for (int a = 0; a < 2; ++a)
#pragma unroll
            for (int b = 0; b < 2; ++b)
#pragma unroll
                for (int m = 0; m < 4; ++m)
#pragma unroll
                    for (int n = 0; n < 2; ++n) acc[a][b][m][n] = (f32x4){0.f, 0.f, 0.f, 0.f};
        cur = nxt; cA = nA; cB = nB; ++ui;
        if constexpr (ALIGN_EPI) { if (wr == 1) PG8_BAR; }
    }
    PG8_WAIT_V(0);
    if constexpr (!ALIGN_EPI) { if (wr == 0) PG8_BAR; }
    PG8_BAR;
    if constexpr (Epi::AFTER_DRAIN) { E.fused(acc, cur, wr, wc, fr, fq, lds, wid, lane); S.done(cur); }
#undef PG8_SA
#undef PG8_SB
#undef PG8_STAGE
#undef PG8_LDA
#undef PG8_LDB
#undef PG8_MMA
#undef PG8_WAIT_V
#undef PG8_WAIT_L
#undef PG8_BAR
#undef PG8_SCHED
}
}
namespace pg8 {
struct EpiStore {
    static constexpr bool PERM = true, AFTER_DRAIN = false;
    bf16_t* O; int ldc; int act;
    __device__ __forceinline__ void operator()(const f32x4 (&acc)[2][2][4][2], const Unit& u, int wr, int wc, int fr, int fq) const {
        const int row0 = u.pm * BM + wr * 64 + fr; const int col0 = u.pn * BM + wc * 32 + 8 * fq;
#pragma unroll
        for (int ai = 0; ai < 2; ++ai)
#pragma unroll
            for (int m = 0; m < 4; ++m) { bf16_t* rowp = O + (size_t)(row0 + ai * HALF + m * 16) * ldc + col0;
#pragma unroll
                for (int bj = 0; bj < 2; ++bj) { f32x4 v0 = acc[ai][bj][m][0], v1 = acc[ai][bj][m][1];
                    if (act == 1) {
#pragma unroll
                        for (int e = 0; e < 4; ++e) { float a = fmaxf(v0[e], 0.f), b = fmaxf(v1[e], 0.f); v0[e] = a * a; v1[e] = b * b; } }
                    u32x4 w; w.x = cvt_pk_bf16(v0[0], v0[1]); w.y = cvt_pk_bf16(v0[2], v0[3]); w.z = cvt_pk_bf16(v1[0], v1[1]); w.w = cvt_pk_bf16(v1[2], v1[3]);
                    *(u32x4*)(rowp + bj * HALF) = w; } }
    }
};
}
#define LAS __attribute__((address_space(3)))
#define GAS __attribute__((address_space(1)))
typedef unsigned v4u __attribute__((ext_vector_type(4)));
typedef GAS unsigned gu32;
typedef GAS unsigned long long gu64;
#define RLX_AGENT __ATOMIC_RELAXED, __HIP_MEMORY_SCOPE_AGENT
#define LDS_WAIT() asm volatile("s_waitcnt lgkmcnt(0)" ::: "memory")
#define VM_WAIT() asm volatile("s_waitcnt vmcnt(0)" ::: "memory")
__device__ __forceinline__ unsigned long long rt() { return __builtin_amdgcn_s_memrealtime(); }
#define XB_TMO      128
#define XB_XCNT(j)  (256  + 64 * (j))
#define XB_XSUB(j)  (1280 + 64 * (j))
#define XB_XGEN(j)  (2304 + 64 * (j))
#define XB_TOP      3328
#define XB_TOPGEN   3392
#define XCD_BAR_WORDS 3456
#define XB_SPIN_CAP (1u << 22)

__device__ __forceinline__ unsigned xb_ld(unsigned* p)              { return __hip_atomic_load(p, __ATOMIC_RELAXED, __HIP_MEMORY_SCOPE_AGENT); }
__device__ __forceinline__ unsigned xb_add(unsigned* p, unsigned v) { return __hip_atomic_fetch_add(p, v, __ATOMIC_RELAXED, __HIP_MEMORY_SCOPE_AGENT); }
__device__ __forceinline__ unsigned xb_xcc_id() { return (unsigned)__builtin_amdgcn_s_getreg((3 << 11) | 20) & 0xFu; }
#define XB_SPIN(cond, bar) do { unsigned _sp = 0; while (cond) { __builtin_amdgcn_s_sleep(1); \
    if ((++_sp & 255u) == 0u) { if (xb_ld(&(bar)[XB_TMO])) break; if (_sp > XB_SPIN_CAP) { atomicAdd(&(bar)[XB_TMO], 1u); break; } } } } while (0)

struct XcdBarrier {
    unsigned* bar; unsigned x;
    volatile LAS unsigned* st;
};

__device__ __forceinline__ XcdBarrier xcd_barrier_post(unsigned* bar, volatile LAS unsigned* st) {
    XcdBarrier b; b.bar = bar; b.x = xb_xcc_id(); b.st = st;
    if (threadIdx.x == 0) (void)xb_add(&bar[XB_XCNT(b.x)], 1u);
    return b;
}
__device__ __forceinline__ void xcd_barrier_complete(unsigned* bar, unsigned x, unsigned& nloc, unsigned& nx) {
    const unsigned G = gridDim.x * gridDim.y * gridDim.z;
    unsigned sum, cnt, mine, sp = 0u;
    for (;;) {
        sum = 0u; cnt = 0u; mine = 0u;
#pragma unroll
        for (unsigned j = 0; j < 16; ++j) { const unsigned c = xb_ld(&bar[XB_XCNT(j)]); sum += c; cnt += (c > 0u) ? 1u : 0u; mine = (j == x) ? c : mine; }
        if (sum == G) break;
        __builtin_amdgcn_s_sleep(1);
        if ((++sp & 255u) == 0u) { if (xb_ld(&bar[XB_TMO])) break; if (sp > XB_SPIN_CAP) { atomicAdd(&bar[XB_TMO], 1u); break; } }
    }
    nloc = mine > 0u ? mine : 1u; nx = cnt > 0u ? cnt : 1u;
}

__device__ __forceinline__ void xcd_barrier(const XcdBarrier& b) {
    asm volatile("s_waitcnt vmcnt(0)" ::: "memory");
    __syncthreads();
    if (threadIdx.x == 0) {
        unsigned* bar = b.bar;
        __builtin_amdgcn_s_waitcnt(0);
        unsigned nloc = b.st[0], nx = b.st[1];
        if (nloc == 0u) { xcd_barrier_complete(bar, b.x, nloc, nx); b.st[0] = nloc; b.st[1] = nx; }
        const unsigned old = xb_add(&bar[XB_XSUB(b.x)], 1u);
        const unsigned gen = old / nloc;
        if (old + 1u == (gen + 1u) * nloc) {
            __builtin_amdgcn_fence(__ATOMIC_RELEASE, "agent");
            asm volatile("s_waitcnt vmcnt(0)" ::: "memory");
            const unsigned og = xb_add(&bar[XB_TOP], 1u);
            const unsigned tg = og / nx;
            if (og + 1u == (tg + 1u) * nx) xb_add(&bar[XB_TOPGEN], 1u);
            else XB_SPIN(xb_ld(&bar[XB_TOPGEN]) == tg, bar);
            __builtin_amdgcn_fence(__ATOMIC_ACQUIRE, "agent");
            xb_add(&bar[XB_XGEN(b.x)], 1u);
            asm volatile("s_waitcnt vmcnt(0)" ::: "memory");
        } else {
            XB_SPIN(xb_ld(&bar[XB_XGEN(b.x)]) == gen, bar);
            __builtin_amdgcn_fence(__ATOMIC_ACQUIRE, "agent");
            asm volatile("s_waitcnt vmcnt(0)" ::: "memory");
        }
    }
    __syncthreads();
}

typedef unsigned short bf16;
typedef short bf16x8 __attribute__((ext_vector_type(8)));
typedef short s16x4 __attribute__((ext_vector_type(4)));
typedef float f32x4 __attribute__((ext_vector_type(4)));
typedef float f32x16 __attribute__((ext_vector_type(16)));
typedef unsigned u32x4 __attribute__((ext_vector_type(4)));
typedef unsigned u32x2 __attribute__((ext_vector_type(2)));

constexpr int DM = 1024, NB = 32, SEQ = 2048, CTXL = 256, RPB = SEQ + CTXL, MROWS = NB * RPB;
constexpr int DFF = 4096, DEPTH = 4, NWAVES = 8, NTHR = 512;
constexpr int PE = 2048, PO = 2304;
constexpr int E_CKV = 256, E_KR = 384, E_DQ = 416, E_DK = 928, E_DV = 1440;
constexpr int O_GK = 512, O_GV = 640, O_NQ = 768, O_NK = 1280, O_NV = 1792;
constexpr float EPSN = 1e-6f, LOG2E = 1.4426950408889634f, LOG2_THETA = 13.287712379549449f;
constexpr float MLA_SC = 0.10206207261596575f  , HD_SC = 0.125f;

constexpr size_t MiB = 1u << 20;
constexpr size_t WS_MOD = 0;
constexpr size_t WS_HB = 852 * MiB;
constexpr size_t WS_HCB = 980 * MiB;
constexpr size_t WS_WT = 36 * MiB;
constexpr size_t WS_AF = 132 * MiB;
constexpr size_t WS_P = 276 * MiB;
constexpr size_t WS_QM = 600 * MiB;
constexpr size_t WS_KVM = 708 * MiB;
constexpr size_t WS_O = WS_AF;
constexpr size_t WS_F1 = WS_P;
constexpr size_t WS_END = 996 * MiB;
constexpr size_t WS_H = WS_P;
constexpr size_t WL_STRIDE = 24 * MiB, WL_IN = 0, WL_OUT = 5 * MiB, WL_FF1 = 7 * MiB, WL_FF2 = 15 * MiB, WL_UQ = 23 * MiB, WL_UKV = 23 * MiB + 512 * 1024;
static_assert(WS_H + (size_t)MROWS * DFF * 2 <= WS_HB, "H overlay");
constexpr int LDS_BYTES = 147456, LDS_BARST = 147200;
constexpr size_t WS_BAR = 3 * MiB + 512 * 1024;

struct Args { const float* in[21]; float* out; unsigned char* ws; int ph_lo, ph_hi; };

__device__ __forceinline__ float bf2f(unsigned short b) { return __uint_as_float((unsigned)b << 16); }
typedef float f32x2_t __attribute__((ext_vector_type(2))); typedef __bf16 bf16x2_t __attribute__((ext_vector_type(2)));
__device__ __forceinline__ unsigned pk2(float lo, float hi) { f32x2_t v = {lo, hi}; bf16x2_t b = __builtin_convertvector(v, bf16x2_t); return __builtin_bit_cast(unsigned, b); }
__device__ __forceinline__ unsigned short f2bf(float f) { return (unsigned short)(pk2(f, 0.f) & 0xffffu); }
__device__ __forceinline__ float dpp_add(float v, int ctrl_qp1, int) { return v; }
template <int CTRL> __device__ __forceinline__ float dpp_mov(float v) { return __int_as_float(__builtin_amdgcn_update_dpp(0, __float_as_int(v), CTRL, 0xF, 0xF, true)); }
__device__ __forceinline__ float sum8(float v) {
    v += dpp_mov<0xB1>(v);
    v += dpp_mov<0x4E>(v);
    v += dpp_mov<0x141>(v);
    return v;
}
__device__ __forceinline__ float sum16(float v) { v = sum8(v); v += dpp_mov<0x140>(v); return v; }
__device__ __forceinline__ float wave_sum(float v) { v = sum16(v); v += __shfl_xor(v, 16); v += __shfl_xor(v, 32); return v; }
__device__ __forceinline__ float half_sum(float v) {
#pragma unroll
    for (int o = 1; o < 32; o <<= 1) v += __shfl_xor(v, o);
    return v;
}

__device__ __forceinline__ void transpose_item(const float* W, int K, int N, bf16* WT, LAS float* scr, int item, int lane, const float* kscale, float sc) {
    const int nblk = N / 32, kb = item / nblk, nb = item % nblk, k0 = 64 * kb, n0 = 32 * nb;
#pragma unroll
    for (int i = 0; i < 8; ++i) { const int kk = 8 * i + (lane >> 3); const f32x4 w = *(const f32x4*)(W + (size_t)(k0 + kk) * N + n0 + 4 * (lane & 7));
        const float s_ = kscale ? kscale[k0 + kk] * sc : sc;
#pragma unroll
        for (int j = 0; j < 4; ++j) scr[kk * 33 + 4 * (lane & 7) + j] = w[j] * s_; }
    asm volatile("s_waitcnt lgkmcnt(0)" ::: "memory");
    const int c = lane & 7;
#pragma unroll
    for (int j = 0; j < 4; ++j) { const int n = (lane >> 3) + 8 * j; const LAS float* s = scr + (8 * c) * 33 + n;
        u32x4 o; o.x = pk2(s[0 * 33], s[1 * 33]); o.y = pk2(s[2 * 33], s[3 * 33]); o.z = pk2(s[4 * 33], s[5 * 33]); o.w = pk2(s[6 * 33], s[7 * 33]);
        *(u32x4*)(WT + (size_t)(n0 + n) * K + k0 + 8 * c) = o; }
    asm volatile("s_waitcnt lgkmcnt(0)" ::: "memory");
}

struct Ctx {
    LAS unsigned char* lds; int tid, lane, wave, vcu, G;
    float* out; unsigned char* ws;
};

__device__ __forceinline__ void phase_prologue_a(const Ctx& F, const Args& args) {
    {
        LAS float* S = (LAS float*)F.lds;
        LAS float* R = (LAS float*)(F.lds + 33 * 512 * 4);
        const float* c = args.in[1]; const float* cc = args.in[3]; const float* wada = args.in[4]; const float* bada = args.in[5];
        float* MOD = (float*)(F.ws + WS_MOD);
        const int cg_ = F.lane & 31, kh = F.lane >> 5;
        for (int it = F.vcu; it < 4 * 192; it += F.G) {
            const int l = it / 192, n0 = (it % 192) * 32;
            float acc[33];
#pragma unroll
            for (int r = 0; r < 33; ++r) acc[r] = 0.f;
            for (int half = 0; half < 2; ++half) {
                __syncthreads();
                for (int e = F.tid; e < 33 * 512; e += NTHR) { const int r = e >> 9, k = (e & 511) + half * 512; const float v = (r < 32) ? c[r * 1024 + k] : cc[k]; S[e] = v / (1.f + __expf(-v)); }
                __syncthreads();
                const int kb = F.wave * 64 + kh * 32;
                const float* wp = wada + ((size_t)l * 1024 + half * 512 + kb) * 6144 + n0 + cg_;
#pragma unroll 1
                for (int kk = 0; kk < 32; kk += 8) {
                    const float w0 = wp[(size_t)(kk + 0) * 6144], w1 = wp[(size_t)(kk + 1) * 6144], w2 = wp[(size_t)(kk + 2) * 6144], w3 = wp[(size_t)(kk + 3) * 6144];
                    const float w4 = wp[(size_t)(kk + 4) * 6144], w5 = wp[(size_t)(kk + 5) * 6144], w6 = wp[(size_t)(kk + 6) * 6144], w7 = wp[(size_t)(kk + 7) * 6144];
#pragma unroll
                    for (int r = 0; r < 33; ++r) { const f32x4 s = *(const LAS f32x4*)(S + r * 512 + kb + kk), t = *(const LAS f32x4*)(S + r * 512 + kb + kk + 4);
                        acc[r] += (s[0] * w0 + s[1] * w1 + s[2] * w2 + s[3] * w3) + (t[0] * w4 + t[1] * w5 + t[2] * w6 + t[3] * w7); }
                }
            }
#pragma unroll
            for (int r = 0; r < 33; ++r) { acc[r] += __shfl_xor(acc[r], 32); if (kh == 0) R[(F.wave * 33 + r) * 32 + cg_] = acc[r]; }
            __syncthreads();
            for (int e = F.tid; e < 33 * 32; e += NTHR) { float s = 0.f;
#pragma unroll
                for (int w = 0; w < 8; ++w) s += R[w * 33 * 32 + e];
                const int r = e >> 5, n = n0 + (e & 31); MOD[((size_t)l * 33 + r) * 6144 + n] = s + bada[l * 6144 + n]; }
        }
        __syncthreads();
    }
    {
        LAS float* scr = (LAS float*)(F.lds + F.wave * 16384);
        const int gw = F.vcu * NWAVES + F.wave, NGW = F.G * NWAVES;
        constexpr int I_INE = 16 * 61, I_INO = 16 * 72, I_OUT = 16 * 32, I_FF1 = 16 * 128, I_FF2 = 64 * 32, I_UQ = 4 * 24, I_UKV = 2 * 32, I_Z = 96;
        constexpr int PER_E = I_INE + I_OUT + I_FF1 + I_FF2 + I_UQ + I_UKV + I_Z, PER_O = I_INO + I_OUT + I_FF1 + I_FF2;
        constexpr int NIT = 2 * (PER_E + PER_O);
        for (int it = gw; it < NIT; it += NGW) {
            int pr = it / (PER_E + PER_O), r = it % (PER_E + PER_O);
            const bool odd = r >= PER_E; if (odd) r -= PER_E;
            const int L = 2 * pr + (odd ? 1 : 0);
            unsigned char* wl = F.ws + WS_WT + (size_t)L * WL_STRIDE;
            const float* W; int K, N; size_t wo; const float* ks = nullptr; float sc = 1.f; bool zero = false;
            if (!odd) {
                if (r < I_INE) { W = args.in[9] + (size_t)pr * 1024 * 1952; K = 1024; N = 1952; wo = WL_IN; }
                else if ((r -= I_INE) < I_OUT) { W = args.in[10] + (size_t)pr * 1024 * 1024; K = 1024; N = 1024; wo = WL_OUT; }
                else if ((r -= I_OUT) < I_FF1) { W = args.in[7] + (size_t)L * 1024 * 4096; K = 1024; N = 4096; wo = WL_FF1; }
                else if ((r -= I_FF1) < I_FF2) { W = args.in[8] + (size_t)L * 4096 * 1024; K = 4096; N = 1024; wo = WL_FF2; }
                else if ((r -= I_FF2) < I_UQ) { W = args.in[12] + (size_t)pr * 256 * 768; K = 256; N = 768; wo = WL_UQ; ks = args.in[11] + pr * 256; sc = MLA_SC * LOG2E; }
                else if ((r -= I_UQ) < I_UKV) { W = args.in[14] + (size_t)pr * 128 * 1024; K = 128; N = 1024; wo = WL_UKV; ks = args.in[13] + pr * 128; }
                else { r -= I_UKV; zero = true; W = nullptr; K = 0; N = 0; wo = WL_IN; }
            } else {
                if (r < I_INO) { W = args.in[17] + (size_t)pr * 1024 * 2304; K = 1024; N = 2304; wo = WL_IN; }
                else if ((r -= I_INO) < I_OUT) { W = args.in[18] + (size_t)pr * 1024 * 1024; K = 1024; N = 1024; wo = WL_OUT; }
                else if ((r -= I_OUT) < I_FF1) { W = args.in[7] + (size_t)L * 1024 * 4096; K = 1024; N = 4096; wo = WL_FF1; }
                else { r -= I_FF1; W = args.in[8] + (size_t)L * 4096 * 1024; K = 4096; N = 1024; wo = WL_FF2; }
            }
            if (zero) { bf16* z = (bf16*)(wl + WL_IN) + (size_t)(1952 + r) * 1024; u32x4 zz = {0u, 0u, 0u, 0u}; *(u32x4*)(z + F.lane * 8) = zz; *(u32x4*)(z + 512 + F.lane * 8) = zz; }
            else transpose_item(W, K, N, (bf16*)(wl + wo), scr, r, F.lane, ks, sc);
        }
    }
}

__device__ __forceinline__ void unpack8(const u32x4 v, float* x) {
#pragma unroll
    for (int i = 0; i < 4; ++i) { x[2 * i] = __uint_as_float(v[i] << 16); x[2 * i + 1] = __uint_as_float(v[i] & 0xffff0000u); }
}
__device__ __forceinline__ u32x4 pack8(const float* x) { u32x4 w; w.x = pk2(x[0], x[1]); w.y = pk2(x[2], x[3]); w.z = pk2(x[4], x[5]); w.w = pk2(x[6], x[7]); return w; }
struct RowPassP { const void* hin_lat; const void* hin_ctx; bf16* hb_lat; bf16* hb_ctx; float* out32; const bf16* Fsrc; bf16* Adst; const float* g_post; const float* g_pre;
                  const float* mod_post; const float* mod_pre; int gate_chunk, shift_chunk, scale_chunk; int has_f, write_h, write_a, skip_ctx, final32; };
template <bool HIN32, bool HAS_F, bool WRITE_H, bool WRITE_A, bool FINAL32>
__device__ __forceinline__ void phase_rowpass(const Ctx& F, const RowPassP p) {
    const int nrows = p.skip_ctx ? NB * SEQ : MROWS;
    const int rpb_ = (nrows + F.G - 1) / F.G; const int cbeg = F.vcu * rpb_, cend = min(cbeg + rpb_, nrows);
    const int c0 = F.lane * 8;
    float gpo[16], gpr[16];
#pragma unroll
    for (int jj = 0; jj < 2; ++jj)
#pragma unroll
        for (int q = 0; q < 2; ++q) { const f32x4 a = *(const f32x4*)(p.g_post + jj * 512 + c0 + q * 4), b = *(const f32x4*)(p.g_pre + jj * 512 + c0 + q * 4);
#pragma unroll
            for (int e = 0; e < 4; ++e) { gpo[jj * 8 + q * 4 + e] = a[e]; gpr[jj * 8 + q * 4 + e] = b[e]; } }
    int cur = cbeg;
    while (cur < cend) {
        int b, j0, send;
        if (p.skip_ctx) { b = cur / SEQ; j0 = cur - b * SEQ + CTXL; send = min(cend, (b + 1) * SEQ); }
        else { b = cur / RPB; j0 = cur - b * RPB; send = min(cend, (j0 < CTXL) ? b * RPB + CTXL : (b + 1) * RPB); }
        const bool isc = j0 < CTXL; const int mrow = isc ? 32 : b; const int n = send - cur;
        const size_t hbase = isc ? (size_t)(b * CTXL + j0) * DM : (size_t)(b * SEQ + j0 - CTXL) * DM;
        const size_t rbase = (size_t)(b * RPB + j0) * DM;
        float gt[16], sh[16], sc[16];
        { const float* gp = p.mod_post + (size_t)mrow * 6144 + p.gate_chunk * 1024; const float* sp = p.mod_pre + (size_t)mrow * 6144 + p.shift_chunk * 1024; const float* cp = p.mod_pre + (size_t)mrow * 6144 + p.scale_chunk * 1024;
#pragma unroll
          for (int jj = 0; jj < 2; ++jj)
#pragma unroll
              for (int q = 0; q < 2; ++q) { const f32x4 a = *(const f32x4*)(gp + jj * 512 + c0 + q * 4), s1 = *(const f32x4*)(sp + jj * 512 + c0 + q * 4), s2 = *(const f32x4*)(cp + jj * 512 + c0 + q * 4);
#pragma unroll
                  for (int e = 0; e < 4; ++e) { gt[jj * 8 + q * 4 + e] = a[e]; sh[jj * 8 + q * 4 + e] = s1[e]; sc[jj * 8 + q * 4 + e] = 1.f + s2[e]; } } }
        const float* hin32 = (const float*)(isc ? p.hin_ctx : p.hin_lat) + hbase; const bf16* hinb = (const bf16*)(isc ? p.hin_ctx : p.hin_lat) + hbase;
        bf16* houtb = (isc ? p.hb_ctx : p.hb_lat) + hbase; float* hout32 = p.out32 + hbase;
        const bf16* fsrc = p.Fsrc + rbase; bf16* adst = p.Adst + rbase;
        f32x4 hn[HIN32 ? 4 : 1]; u32x4 hbn[HIN32 ? 1 : 2]; u32x4 fn[2];
#define RP_LOAD(i_) do { const size_t o_ = (size_t)(i_) * DM; \
            if constexpr (HIN32) { _Pragma("unroll") for (int jj_ = 0; jj_ < 2; ++jj_) { hn[jj_ * 2] = *(const f32x4*)(hin32 + o_ + jj_ * 512 + c0); hn[jj_ * 2 + 1] = *(const f32x4*)(hin32 + o_ + jj_ * 512 + c0 + 4); } } \
            else { _Pragma("unroll") for (int jj_ = 0; jj_ < 2; ++jj_) hbn[jj_] = __builtin_nontemporal_load((const u32x4*)(hinb + o_ + jj_ * 512 + c0)); } \
            if constexpr (HAS_F) { _Pragma("unroll") for (int jj_ = 0; jj_ < 2; ++jj_) fn[jj_] = *(const u32x4*)(fsrc + o_ + jj_ * 512 + c0); } } while (0)
        int i = F.wave;
        if (i < n) RP_LOAD(i);
        for (; i < n; i += NWAVES) {
            float h[16]; u32x4 fc[2];
#pragma unroll
            for (int jj = 0; jj < 2; ++jj) {
                if constexpr (HIN32) {
#pragma unroll
                    for (int e = 0; e < 4; ++e) { h[jj * 8 + e] = hn[jj * 2][e]; h[jj * 8 + 4 + e] = hn[jj * 2 + 1][e]; } }
                else unpack8(hbn[jj], h + jj * 8);
                if constexpr (HAS_F) fc[jj] = fn[jj]; }
            { const int inx = (i + NWAVES < n) ? i + NWAVES : i; RP_LOAD(inx); }
            const size_t ro = (size_t)i * DM;
            if constexpr (HAS_F) {
                float f[16]; float ss = 0.f;
                unpack8(fc[0], f); unpack8(fc[1], f + 8);
#pragma unroll
                for (int e = 0; e < 16; ++e) ss += f[e] * f[e];
                ss = wave_sum(ss); const float rs = rsqrtf(ss * (1.f / DM) + EPSN);
#pragma unroll
                for (int e = 0; e < 16; ++e) h[e] += gt[e] * (f[e] * rs * gpo[e]);
            }
            if constexpr (FINAL32) {
#pragma unroll
                for (int jj = 0; jj < 2; ++jj) { f32x4 a, c;
#pragma unroll
                    for (int e = 0; e < 4; ++e) { a[e] = h[jj * 8 + e]; c[e] = h[jj * 8 + 4 + e]; }
                    *(f32x4*)(hout32 + ro + jj * 512 + c0) = a; *(f32x4*)(hout32 + ro + jj * 512 + c0 + 4) = c; }
            }
            if constexpr (WRITE_H) {
#pragma unroll
                for (int jj = 0; jj < 2; ++jj) { const u32x4 w = pack8(h + jj * 8); __builtin_nontemporal_store(w, (u32x4*)(houtb + ro + jj * 512 + c0)); unpack8(w, h + jj * 8); }
            }
            if constexpr (WRITE_A) {
                float ss = 0.f;
#pragma unroll
                for (int e = 0; e < 16; ++e) ss += h[e] * h[e];
                ss = wave_sum(ss); const float rs = rsqrtf(ss * (1.f / DM) + EPSN);
#pragma unroll
                for (int jj = 0; jj < 2; ++jj) { float o[8];
#pragma unroll
                    for (int e = 0; e < 8; ++e) o[e] = (h[jj * 8 + e] * rs * gpr[jj * 8 + e]) * sc[jj * 8 + e] + sh[jj * 8 + e];
                    *(u32x4*)(adst + ro + jj * 512 + c0) = pack8(o); }
            }
        }
#undef RP_LOAD
        cur = send;
    }
}

__device__ __forceinline__ void rope_cs(int j, int i, int nfreq, float& cs, float& sn) {
    if (j < CTXL) { cs = 1.f; sn = 0.f; return; }
    const int t = j - CTXL; const int fi = (i < nfreq) ? i : i - nfreq; const float pos = (i < nfreq) ? (float)(t >> 6) : (float)(t & 63);
    const float ang = pos * exp2f(-(float)fi * (LOG2_THETA / (float)nfreq));
    cs = __cosf(ang); sn = __sinf(ang);
}
__device__ __forceinline__ void rope8(float* x, int lane, bool isx2, float pos, const float* finv, bool doit, float scale) {
    float y[8];
#pragma unroll
    for (int e = 0; e < 8; ++e) y[e] = __shfl_xor(x[e], 4);
    (void)lane;
#pragma unroll
    for (int e = 0; e < 8; ++e) {
        float cs = 1.f, sn = 0.f;
        if (doit) { const float ang = pos * finv[e]; cs = __cosf(ang); sn = __sinf(ang); }
        x[e] = (isx2 ? (x[e] * cs + y[e] * sn) : (x[e] * cs - y[e] * sn)) * scale;
    }
}
__device__ __forceinline__ void phase_prep_even(const Ctx& F) {
    bf16* P = (bf16*)(F.ws + WS_P); bf16* CQN = (bf16*)(F.ws + WS_AF); bf16* CKVN = (bf16*)(F.ws + WS_AF + 36 * MiB);
    const int gw = F.vcu * NWAVES + F.wave, NGW = F.G * NWAVES; const int lane = F.lane; const int chunk = (MROWS + NGW - 1) / NGW;
    const int r0 = gw * chunk, r1 = min(r0 + chunk, MROWS);
    if (r0 >= r1) return;
    const int ca = lane < 52 ? lane : 51;
    const int cv = lane & 7; const bool isx2 = (cv & 4) != 0; const bool colang = (cv & 2) != 0;
    float finv[8], finvk[8];
#pragma unroll
    for (int e = 0; e < 8; ++e) { finv[e] = exp2f(-(float)(8 * (cv & 1) + e) * (LOG2_THETA / 16.f)); finvk[e] = exp2f(-(float)e * (LOG2_THETA / 8.f)); }
    u32x4 na, nb, nc;
    { const bf16* pr = P + (size_t)r0 * PE; na = *(const u32x4*)(pr + 8 * ca); nb = *(const u32x4*)(pr + E_DQ + 8 * lane); nc = *(const u32x4*)(pr + E_DK + 8 * lane); }
    for (int r = r0; r < r1; ++r) {
        const u32x4 va = na, vb = nb, vc = nc;
        if (r + 1 < r1) { const bf16* pn = P + (size_t)(r + 1) * PE; na = *(const u32x4*)(pn + 8 * ca); nb = *(const u32x4*)(pn + E_DQ + 8 * lane); nc = *(const u32x4*)(pn + E_DK + 8 * lane); }
        const int j = r % RPB; const bool lat = j >= CTXL; const int t = j - CTXL;
        const float posh = colang ? (float)(t & 63) : (float)(t >> 6);
        bf16* pr = P + (size_t)r * PE;
        {
            float x[8]; unpack8(va, x);
            float ss = 0.f;
#pragma unroll
            for (int e = 0; e < 8; ++e) ss += x[e] * x[e];
            ss = sum16(ss);
            const float ss32 = ss + __shfl_xor(ss, 16);
            const float rs = (lane < 32) ? rsqrtf(ss32 * (1.f / 256.f) + EPSN) : rsqrtf(ss * (1.f / 128.f) + EPSN);
            float y[8];
#pragma unroll
            for (int e = 0; e < 8; ++e) y[e] = __shfl_xor(x[e], 2);
            if (lane < 32) { float o[8];
#pragma unroll
                for (int e = 0; e < 8; ++e) o[e] = x[e] * rs;
                *(u32x4*)(CQN + (size_t)r * 256 + 8 * lane) = pack8(o); }
            else if (lane < 48) { float o[8];
#pragma unroll
                for (int e = 0; e < 8; ++e) o[e] = x[e] * rs;
                *(u32x4*)(CKVN + (size_t)r * 128 + 8 * (lane - 32)) = pack8(o); }
            else if (lane < 52 && lat) { const float pos = (lane & 1) ? (float)(t & 63) : (float)(t >> 6); const bool x2 = (lane & 2) != 0; float o[8];
#pragma unroll
                for (int e = 0; e < 8; ++e) { const float ang = pos * finvk[e]; const float cs = __cosf(ang), sn = __sinf(ang); o[e] = x2 ? (x[e] * cs + y[e] * sn) : (x[e] * cs - y[e] * sn); }
                *(u32x4*)(pr + 8 * lane) = pack8(o); }
        }
        { float x[8]; unpack8(vb, x); rope8(x, lane, isx2, posh, finv, lat, HD_SC * LOG2E); *(u32x4*)(pr + E_DQ + 8 * lane) = pack8(x); }
        if (lat) { float x[8]; unpack8(vc, x); rope8(x, lane, isx2, posh, finv, true, 1.f); *(u32x4*)(pr + E_DK + 8 * lane) = pack8(x); }
    }
}
__device__ __forceinline__ void phase_prep_odd(const Ctx& F, const float* qkn  ) {
    bf16* P = (bf16*)(F.ws + WS_P);
    const int gw = F.vcu * NWAVES + F.wave, NGW = F.G * NWAVES; const int lane = F.lane; const int chunk = (MROWS + NGW - 1) / NGW;
    const int r0 = gw * chunk, r1 = min(r0 + chunk, MROWS);
    if (r0 >= r1) return;
    const int cv = lane & 7; const bool isx2 = (cv & 4) != 0; const bool colang = (cv & 2) != 0;
    float finv[8], gq[8], gk[8];
#pragma unroll
    for (int e = 0; e < 8; ++e) { finv[e] = exp2f(-(float)(8 * (cv & 1) + e) * (LOG2_THETA / 16.f)); gq[e] = qkn[8 * cv + e]; gk[e] = qkn[64 + 8 * cv + e]; }
    u32x4 na, nb, nc;
    { const bf16* pr = P + (size_t)r0 * PO; na = *(const u32x4*)(pr + 8 * lane); nb = *(const u32x4*)(pr + O_GK + 8 * (lane & 15)); nc = *(const u32x4*)(pr + O_NQ + 8 * lane); }
    for (int r = r0; r < r1; ++r) {
        const u32x4 va = na, vb = nb, vc = nc;
        if (r + 1 < r1) { const bf16* pn = P + (size_t)(r + 1) * PO; na = *(const u32x4*)(pn + 8 * lane); nb = *(const u32x4*)(pn + O_GK + 8 * (lane & 15)); nc = *(const u32x4*)(pn + O_NQ + 8 * lane); }
        const int j = r % RPB; const bool lat = j >= CTXL; const int t = j - CTXL;
        const float posh = colang ? (float)(t & 63) : (float)(t >> 6);
        bf16* pr = P + (size_t)r * PO;
        { float x[8]; unpack8(va, x); float ss = 0.f;
#pragma unroll
          for (int e = 0; e < 8; ++e) ss += x[e] * x[e];
          ss = sum8(ss);
          const float rs = rsqrtf(ss * (1.f / 64.f) + EPSN);
#pragma unroll
          for (int e = 0; e < 8; ++e) x[e] *= rs * gq[e];
          rope8(x, lane, isx2, posh, finv, lat, HD_SC * LOG2E); *(u32x4*)(pr + 8 * lane) = pack8(x); }
        { float x[8]; unpack8(vb, x); float ss = 0.f;
#pragma unroll
          for (int e = 0; e < 8; ++e) ss += x[e] * x[e];
          ss = sum8(ss);
          const float rs = rsqrtf(ss * (1.f / 64.f) + EPSN);
#pragma unroll
          for (int e = 0; e < 8; ++e) x[e] *= rs * gk[e];
          rope8(x, lane, isx2, posh, finv, lat, 1.f); if (lane < 16) *(u32x4*)(pr + O_GK + 8 * lane) = pack8(x); }
        { float x[8]; unpack8(vc, x);
#pragma unroll
          for (int e = 0; e < 8; ++e) x[e] *= (HD_SC * LOG2E);
          *(u32x4*)(pr + O_NQ + 8 * lane) = pack8(x); }
    }
}

struct AttnP {
    const bf16* q; int qpitch; const bf16* ka; int kapitch; const bf16* kb; int kbpitch; const bf16* v; int vpitch; bf16* o; int opitch;
    int nA, tB0, nB;
    int rope_t0;
    int mode;
    float lam, post; const float* subln;
    int na_row0;
};
__device__ __forceinline__ int crow(int r, int hi) { return (r & 3) + 8 * (r >> 2) + 4 * hi; }

struct AttnP2 { const bf16* qA; const bf16* qB; int qpitch; const bf16* ka; int kapitch; const bf16* v; int vpitch; bf16* oA; bf16* oB; int opitch; int ntile; };
__device__ __forceinline__ void attn_unit_gqa2(const AttnP2& a, LAS unsigned char* lds, int tid) {
    constexpr int DQK = 64, DV = 64, KP = DQK * 2 + 16, KBYTES = 64 * KP, VBYTES = 64 * DV * 2, BUF = KBYTES + VBYTES, KCH = DQK / 8, VCH = DV / 8, ND = DQK / 16, NDB = DV / 32;
    const int lane = tid & 63, wave = __builtin_amdgcn_readfirstlane(tid >> 6), r32 = lane & 31, hi = lane >> 5;
    bf16x8 qfA[ND], qfB[ND];
    { const size_t ro = (size_t)(wave * 32 + r32) * a.qpitch + hi * 8;
#pragma unroll
      for (int d0 = 0; d0 < ND; ++d0) { qfA[d0] = *(const bf16x8*)(a.qA + ro + d0 * 16); qfB[d0] = *(const bf16x8*)(a.qB + ro + d0 * 16); } }
    constexpr int KS = KP / 16, NIK = KS, NIV = VCH, NI = NIK + NIV, MAXI = (NI + 7) / 8;
    const bf16* gsrc[MAXI]; unsigned gstep[MAXI];
#pragma unroll
    for (int j = 0; j < MAXI; ++j) {
        const int ii = wave + 8 * j; const int s = ii * 64 + lane;
        if (ii < NIK) { const int row = s / KS; int ch = s - row * KS; if (ch >= KCH) ch = 0; gsrc[j] = a.ka + (size_t)row * a.kapitch + ch * 8; gstep[j] = 64u * (unsigned)a.kapitch; }
        else { const int s2 = (s - 64 * KS) & (64 * VCH - 1); const int st = s2 >> 5, rowin = (s2 & 31) >> 2, chin = s2 & 3; const int row = (st / NDB) * 8 + rowin, ch = (st % NDB) * 4 + chin;
            gsrc[j] = a.v + (size_t)row * a.vpitch + ch * 8; gstep[j] = 64u * (unsigned)a.vpitch; }
    }
    const int mycnt = (NI - 1 - wave) / 8 + 1;
    const int ntile = a.ntile;
#define ATT_ISSUE(tt_, slot_) do { _Pragma("unroll") for (int j_ = 0; j_ < MAXI; ++j_) if (wave + 8 * j_ < NI) \
        __builtin_amdgcn_global_load_lds((const unsigned*)(gsrc[j_] + (size_t)(tt_) * gstep[j_]), (LAS unsigned*)(lds + (slot_) * BUF + (wave + 8 * j_) * 1024), 16, 0, 0); } while (0)
#define ATT_WAITBAR(keep_) do { if (keep_) { if (mycnt == MAXI) asm volatile("s_waitcnt vmcnt(%0) lgkmcnt(0)\n\ts_barrier" :: "n"(MAXI) : "memory"); else asm volatile("s_waitcnt vmcnt(%0) lgkmcnt(0)\n\ts_barrier" :: "n"(MAXI - 1) : "memory"); } \
        else asm volatile("s_waitcnt vmcnt(0) lgkmcnt(0)\n\ts_barrier" ::: "memory"); } while (0)
    ATT_ISSUE(0, 0);
    if (ntile > 1) ATT_ISSUE(1, 1);
    ATT_WAITBAR(ntile > 1);
    constexpr float THR = 8.f;
    float mrunA = 0.f, lrunA = 0.f, mrunB = 0.f, lrunB = 0.f;
    f32x16 oA[NDB], oB[NDB];
#pragma unroll
    for (int d = 0; d < NDB; ++d) { oA[d] = f32x16{}; oB[d] = f32x16{}; }
    const int koff = r32 * KP + hi * 16;
    const int voff = KBYTES + (4 * hi + ((lane & 15) >> 2)) * 64 + ((lane >> 4) & 1) * 32 + (lane & 3) * 8;
    int slot0 = 0, slot2 = 2;
    for (int it = 0; it < ntile; ++it) {
        if (it + 2 < ntile) ATT_ISSUE(it + 2, slot2);
        LAS unsigned char* kb_ = lds + slot0 * BUF;
        bf16x8 kf0[ND], kf1[ND];
#pragma unroll
        for (int d0 = 0; d0 < ND; ++d0) { kf0[d0] = *(const LAS bf16x8*)(kb_ + koff + d0 * 32); kf1[d0] = *(const LAS bf16x8*)(kb_ + koff + 32 * KP + d0 * 32); }
        bf16x8 pwA[4], pwB[4];
#define GQ_HEAD(QF_, MRUN_, LRUN_, O_, PW_) do { \
            f32x16 p0 = f32x16{}, p1 = f32x16{}; \
            _Pragma("unroll") for (int d0 = 0; d0 < ND; ++d0) { p0 = __builtin_amdgcn_mfma_f32_32x32x16_bf16(kf0[d0], QF_[d0], p0, 0, 0, 0); p1 = __builtin_amdgcn_mfma_f32_32x32x16_bf16(kf1[d0], QF_[d0], p1, 0, 0, 0); } \
            float mxa = fmaxf(fmaxf(p0[0], p0[1]), p1[0]), mxb = fmaxf(fmaxf(p0[2], p0[3]), p1[1]); \
            mxa = fmaxf(fmaxf(mxa, p1[2]), p1[3]); \
            _Pragma("unroll") for (int r = 4; r < 16; r += 4) { mxa = fmaxf(fmaxf(mxa, p0[r]), p0[r + 1]); mxb = fmaxf(fmaxf(mxb, p0[r + 2]), p0[r + 3]); mxa = fmaxf(fmaxf(mxa, p1[r]), p1[r + 1]); mxb = fmaxf(fmaxf(mxb, p1[r + 2]), p1[r + 3]); } \
            float mx = fmaxf(mxa, mxb); \
            { const auto rr = __builtin_amdgcn_permlane32_swap(__float_as_uint(mx), __float_as_uint(mx), false, false); mx = fmaxf(__uint_as_float(rr[0]), __uint_as_float(rr[1])); } \
            mx -= MRUN_; \
            if (it == 0 || __any(mx > THR)) { const float dl = (it == 0) ? mx : fmaxf(mx, 0.f); MRUN_ += dl; const float alpha = __builtin_amdgcn_exp2f(-dl); LRUN_ *= alpha; \
                _Pragma("unroll") for (int d = 0; d < NDB; ++d) _Pragma("unroll") for (int r = 0; r < 16; ++r) O_[d][r] *= alpha; } \
            float rs0 = 0.f, rs1 = 0.f; \
            _Pragma("unroll") for (int r = 0; r < 16; ++r) { p0[r] = __builtin_amdgcn_exp2f(p0[r] - MRUN_); p1[r] = __builtin_amdgcn_exp2f(p1[r] - MRUN_); rs0 += p0[r]; rs1 += p1[r]; } \
            LRUN_ += rs0 + rs1; \
            _Pragma("unroll") for (int ks = 0; ks < 4; ++ks) { u32x4 w; const int b = 8 * (ks & 1); \
                if (ks < 2) { w.x = pk2(p0[b], p0[b + 1]); w.y = pk2(p0[b + 2], p0[b + 3]); w.z = pk2(p0[b + 4], p0[b + 5]); w.w = pk2(p0[b + 6], p0[b + 7]); } \
                else { w.x = pk2(p1[b], p1[b + 1]); w.y = pk2(p1[b + 2], p1[b + 3]); w.z = pk2(p1[b + 4], p1[b + 5]); w.w = pk2(p1[b + 6], p1[b + 7]); } \
                PW_[ks] = __builtin_bit_cast(bf16x8, w); } } while (0)
        GQ_HEAD(qfA, mrunA, lrunA, oA, pwA);
        GQ_HEAD(qfB, mrunB, lrunB, oB, pwB);
#undef GQ_HEAD
        {
            const unsigned vaddr = (unsigned)(size_t)kb_ + (unsigned)voff;
            s16x4 vlo[2][NDB], vhi[2][NDB];
#define ATT_VRD(set_, ks_) do { _Pragma("unroll") for (int d_ = 0; d_ < NDB; ++d_) { \
                asm volatile("ds_read_b64_tr_b16 %0, %1 offset:%2" : "=&v"(vlo[set_][d_]) : "v"(vaddr), "n"(((2 * (ks_)) * NDB + d_) * 512)); \
                asm volatile("ds_read_b64_tr_b16 %0, %1 offset:%2" : "=&v"(vhi[set_][d_]) : "v"(vaddr), "n"(((2 * (ks_) + 1) * NDB + d_) * 512)); } } while (0)
            ATT_VRD(0, 0);
#pragma unroll
            for (int ks = 0; ks < 4; ++ks) {
                const int cs = ks & 1;
                if (ks < 3) { if (ks == 0) ATT_VRD(1, 1); else if (ks == 1) ATT_VRD(0, 2); else ATT_VRD(1, 3); }
                if (ks < 3) asm volatile("s_waitcnt lgkmcnt(4)" : "+v"(vlo[cs][0]), "+v"(vhi[cs][0]), "+v"(vlo[cs][1]), "+v"(vhi[cs][1]));
                else asm volatile("s_waitcnt lgkmcnt(0)" : "+v"(vlo[cs][0]), "+v"(vhi[cs][0]), "+v"(vlo[cs][1]), "+v"(vhi[cs][1]));
#pragma unroll
                for (int d = 0; d < NDB; ++d) {
                    const bf16x8 vf = {vlo[cs][d][0], vlo[cs][d][1], vlo[cs][d][2], vlo[cs][d][3], vhi[cs][d][0], vhi[cs][d][1], vhi[cs][d][2], vhi[cs][d][3]};
                    oA[d] = __builtin_amdgcn_mfma_f32_32x32x16_bf16(vf, pwA[ks], oA[d], 0, 0, 0);
                    oB[d] = __builtin_amdgcn_mfma_f32_32x32x16_bf16(vf, pwB[ks], oB[d], 0, 0, 0);
                }
            }
#undef ATT_VRD
        }
        ATT_WAITBAR(it + 2 < ntile);
        slot0 = (slot0 == 2) ? 0 : slot0 + 1; slot2 = (slot2 == 2) ? 0 : slot2 + 1;
    }
#undef ATT_ISSUE
#undef ATT_WAITBAR
    lrunA += __shfl_xor(lrunA, 32); lrunB += __shfl_xor(lrunB, 32);
    const float invA = 1.f / lrunA, invB = 1.f / lrunB;
    const size_t oo = (size_t)(wave * 32 + r32) * a.opitch + 4 * hi;
#pragma unroll
    for (int d = 0; d < NDB; ++d)
#pragma unroll
        for (int g = 0; g < 4; ++g) { u32x2 w; w.x = pk2(oA[d][4 * g] * invA, oA[d][4 * g + 1] * invA); w.y = pk2(oA[d][4 * g + 2] * invA, oA[d][4 * g + 3] * invA); *(u32x2*)(a.oA + oo + 32 * d + 8 * g) = w;
            u32x2 w2; w2.x = pk2(oB[d][4 * g] * invB, oB[d][4 * g + 1] * invB); w2.y = pk2(oB[d][4 * g + 2] * invB, oB[d][4 * g + 3] * invB); *(u32x2*)(a.oB + oo + 32 * d + 8 * g) = w2; }
}

template <int DQK, int DV, bool NA>
__device__ __forceinline__ void attn_unit(const AttnP& a, LAS unsigned char* lds, const LAS float* biasT, int tid) {
    constexpr int KP = DQK * 2 + 16, KBYTES = 64 * KP, VBYTES = 64 * DV * 2, BUF = KBYTES + VBYTES;
    constexpr int KCH = DQK / 8, VCH = DV / 8, ND = DQK / 16, NDB = DV / 32;
    const int lane = tid & 63, wave = __builtin_amdgcn_readfirstlane(tid >> 6), r32 = lane & 31, hi = lane >> 5;
    bf16x8 qf[ND];
    { const bf16* qrow = a.q + (size_t)(wave * 32 + r32) * a.qpitch + hi * 8;
#pragma unroll
      for (int d0 = 0; d0 < ND; ++d0) qf[d0] = *(const bf16x8*)(qrow + d0 * 16); }
    if constexpr (DQK == 96) {
        if (a.rope_t0 >= 0) {
            const int t = a.rope_t0 + wave * 32 + r32; const float pos = hi ? (float)(t & 63) : (float)(t >> 6);
#pragma unroll
            for (int e = 0; e < 8; ++e) { const float ang = pos * exp2f(-(float)e * (LOG2_THETA / 8.f)); const float cs = __cosf(ang), sn = __sinf(ang);
                const float x1 = bf2f((unsigned short)qf[4][e]), x2 = bf2f((unsigned short)qf[5][e]);
                qf[4][e] = (short)f2bf(x1 * cs - x2 * sn); qf[5][e] = (short)f2bf(x2 * cs + x1 * sn); }
        }
    }
    constexpr int KS = KP / 16, NIK = KS, NIV = VCH, NI = NIK + NIV, MAXI = (NI + 7) / 8;
    const bf16* gsrc[MAXI]; unsigned gstep[MAXI];
#pragma unroll
    for (int j = 0; j < MAXI; ++j) {
        const int ii = wave + 8 * j; const int s = ii * 64 + lane;
        if (ii < NIK) { const int row = s / KS; int ch = s - row * KS; if (ch >= KCH) ch = 0;
            if (DQK == 96 && ch >= 8) { gsrc[j] = a.kb + (size_t)row * a.kbpitch + (ch - 8) * 8; gstep[j] = 64u * (unsigned)a.kbpitch; }
            else { gsrc[j] = a.ka + (size_t)row * a.kapitch + ch * 8; gstep[j] = 64u * (unsigned)a.kapitch; } }
        else { const int s2 = (s - 64 * KS) & (64 * VCH - 1); const int st = s2 >> 5, rowin = (s2 & 31) >> 2, chin = s2 & 3; const int row = (st / NDB) * 8 + rowin, ch = (st % NDB) * 4 + chin;
            gsrc[j] = a.v + (size_t)row * a.vpitch + ch * 8; gstep[j] = 64u * (unsigned)a.vpitch; }
    }
    const int mycnt = (NI - 1 - wave) / 8 + 1;
    const int ntile = a.nA + a.nB;
#define ATT_TILE(i_) ((i_) < a.nA ? (i_) : a.tB0 + ((i_) - a.nA))
#define ATT_ISSUE(tt_, slot_) do { _Pragma("unroll") for (int j_ = 0; j_ < MAXI; ++j_) if (wave + 8 * j_ < NI) \
        __builtin_amdgcn_global_load_lds((const unsigned*)(gsrc[j_] + (size_t)(tt_) * gstep[j_]), (LAS unsigned*)(lds + (slot_) * BUF + (wave + 8 * j_) * 1024), 16, 0, 0); } while (0)
#define ATT_WAITBAR(keep_) do { if (keep_) { if (mycnt == MAXI) asm volatile("s_waitcnt vmcnt(%0) lgkmcnt(0)\n\ts_barrier" :: "n"(MAXI) : "memory"); else asm volatile("s_waitcnt vmcnt(%0) lgkmcnt(0)\n\ts_barrier" :: "n"(MAXI - 1) : "memory"); } \
        else asm volatile("s_waitcnt vmcnt(0) lgkmcnt(0)\n\ts_barrier" ::: "memory"); } while (0)
    ATT_ISSUE(ATT_TILE(0), 0);
    if (ntile > 1) ATT_ISSUE(ATT_TILE(1), 1);
    if constexpr (NA) {
        LAS float* bt = (LAS float*)biasT; const float* rp = a.subln;
        for (int e = tid; e < 704; e += NTHR) { const int j = e - 64, rr = j >> 5, cc = j & 31; bt[e] = (j >= 0 && j < 15 * 32 && cc < 31) ? rp[rr * 31 + cc] * LOG2E : 0.f; }
    }
    ATT_WAITBAR(ntile > 1);
    constexpr float THR = 8.f;
    constexpr bool NEGM = (DV == 64) && !NA;
    float mrun = 0.f, lrun = 0.f;
    f32x16 negm = f32x16{};
    f32x16 o[NDB];
#pragma unroll
    for (int d = 0; d < NDB; ++d) o[d] = f32x16{};
    const int koff = r32 * KP + hi * 16;
    const int voff = KBYTES + (4 * hi + ((lane & 15) >> 2)) * 64 + ((lane >> 4) & 1) * 32 + (lane & 3) * 8;
    int na_rq = 0, na_r0 = 0, na_c = 0, na_ws = 0;
    if constexpr (NA) { na_rq = a.na_row0 + (wave >> 1); na_r0 = min(max(na_rq - 4, 0), 24); na_c = 32 * (wave & 1) + r32; na_ws = min(max(na_c - 8, 0), 48); }
    float mv[NA ? 20 : 1]; const LAS float* tb0 = nullptr; const int napar = wave & 1;
    if constexpr (NA) {
        tb0 = biasT + (64 + 15 - na_c + 4 * hi);
        if (napar == 0) {
#pragma unroll
            for (int r = 0; r < 16; ++r) { const int kc0 = crow(r, hi); mv[r] = (kc0 >= na_ws && kc0 < na_ws + 16) ? 0.f : -INFINITY; }
#pragma unroll
            for (int r = 0; r < 4; ++r) { const int kc1 = 32 + crow(r, hi); mv[16 + r] = (kc1 >= na_ws && kc1 < na_ws + 16) ? 0.f : -INFINITY; }
        } else {
#pragma unroll
            for (int r = 0; r < 16; ++r) { const int kc1 = 32 + crow(r, hi); mv[r] = (kc1 >= na_ws && kc1 < na_ws + 16) ? 0.f : -INFINITY; }
#pragma unroll
            for (int r = 0; r < 4; ++r) { const int kc0 = crow(12 + r, hi); mv[16 + r] = (kc0 >= na_ws && kc0 < na_ws + 16) ? 0.f : -INFINITY; }
        }
    }
    int slot0 = 0, slot2 = 2;
    for (int it = 0; it < ntile; ++it) {
        const int tt = ATT_TILE(it);
        if (it + 2 < ntile) { const int tn = ATT_TILE(it + 2); ATT_ISSUE(tn, slot2); }
        bool active = true; int rowoff = 0; bool local = false;
        if constexpr (NA) { if (tt >= 4) { const int kr = tt - 4; local = true; active = (kr >= na_r0) && (kr < na_r0 + 8); rowoff = (kr - na_rq + 7) * 32; } }
        if (active) {
            LAS unsigned char* kb_ = lds + slot0 * BUF;
            f32x16 p0, p1;
            if constexpr (NEGM) { p0 = negm; p1 = negm; } else { p0 = f32x16{}; p1 = f32x16{}; }
            {
                bf16x8 kf0[ND], kf1[ND];
#pragma unroll
                for (int d0 = 0; d0 < ND; ++d0) { kf0[d0] = *(const LAS bf16x8*)(kb_ + koff + d0 * 32); kf1[d0] = *(const LAS bf16x8*)(kb_ + koff + 32 * KP + d0 * 32); }
                __builtin_amdgcn_sched_barrier(0);
#pragma unroll
                for (int d0 = 0; d0 < ND; ++d0) {
                    p0 = __builtin_amdgcn_mfma_f32_32x32x16_bf16(kf0[d0], qf[d0], p0, 0, 0, 0);
                    p1 = __builtin_amdgcn_mfma_f32_32x32x16_bf16(kf1[d0], qf[d0], p1, 0, 0, 0);
                }
            }
            if constexpr (NA) {
                if (local) {
                    const LAS float* tb = tb0 + rowoff;
                    if (napar == 0) {
#pragma unroll
                        for (int r = 0; r < 16; ++r) p0[r] = (p0[r] + tb[(r & 3) + 8 * (r >> 2)]) + mv[r];
#pragma unroll
                        for (int r = 0; r < 4; ++r) p1[r] = (p1[r] + tb[32 + (r & 3)]) + mv[16 + r];
#pragma unroll
                        for (int r = 4; r < 16; ++r) p1[r] = -INFINITY;
                    } else {
#pragma unroll
                        for (int r = 0; r < 12; ++r) p0[r] = -INFINITY;
#pragma unroll
                        for (int r = 12; r < 16; ++r) p0[r] = (p0[r] + tb[(r & 3) + 24]) + mv[16 + r - 12];
#pragma unroll
                        for (int r = 0; r < 16; ++r) p1[r] = (p1[r] + tb[32 + (r & 3) + 8 * (r >> 2)]) + mv[r];
                    }
                }
            }
            float mxa = fmaxf(fmaxf(p0[0], p0[1]), p1[0]), mxb = fmaxf(fmaxf(p0[2], p0[3]), p1[1]);
            mxa = fmaxf(fmaxf(mxa, p1[2]), p1[3]);
#pragma unroll
            for (int r = 4; r < 16; r += 4) { mxa = fmaxf(fmaxf(mxa, p0[r]), p0[r + 1]); mxb = fmaxf(fmaxf(mxb, p0[r + 2]), p0[r + 3]); mxa = fmaxf(fmaxf(mxa, p1[r]), p1[r + 1]); mxb = fmaxf(fmaxf(mxb, p1[r + 2]), p1[r + 3]); }
            float mx = fmaxf(mxa, mxb);
            { const auto rr = __builtin_amdgcn_permlane32_swap(__float_as_uint(mx), __float_as_uint(mx), false, false); mx = fmaxf(__uint_as_float(rr[0]), __uint_as_float(rr[1])); }
            if constexpr (!NEGM) mx -= mrun;
            if (it == 0 || __any(mx > THR)) {
                const float dl = (it == 0) ? mx : fmaxf(mx, 0.f);
                mrun += dl;
                const float alpha = __builtin_amdgcn_exp2f(-dl);
                lrun *= alpha;
#pragma unroll
                for (int d = 0; d < NDB; ++d)
#pragma unroll
                    for (int r = 0; r < 16; ++r) o[d][r] *= alpha;
                if constexpr (NEGM) {
#pragma unroll
                    for (int r = 0; r < 16; ++r) { p0[r] -= dl; p1[r] -= dl; negm[r] = -mrun; }
                }
            }
            float rs0 = 0.f, rs1 = 0.f, rs2 = 0.f, rs3 = 0.f;
#pragma unroll
            for (int r = 0; r < 16; r += 2) {
                if constexpr (NEGM) { p0[r] = __builtin_amdgcn_exp2f(p0[r]); p0[r + 1] = __builtin_amdgcn_exp2f(p0[r + 1]); p1[r] = __builtin_amdgcn_exp2f(p1[r]); p1[r + 1] = __builtin_amdgcn_exp2f(p1[r + 1]); }
                else { p0[r] = __builtin_amdgcn_exp2f(p0[r] - mrun); p0[r + 1] = __builtin_amdgcn_exp2f(p0[r + 1] - mrun); p1[r] = __builtin_amdgcn_exp2f(p1[r] - mrun); p1[r + 1] = __builtin_amdgcn_exp2f(p1[r + 1] - mrun); }
                rs0 += p0[r]; rs1 += p0[r + 1]; rs2 += p1[r]; rs3 += p1[r + 1];
            }
            lrun += (rs0 + rs1) + (rs2 + rs3);
            bf16x8 pw[4];
#pragma unroll
            for (int ks = 0; ks < 4; ++ks) { u32x4 w;
                if (ks < 2) { const int b = 8 * (ks & 1); w.x = pk2(p0[b], p0[b + 1]); w.y = pk2(p0[b + 2], p0[b + 3]); w.z = pk2(p0[b + 4], p0[b + 5]); w.w = pk2(p0[b + 6], p0[b + 7]); }
                else { const int b = 8 * (ks & 1); w.x = pk2(p1[b], p1[b + 1]); w.y = pk2(p1[b + 2], p1[b + 3]); w.z = pk2(p1[b + 4], p1[b + 5]); w.w = pk2(p1[b + 6], p1[b + 7]); }
                pw[ks] = __builtin_bit_cast(bf16x8, w); }
            {
                const unsigned vaddr = (unsigned)(size_t)kb_ + (unsigned)voff;
                s16x4 vlo[2][NDB], vhi[2][NDB];
#define ATT_VRD(set_, ks_) do { _Pragma("unroll") for (int d_ = 0; d_ < NDB; ++d_) { \
                    asm volatile("ds_read_b64_tr_b16 %0, %1 offset:%2" : "=&v"(vlo[set_][d_]) : "v"(vaddr), "n"(((2 * (ks_)) * NDB + d_) * 512)); \
                    asm volatile("ds_read_b64_tr_b16 %0, %1 offset:%2" : "=&v"(vhi[set_][d_]) : "v"(vaddr), "n"(((2 * (ks_) + 1) * NDB + d_) * 512)); } } while (0)
                ATT_VRD(0, 0);
#pragma unroll
                for (int ks = 0; ks < 4; ++ks) {
                    const int cs = ks & 1;
                    if (ks < 3) { if (ks == 0) ATT_VRD(1, 1); else if (ks == 1) ATT_VRD(0, 2); else ATT_VRD(1, 3); }
                    if (ks < 3) { if constexpr (NDB == 2) asm volatile("s_waitcnt lgkmcnt(4)" : "+v"(vlo[cs][0]), "+v"(vhi[cs][0]), "+v"(vlo[cs][1]), "+v"(vhi[cs][1]));
                                  else asm volatile("s_waitcnt lgkmcnt(8)" : "+v"(vlo[cs][0]), "+v"(vhi[cs][0]), "+v"(vlo[cs][1]), "+v"(vhi[cs][1]), "+v"(vlo[cs][NDB - 2]), "+v"(vhi[cs][NDB - 2]), "+v"(vlo[cs][NDB - 1]), "+v"(vhi[cs][NDB - 1])); }
                    else { if constexpr (NDB == 2) asm volatile("s_waitcnt lgkmcnt(0)" : "+v"(vlo[cs][0]), "+v"(vhi[cs][0]), "+v"(vlo[cs][1]), "+v"(vhi[cs][1]));
                           else asm volatile("s_waitcnt lgkmcnt(0)" : "+v"(vlo[cs][0]), "+v"(vhi[cs][0]), "+v"(vlo[cs][1]), "+v"(vhi[cs][1]), "+v"(vlo[cs][NDB - 2]), "+v"(vhi[cs][NDB - 2]), "+v"(vlo[cs][NDB - 1]), "+v"(vhi[cs][NDB - 1])); }
#pragma unroll
                    for (int d = 0; d < NDB; ++d) {
                        const bf16x8 vf = {vlo[cs][d][0], vlo[cs][d][1], vlo[cs][d][2], vlo[cs][d][3], vhi[cs][d][0], vhi[cs][d][1], vhi[cs][d][2], vhi[cs][d][3]};
                        o[d] = __builtin_amdgcn_mfma_f32_32x32x16_bf16(vf, pw[ks], o[d], 0, 0, 0);
                    }
                }
#undef ATT_VRD
            }
        }
        ATT_WAITBAR(it + 2 < ntile);
        slot0 = (slot0 == 2) ? 0 : slot0 + 1; slot2 = (slot2 == 2) ? 0 : slot2 + 1;
    }
#undef ATT_TILE
#undef ATT_ISSUE
#undef ATT_WAITBAR
    lrun += __shfl_xor(lrun, 32);
    const float inv = 1.f / lrun;
    bf16* orow = a.o + (size_t)(wave * 32 + r32) * a.opitch + 4 * hi;
    if (a.mode == 2) {
        float ss = 0.f;
#pragma unroll
        for (int d = 0; d < NDB; ++d)
#pragma unroll
            for (int g = 0; g < 4; ++g) { const u32x2 w = *(const u32x2*)(orow + 32 * d + 8 * g);
                const float o1[4] = {bf2f(w.x & 0xffff), bf2f(w.x >> 16), bf2f(w.y & 0xffff), bf2f(w.y >> 16)};
#pragma unroll
                for (int e = 0; e < 4; ++e) { const float dl = o1[e] - a.lam * (o[d][4 * g + e] * inv); o[d][4 * g + e] = dl; ss += dl * dl; } }
        ss += __shfl_xor(ss, 32);
        const float rs = rsqrtf(ss * (1.f / (float)DV) + EPSN) * a.post;
#pragma unroll
        for (int d = 0; d < NDB; ++d)
#pragma unroll
            for (int g = 0; g < 4; ++g) { const f32x4 sl = *(const f32x4*)(a.subln + 32 * d + 8 * g + 4 * hi);
                u32x2 w; w.x = pk2(o[d][4 * g] * rs * sl[0], o[d][4 * g + 1] * rs * sl[1]); w.y = pk2(o[d][4 * g + 2] * rs * sl[2], o[d][4 * g + 3] * rs * sl[3]);
                *(u32x2*)(orow + 32 * d + 8 * g) = w; }
    } else {
#pragma unroll
        for (int d = 0; d < NDB; ++d)
#pragma unroll
            for (int g = 0; g < 4; ++g) { u32x2 w; w.x = pk2(o[d][4 * g] * inv, o[d][4 * g + 1] * inv); w.y = pk2(o[d][4 * g + 2] * inv, o[d][4 * g + 3] * inv);
                *(u32x2*)(orow + 32 * d + 8 * g) = w; }
    }
}

__device__ __forceinline__ void phase_attn_even(const Ctx& F, const Args& args, int L, bool want_ctx) {
    const bf16* P = (const bf16*)(F.ws + WS_P); const bf16* QM = (const bf16*)(F.ws + WS_QM); const bf16* KVM = (const bf16*)(F.ws + WS_KVM); bf16* O = (bf16*)(F.ws + WS_O);
    const int pr = L >> 1;
    const float lam_init = (L == 0) ? 0.2f : 0.47071302f;
    float lam;
    { const float* lp = args.in[15] + pr * 256; const float sa = wave_sum(lp[F.lane] * lp[64 + F.lane]), sb = wave_sum(lp[128 + F.lane] * lp[192 + F.lane]); lam = __expf(sa) - __expf(sb) + lam_init; }
    const float* subln = args.in[16] + pr * 128;
    const int n0 = 1024, n1 = 2048, n2 = want_ctx ? 128 : 0, n3 = want_ctx ? 256 : 0, ntot = n0 + n1 + n2 + n3;
    for (int u = F.vcu; u < ntot; u += F.G) {
        AttnP a; a.kb = nullptr; a.kbpitch = 0; a.tB0 = 0; a.nB = 0; a.rope_t0 = -1; a.mode = 0; a.lam = lam; a.post = 1.f - lam_init; a.subln = subln; a.na_row0 = 0;
        int cls, uu = u;
        if (uu < n0) cls = 0; else if ((uu -= n0) < n1) cls = 1; else if ((uu -= n1) < n2) cls = 2; else { uu -= n2; cls = 3; }
        if (cls == 0 || cls == 2) {
            int b, h, row0;
            if (cls == 0) { const int bh = uu >> 3, qb = uu & 7; b = bh >> 2; h = bh & 3; row0 = b * RPB + CTXL + 256 * qb; a.nA = 36; }
            else { b = uu >> 2; h = uu & 3; row0 = b * RPB; a.nA = 4; }
            const size_t base = (size_t)b * RPB;
            a.qpitch = PE; a.kapitch = PE; a.vpitch = PE; a.opitch = DM;
            a.v = P + base * PE + E_DV + h * 128; a.o = O + (size_t)row0 * DM + 512 + h * 128;
            for (int m = 0; m < 2; ++m) {
                a.q = P + (size_t)row0 * PE + E_DQ + h * 128 + m * 64; a.ka = P + base * PE + E_DK + h * 128 + m * 64; a.mode = 1 + m;
                attn_unit<64, 128, false>(a, F.lds, nullptr, F.tid);
            }
        } else {
            int b, h, row0;
            if (cls == 1) { const int bh = uu >> 3, qb = uu & 7; b = bh >> 3; h = bh & 7; row0 = b * RPB + CTXL + 256 * qb; a.nA = 36; a.rope_t0 = 256 * qb; }
            else { b = uu >> 3; h = uu & 7; row0 = b * RPB; a.nA = 4; }
            const size_t base = (size_t)b * RPB;
            a.q = QM + (size_t)row0 * 768 + h * 96; a.qpitch = 768; a.ka = KVM + base * 1024 + h * 128; a.kapitch = 1024; a.kb = P + base * PE + E_KR; a.kbpitch = PE;
            a.v = KVM + base * 1024 + h * 128 + 64; a.vpitch = 1024; a.o = O + (size_t)row0 * DM + h * 64; a.opitch = DM;
            attn_unit<96, 64, false>(a, F.lds, nullptr, F.tid);
        }
    }
}
__device__ __forceinline__ void phase_attn_odd(const Ctx& F, const Args& args, int L, bool want_ctx) {
    const bf16* P = (const bf16*)(F.ws + WS_P); bf16* O = (bf16*)(F.ws + WS_O);
    const int pr = L >> 1;
    const float* rpb = args.in[20] + (size_t)pr * 8 * 15 * 31;
    LAS float* biasT = (LAS float*)(F.lds + 98304);
    const int n0 = 1024, n1 = 2048, n2 = want_ctx ? 256 : 0, n3 = want_ctx ? 256 : 0, ntot = n0 + n1 + n2 + n3;
    for (int u = F.vcu; u < ntot; u += F.G) {
        if (u < n0) {
            const int qb = u & 7, bhp = u >> 3, pair = bhp & 1, hkv = (bhp >> 1) & 1, b = bhp >> 2; const int hA = 4 * hkv + 2 * pair;
            const int row0 = b * RPB + CTXL + 256 * qb; const size_t base = (size_t)b * RPB;
            AttnP2 a2; a2.qA = P + (size_t)row0 * PO + hA * 64; a2.qB = a2.qA + 64; a2.qpitch = PO; a2.ka = P + base * PO + O_GK + hkv * 64; a2.kapitch = PO; a2.v = P + base * PO + O_GV + hkv * 64; a2.vpitch = PO;
            a2.oA = O + (size_t)row0 * DM + hA * 64; a2.oB = a2.oA + 64; a2.opitch = DM; a2.ntile = 36;
            attn_unit_gqa2(a2, F.lds, F.tid);
            continue;
        }
        AttnP a; a.kb = nullptr; a.kbpitch = 0; a.tB0 = 0; a.nB = 0; a.rope_t0 = -1; a.mode = 0; a.lam = 0.f; a.post = 1.f; a.subln = nullptr; a.na_row0 = 0;
        a.qpitch = PO; a.kapitch = PO; a.vpitch = PO; a.opitch = DM;
        int cls, uu = u - n0;
        if (uu < n1) cls = 1; else if ((uu -= n1) < n2) cls = 2; else { uu -= n2; cls = 3; }
        int b, h, row0, qb = 0;
        if (cls < 2) { const int bh = uu >> 3; qb = uu & 7; b = bh >> 3; h = bh & 7; row0 = b * RPB + CTXL + 256 * qb; }
        else { b = uu >> 3; h = uu & 7; row0 = b * RPB; }
        const size_t base = (size_t)b * RPB;
        if (cls == 0 || cls == 2) {
            a.q = P + (size_t)row0 * PO + h * 64; a.ka = P + base * PO + O_GK + (h >> 2) * 64; a.v = P + base * PO + O_GV + (h >> 2) * 64; a.o = O + (size_t)row0 * DM + h * 64;
            a.nA = (cls == 0) ? 36 : 4;
            attn_unit<64, 64, false>(a, F.lds, nullptr, F.tid);
        } else {
            a.q = P + (size_t)row0 * PO + O_NQ + h * 64; a.ka = P + base * PO + O_NK + h * 64; a.v = P + base * PO + O_NV + h * 64; a.o = O + (size_t)row0 * DM + 512 + h * 64;
            a.nA = 4;
            if (cls == 1) {
                const int rlo = 4 * qb, rmin = min(max(rlo - 4, 0), 24), rmax = min(max(rlo + 3 - 4, 0), 24) + 7;
                a.tB0 = 4 + rmin; a.nB = rmax - rmin + 1; a.na_row0 = rlo;
                int tl_ = F.tid; asm volatile("" : "+v"(tl_));
                a.subln = rpb + (size_t)h * 15 * 31;
                attn_unit<64, 64, true>(a, F.lds, biasT, tl_);
            } else {
                attn_unit<64, 64, false>(a, F.lds, nullptr, F.tid);
            }
        }
    }
}

constexpr int N_PHASES = 2 + 9 * DEPTH;
#ifndef REP_A0
#define REP_A0 1
#endif
#ifndef REP_SYNC
#define REP_SYNC 1
#endif
#ifndef REP_PRO
#define REP_PRO 1
#endif
#ifndef REP_ATTN
#define REP_ATTN 1
#endif
#ifndef REP_GEMM
#define REP_GEMM 1
#endif
#ifndef EN_PRO
#define EN_PRO 1
#endif
#ifndef EN_ROW
#define EN_ROW 1
#endif
#ifndef EN_PREP
#define EN_PREP 1
#endif
#ifndef EN_AE
#define EN_AE 1
#endif
#ifndef EN_AO
#define EN_AO 1
#endif
#ifndef EN_GEMM
#define EN_GEMM 1
#endif
__global__ void __launch_bounds__(NTHR, 2) fwd_kernel(Args args) {
    extern __shared__ __attribute__((aligned(16))) unsigned char lds_raw[];
    cg::grid_group grid = cg::this_grid();
    Ctx F;
    F.lds = (LAS unsigned char*)lds_raw;
    F.G = gridDim.x; { const int bx = blockIdx.x; F.vcu = (F.G % 8 == 0) ? (bx % 8) * (F.G / 8) + bx / 8 : bx; }
    F.out = args.out; F.ws = args.ws;
    const int lo = args.ph_lo, hi = args.ph_hi;
    volatile LAS unsigned* barst = (volatile LAS unsigned*)(F.lds + LDS_BARST);
    if (threadIdx.x == 0) { barst[0] = 0u; barst[1] = 0u; }
    __syncthreads();
    unsigned* barw = (unsigned*)(F.ws + WS_BAR);
    XcdBarrier xbar; xbar.bar = barw; xbar.x = 0; xbar.st = barst;
    int nsync = 0;
    for (int ph = lo; ph < hi; ++ph) {
        { int t_ = threadIdx.x; asm volatile("" : "+v"(t_)); F.tid = t_; F.lane = t_ & 63; F.wave = __builtin_amdgcn_readfirstlane(t_ >> 6); }
        float* MOD = (float*)(F.ws + WS_MOD); bf16* AF = (bf16*)(F.ws + WS_AF);
        const float* normg = args.in[6];
        const int L = (ph < 2) ? 0 : (ph - 2) / 9, k = (ph < 2) ? -1 : (ph - 2) % 9;
        const bool even = (L & 1) == 0, want_ctx = L < DEPTH - 1;
        unsigned char* wl = F.ws + WS_WT + (size_t)L * WL_STRIDE;
        if (ph == lo && hi - lo > 1 && blockIdx.x == 0) { for (int w_ = threadIdx.x; w_ < XCD_BAR_WORDS; w_ += NTHR) barw[w_] = 0u; }
        if (ph == 0) { for (int rep_ = 0; rep_ < REP_PRO; ++rep_) { if (EN_PRO) phase_prologue_a(F, args); __syncthreads(); } }
        else if (ph == 1 || k == 5 || k == 8) {
            const float* modL = MOD + (size_t)L * 33 * 6144;
            RowPassP p;
            bf16* HB = (bf16*)(F.ws + WS_HB); bf16* HCB = (bf16*)(F.ws + WS_HCB);
            p.Adst = AF; p.Fsrc = AF; p.hb_lat = HB; p.hb_ctx = HCB; p.out32 = F.out; p.final32 = 0; p.hin_lat = HB; p.hin_ctx = HCB;
            bool hin32 = false;
            if (ph == 1) { p.hin_lat = args.in[0]; p.hin_ctx = args.in[2]; hin32 = true; p.g_post = normg; p.g_pre = normg; p.mod_post = MOD; p.mod_pre = MOD;
                p.gate_chunk = 0; p.shift_chunk = 0; p.scale_chunk = 1; p.has_f = 0; p.write_h = 0; p.write_a = 1; p.skip_ctx = 0; }
            else if (k == 5) { if (L == 0) { p.hin_lat = args.in[0]; p.hin_ctx = args.in[2]; hin32 = true; } p.Fsrc = (const bf16*)(F.ws + WS_F1); p.g_post = normg + (L * 4 + 1) * DM; p.g_pre = normg + (L * 4 + 2) * DM;
                p.mod_post = modL; p.mod_pre = modL; p.gate_chunk = 2; p.shift_chunk = 3; p.scale_chunk = 4; p.has_f = 1; p.write_h = 1; p.write_a = 1; p.skip_ctx = want_ctx ? 0 : 1; }
            else { const int Ln = (L + 1 < DEPTH) ? L + 1 : L;
                p.g_post = normg + (L * 4 + 3) * DM; p.g_pre = normg + (Ln * 4 + 0) * DM; p.mod_post = modL; p.mod_pre = MOD + (size_t)Ln * 33 * 6144;
                p.gate_chunk = 5; p.shift_chunk = 0; p.scale_chunk = 1; p.has_f = 1; p.write_h = 1; p.write_a = want_ctx ? 1 : 0; p.skip_ctx = want_ctx ? 0 : 1; p.final32 = want_ctx ? 0 : 1; }
            if (EN_ROW) {
                if (ph == 1) { for (int rep_ = 0; rep_ < REP_A0; ++rep_) { phase_rowpass<true, false, false, true, false>(F, p); __syncthreads(); } }
                else if (hin32) phase_rowpass<true, true, true, true, false>(F, p);
                else if (p.final32) phase_rowpass<false, true, false, false, true>(F, p);
                else phase_rowpass<false, true, true, true, false>(F, p);
            }
        }
        else if (k == 1) { if (EN_PREP) { if (even) phase_prep_even(F); else phase_prep_odd(F, args.in[19] + (L >> 1) * 128); } }
        else if (k == 3) { for (int rep_ = 0; rep_ < REP_ATTN; ++rep_) { if (even) { if (EN_AE) phase_attn_even(F, args, L, want_ctx); } else { if (EN_AO) phase_attn_odd(F, args, L, want_ctx); } } }
        else {
            const int ng = (k == 2) ? (even ? 2 : 0) : 1;
            for (int gi_ = 0; gi_ < ng * REP_GEMM; ++gi_) { const int gi = gi_ % ng;
                pg8::Gemm g; pg8::EpiStore E; E.act = 0;
                g.M = MROWS;
                if (k == 0) { g.A = AF; g.Bt = (const bf16*)(wl + WL_IN); g.N = even ? PE : PO; g.K = DM; g.lda = DM; E.O = (bf16*)(F.ws + WS_P); E.ldc = g.N; }
                else if (k == 2) {
                    if (gi == 0) { g.A = AF; g.Bt = (const bf16*)(wl + WL_UQ); g.N = 768; g.K = 256; g.lda = 256; E.O = (bf16*)(F.ws + WS_QM); E.ldc = 768; }
                    else { g.A = (const bf16*)(F.ws + WS_AF + 36 * MiB); g.Bt = (const bf16*)(wl + WL_UKV); g.N = 1024; g.K = 128; g.lda = 128; E.O = (bf16*)(F.ws + WS_KVM); E.ldc = 1024; } }
                else if (k == 4) { g.A = (const bf16*)(F.ws + WS_O); g.Bt = (const bf16*)(wl + WL_OUT); g.N = DM; g.K = DM; g.lda = DM; E.O = (bf16*)(F.ws + WS_F1); E.ldc = DM; }
                else if (k == 6) { g.A = AF; g.Bt = (const bf16*)(wl + WL_FF1); g.N = DFF; g.K = DM; g.lda = DM; E.O = (bf16*)(F.ws + WS_H); E.ldc = DFF; E.act = 1; }
                else { g.A = (const bf16*)(F.ws + WS_H); g.Bt = (const bf16*)(wl + WL_FF2); g.N = DM; g.K = DFF; g.lda = DFF; E.O = AF; E.ldc = DM; }
                const int skipc = (L == DEPTH - 1 && k >= 4) ? 1 : 0;
                pg8::StaticOrder S; S.init(MROWS, g.N, F.G, (int)blockIdx.x, skipc); S.rev = (k == 7) ? 1 : 0;
                if (EN_GEMM) pg8::gemm_phase<pg8::EpiStore, pg8::StaticOrder, true, true>(F.lds, g, S, E);
            }
        }
        if (ph + 1 < hi) {
            for (int s_ = 0; s_ < REP_SYNC; ++s_) {
                if (nsync == 0) { grid.sync(); xbar = xcd_barrier_post(barw, barst); }
                else xcd_barrier(xbar);
                ++nsync;
            }
        }
    }
}

#ifndef SINGLE_LAUNCH
#define SINGLE_LAUNCH 1
#endif
extern "C" void kernel_launch(void* const* d_in, const int* in_sizes, int n_in, void* d_out, int out_size, void* d_ws, size_t ws_size, hipStream_t stream) {
    static int grid = 0;
    if (grid == 0) {
        if (n_in != 21 || out_size != NB * SEQ * DM || ws_size < WS_END) { fprintf(stderr, "kernel_launch: unexpected problem (n_in %d, out %d, ws %zu)\n", n_in, out_size, ws_size); grid = -1; return; }
        int dev = 0, cus = 0, per_cu = 0;
        hipGetDevice(&dev); hipDeviceGetAttribute(&cus, hipDeviceAttributeMultiprocessorCount, dev);
        hipFuncSetAttribute((const void*)fwd_kernel, hipFuncAttributeMaxDynamicSharedMemorySize, LDS_BYTES);
        hipOccupancyMaxActiveBlocksPerMultiprocessor(&per_cu, (const void*)fwd_kernel, NTHR, LDS_BYTES);
        if (per_cu < 1) per_cu = 1;
        grid = cus;
        (void)hipGetLastError();
    }
    if (grid < 0) return;
    Args a{};
    for (int i = 0; i < 21; ++i) a.in[i] = (const float*)d_in[i];
    a.out = (float*)d_out; a.ws = (unsigned char*)d_ws;
#if SINGLE_LAUNCH
    a.ph_lo = 0; a.ph_hi = N_PHASES;
    void* kargs[] = {&a};
    hipError_t e = hipLaunchCooperativeKernel((const void*)fwd_kernel, dim3(grid), dim3(NTHR), kargs, LDS_BYTES, stream);
    if (e != hipSuccess) fprintf(stderr, "cooperative launch failed: %s (grid %d)\n", hipGetErrorString(e), grid);
#else
    for (int ph = 0; ph < N_PHASES; ++ph) {
        if (ph >= 2) { const int L = (ph - 2) / 9, k = (ph - 2) % 9; if (k == 2 && (L & 1)) continue; }
        a.ph_lo = ph; a.ph_hi = ph + 1;
        hipLaunchKernelGGL(fwd_kernel, dim3(grid), dim3(NTHR), LDS_BYTES, stream, a);
    }
#endif
}
```
